# Optimizing an MI355X kernel written in HIP

```python
import math
import jax, jax.numpy as jnp
from jax import lax
import numpy as np

D_MODEL = 1024
BATCH = 8
SEQ = 2048
DEPTH = 4
DEC_BATCH = 128
DEC_SEQ = 4
PAST_LEN = 16384
PAGE_SIZE = 128

N_META = 16
D_MIX = D_MODEL
LRU_WIDTH = D_MIX // 2
LRU_HEADS = 8
LRU_HEAD_DIM = LRU_WIDTH // LRU_HEADS
LRU_C = 8.0
CONV_K = 4
SSD_INNER = D_MIX - LRU_WIDTH
SSD_HEAD_DIM = 64
SSD_HEADS = SSD_INNER // SSD_HEAD_DIM
SSD_GROUPS = 2
SSD_STATE = 128
SSD_CONV_DIM = SSD_INNER + 2 * SSD_GROUPS * SSD_STATE
SSD_CHUNK = 128
D_FF = 3 * D_MODEL
FFN_CONV_K = 3
P_IN = 2 * LRU_WIDTH + SSD_INNER + SSD_CONV_DIM + SSD_HEADS
EPS = 1e-6

kernel_name = "hymba_rglru_ssd_convffn_step"


def rmsnorm(x, g):
    xf = x.astype(jnp.float32)
    y = xf * lax.rsqrt(jnp.mean(xf * xf, axis=-1, keepdims=True) + EPS)
    return (y * g.astype(jnp.float32)).astype(x.dtype)


def causal_dwconv(x, buf, w, b):
    K = w.shape[0]
    L = x.shape[1]
    xp = jnp.concatenate([buf.astype(x.dtype), x], axis=1)
    y = b + sum(xp[:, k:k + L] * w[k] for k in range(K))
    return y, xp[:, L:]


def rg_lru(x, h0, wa, ba, wx, bx, a_param):
    Bsz, L, W = x.shape
    xh = x.reshape(Bsz, L, LRU_HEADS, LRU_HEAD_DIM)
    r = jax.nn.sigmoid(jnp.einsum('blhi,hij->blhj', xh, wa).reshape(Bsz, L, W) + ba)
    i = jax.nn.sigmoid(jnp.einsum('blhi,hij->blhj', xh, wx).reshape(Bsz, L, W) + bx)
    log_a = -LRU_C * r.astype(jnp.float32) * jax.nn.softplus(-a_param.astype(jnp.float32))
    a = jnp.exp(log_a)
    mult = jnp.sqrt(-jnp.expm1(2.0 * log_a))
    b = mult * (i * x).astype(jnp.float32)
    b = b.at[:, 0].add(a[:, 0] * h0.astype(jnp.float32))

    def combine(lft, rgt):
        a_l, b_l = lft
        a_r, b_r = rgt
        return a_l * a_r, a_r * b_l + b_r

    _, h = lax.associative_scan(combine, (a, b), axis=1)
    return h.astype(x.dtype), h[:, -1]


def ssd_chunked(x, dt, A, Bm, Cm, h0):
    Bsz, L, H, P = x.shape
    Q = min(SSD_CHUNK, L)
    pad = (-L) % Q
    xf = x.astype(jnp.float32)
    Bf = Bm.astype(jnp.float32)
    Cf = Cm.astype(jnp.float32)
    if pad:
        pw = ((0, 0), (0, pad))
        xf = jnp.pad(xf, pw + ((0, 0), (0, 0)))
        dt = jnp.pad(dt, pw + ((0, 0),))
        Bf = jnp.pad(Bf, pw + ((0, 0), (0, 0)))
        Cf = jnp.pad(Cf, pw + ((0, 0), (0, 0)))
    nC = (L + pad) // Q
    rep = H // SSD_GROUPS
    xc = xf.reshape(Bsz, nC, Q, H, P)
    dtc = dt.reshape(Bsz, nC, Q, H)
    Bh = jnp.repeat(Bf.reshape(Bsz, nC, Q, SSD_GROUPS, -1), rep, axis=3)
    Ch = jnp.repeat(Cf.reshape(Bsz, nC, Q, SSD_GROUPS, -1), rep, axis=3)
    cs = jnp.cumsum(dtc * A.astype(jnp.float32), axis=2)
    mask = jnp.tril(jnp.ones((Q, Q), dtype=bool))[None, None, :, :, None]
    seg = cs[:, :, :, None, :] - cs[:, :, None, :, :]
    Lmat = jnp.exp(jnp.where(mask, seg, -jnp.inf))
    xdt = xc * dtc[..., None]
    scores = jnp.einsum('bcthn,bcshn->bctsh', Ch, Bh) * Lmat
    y_intra = jnp.einsum('bctsh,bcshp->bcthp', scores, xdt)
    decay_to_end = jnp.exp(cs[:, :, -1:, :] - cs)
    chunk_states = jnp.einsum('bcsh,bcshn,bcshp->bchpn', decay_to_end, Bh, xdt)
    chunk_decay = jnp.exp(cs[:, :, -1, :])

    def step(h, inp):
        dec, st = inp
        return h * dec[..., None, None] + st, h

    hT, h_in = lax.scan(step, h0.astype(jnp.float32),
                        (jnp.swapaxes(chunk_decay, 0, 1), jnp.swapaxes(chunk_states, 0, 1)))
    h_in = jnp.swapaxes(h_in, 0, 1)
    y_inter = jnp.einsum('bcthn,bchpn->bcthp', Ch, h_in) * jnp.exp(cs)[..., None]
    y = (y_intra + y_inter).reshape(Bsz, nC * Q, H, P)[:, :L]
    return y.astype(x.dtype), hT


def mixer(h, n_lead, st_lru_conv, st_lru_h, st_ssd_conv, st_ssd, p, l):
    Bsz, L, _ = h.shape
    proj = h @ p['w_in'][l]
    o1 = LRU_WIDTH
    o2 = o1 + LRU_WIDTH
    o3 = o2 + SSD_INNER
    o4 = o3 + SSD_CONV_DIM
    lru_x, lru_gate, z, xbc, dt_raw = (proj[..., :o1], proj[..., o1:o2], proj[..., o2:o3],
                                       proj[..., o3:o4], proj[..., o4:])
    xc, new_lru_conv = causal_dwconv(lru_x, st_lru_conv, p['lru_conv_w'][l], p['lru_conv_b'][l])
    hl, new_lru_h = rg_lru(xc, st_lru_h, p['lru_wa'][l], p['lru_ba'][l], p['lru_wx'][l],
                           p['lru_bx'][l], p['lru_a_param'][l])
    lru_out = rmsnorm(hl * jax.nn.gelu(lru_gate), p['lru_out_norm'][l])
    xbc_c, new_ssd_conv = causal_dwconv(xbc, st_ssd_conv, p['ssd_conv_w'][l], p['ssd_conv_b'][l])
    xbc_c = jax.nn.silu(xbc_c)
    xs = xbc_c[..., :SSD_INNER].reshape(Bsz, L, SSD_HEADS, SSD_HEAD_DIM)
    Bm = xbc_c[..., SSD_INNER:SSD_INNER + SSD_GROUPS * SSD_STATE].reshape(Bsz, L, SSD_GROUPS, SSD_STATE)
    Cm = xbc_c[..., SSD_INNER + SSD_GROUPS * SSD_STATE:].reshape(Bsz, L, SSD_GROUPS, SSD_STATE)
    dt = jax.nn.softplus((dt_raw + p['ssd_dt_bias'][l]).astype(jnp.float32))
    A = -jnp.exp(p['ssd_a_log'][l].astype(jnp.float32))
    if n_lead > 0:
        y1, h1 = ssd_chunked(xs[:, :n_lead], dt[:, :n_lead], A, Bm[:, :n_lead], Cm[:, :n_lead], st_ssd)
        y2, new_ssd = ssd_chunked(xs[:, n_lead:], dt[:, n_lead:], A, Bm[:, n_lead:], Cm[:, n_lead:], h1)
        ys = jnp.concatenate([y1, y2], axis=1)
    else:
        ys, new_ssd = ssd_chunked(xs, dt, A, Bm, Cm, st_ssd)
    ys = ys + xs * p['ssd_d'][l][:, None]
    ys = ys.reshape(Bsz, L, SSD_INNER)
    ssd_out = rmsnorm(ys * jax.nn.silu(z), p['ssd_out_norm'][l])
    out = jnp.concatenate([lru_out, ssd_out], axis=-1) @ p['w_out'][l]
    return out, new_lru_conv, new_lru_h, new_ssd_conv, new_ssd


def conv_ffn(h, buf, w_up, cw, cb, w_down):
    u = h @ w_up
    u, new_buf = causal_dwconv(u, buf, cw, cb)
    g, v = u[..., :D_FF], u[..., D_FF:]
    return (jax.nn.gelu(g) * v) @ w_down, new_buf


def trunk(x, n_lead, st_lru_conv, st_lru_h, st_ssd_conv, st_ssd, st_ffn_conv, p):
    o_lc, o_lh, o_sc, o_ss, o_fc = [], [], [], [], []
    for l in range(DEPTH):
        h = rmsnorm(x, p['norm_mix'][l])
        m, lc, lh, sc, ss = mixer(h, n_lead, st_lru_conv[l], st_lru_h[l], st_ssd_conv[l], st_ssd[l], p, l)
        x = x + m
        h = rmsnorm(x, p['norm_ffn'][l])
        f, fc = conv_ffn(h, st_ffn_conv[l], p['ffn_w_up'][l], p['ffn_conv_w'][l],
                         p['ffn_conv_b'][l], p['ffn_w_down'][l])
        x = x + f
        o_lc.append(lc); o_lh.append(lh); o_sc.append(sc); o_ss.append(ss); o_fc.append(fc)
    y = rmsnorm(x, p['norm_final'])
    return y, jnp.stack(o_lc), jnp.stack(o_lh), jnp.stack(o_sc), jnp.stack(o_ss), jnp.stack(o_fc)


def setup_inputs(seed: int = 0) -> dict:
    key = jax.random.key(seed)
    ks = iter(jax.random.split(key, 40))
    nrm = lambda shape, s: jax.random.normal(next(ks), shape, jnp.float32) * s
    gain = lambda shape: 1.0 + nrm(shape, 0.02)
    a0 = jax.random.uniform(next(ks), (DEPTH, LRU_WIDTH), jnp.float32, 0.9, 0.999) ** (1.0 / LRU_C)
    lru_a_param = jnp.log(a0) - jnp.log1p(-a0)
    dt0 = jnp.exp(jax.random.uniform(next(ks), (DEPTH, SSD_HEADS), jnp.float32, math.log(1e-3), math.log(1e-1)))
    ssd_dt_bias = dt0 + jnp.log(-jnp.expm1(-dt0))
    ssd_a_log = jnp.log(jax.random.uniform(next(ks), (DEPTH, SSD_HEADS), jnp.float32, 1.0, 16.0))
    return {
        'x_prompt': nrm((BATCH, SEQ, D_MODEL), 1.0),
        'x_sample': nrm((DEC_BATCH, DEC_SEQ, D_MODEL), 1.0),
        'state_lru_conv': nrm((DEPTH, DEC_BATCH, CONV_K - 1, LRU_WIDTH), 1.0),
        'state_lru_h': nrm((DEPTH, DEC_BATCH, LRU_WIDTH), 0.5),
        'state_ssd_conv': nrm((DEPTH, DEC_BATCH, CONV_K - 1, SSD_CONV_DIM), 1.0),
        'state_ssd': nrm((DEPTH, DEC_BATCH, SSD_HEADS, SSD_HEAD_DIM, SSD_STATE), 0.3),
        'state_ffn_conv': nrm((DEPTH, DEC_BATCH, FFN_CONV_K - 1, 2 * D_FF), 1.0),
        'meta_tokens': nrm((N_META, D_MODEL), 1.0),
        'norm_mix': gain((DEPTH, D_MODEL)),
        'w_in': nrm((DEPTH, D_MODEL, P_IN), D_MODEL ** -0.5),
        'lru_conv_w': nrm((DEPTH, CONV_K, LRU_WIDTH), CONV_K ** -0.5),
        'lru_conv_b': nrm((DEPTH, LRU_WIDTH), 0.02),
        'lru_wa': nrm((DEPTH, LRU_HEADS, LRU_HEAD_DIM, LRU_HEAD_DIM), LRU_HEAD_DIM ** -0.5),
        'lru_ba': nrm((DEPTH, LRU_WIDTH), 0.02),
        'lru_wx': nrm((DEPTH, LRU_HEADS, LRU_HEAD_DIM, LRU_HEAD_DIM), LRU_HEAD_DIM ** -0.5),
        'lru_bx': nrm((DEPTH, LRU_WIDTH), 0.02),
        'lru_a_param': lru_a_param,
        'lru_out_norm': gain((DEPTH, LRU_WIDTH)),
        'ssd_conv_w': nrm((DEPTH, CONV_K, SSD_CONV_DIM), CONV_K ** -0.5),
        'ssd_conv_b': nrm((DEPTH, SSD_CONV_DIM), 0.02),
        'ssd_dt_bias': ssd_dt_bias,
        'ssd_a_log': ssd_a_log,
        'ssd_d': gain((DEPTH, SSD_HEADS)),
        'ssd_out_norm': gain((DEPTH, SSD_INNER)),
        'w_out': nrm((DEPTH, D_MIX, D_MODEL), D_MIX ** -0.5),
        'norm_ffn': gain((DEPTH, D_MODEL)),
        'ffn_w_up': nrm((DEPTH, D_MODEL, 2 * D_FF), D_MODEL ** -0.5),
        'ffn_conv_w': nrm((DEPTH, FFN_CONV_K, 2 * D_FF), FFN_CONV_K ** -0.5),
        'ffn_conv_b': nrm((DEPTH, 2 * D_FF), 0.02),
        'ffn_w_down': nrm((DEPTH, D_FF, D_MODEL), D_FF ** -0.5),
        'norm_final': gain((D_MODEL,)),
    }


def reference(x_prompt, x_sample, state_lru_conv, state_lru_h, state_ssd_conv, state_ssd, state_ffn_conv,
              meta_tokens, norm_mix, w_in, lru_conv_w, lru_conv_b, lru_wa, lru_ba, lru_wx, lru_bx,
              lru_a_param, lru_out_norm, ssd_conv_w, ssd_conv_b, ssd_dt_bias, ssd_a_log, ssd_d,
              ssd_out_norm, w_out, norm_ffn, ffn_w_up, ffn_conv_w, ffn_conv_b, ffn_w_down, norm_final):
    p = dict(norm_mix=norm_mix, w_in=w_in, lru_conv_w=lru_conv_w, lru_conv_b=lru_conv_b,
             lru_wa=lru_wa, lru_ba=lru_ba, lru_wx=lru_wx, lru_bx=lru_bx, lru_a_param=lru_a_param,
             lru_out_norm=lru_out_norm, ssd_conv_w=ssd_conv_w, ssd_conv_b=ssd_conv_b,
             ssd_dt_bias=ssd_dt_bias, ssd_a_log=ssd_a_log, ssd_d=ssd_d, ssd_out_norm=ssd_out_norm,
             w_out=w_out, norm_ffn=norm_ffn, ffn_w_up=ffn_w_up, ffn_conv_w=ffn_conv_w,
             ffn_conv_b=ffn_conv_b, ffn_w_down=ffn_w_down, norm_final=norm_final)
    bp = x_prompt.shape[0]
    dtp = x_prompt.dtype
    xp = jnp.concatenate([jnp.broadcast_to(meta_tokens.astype(dtp)[None], (bp, N_META, D_MODEL)), x_prompt], axis=1)
    z_lc = jnp.zeros((DEPTH, bp, CONV_K - 1, LRU_WIDTH), dtp)
    z_lh = jnp.zeros((DEPTH, bp, LRU_WIDTH), jnp.float32)
    z_sc = jnp.zeros((DEPTH, bp, CONV_K - 1, SSD_CONV_DIM), dtp)
    z_ss = jnp.zeros((DEPTH, bp, SSD_HEADS, SSD_HEAD_DIM, SSD_STATE), jnp.float32)
    z_fc = jnp.zeros((DEPTH, bp, FFN_CONV_K - 1, 2 * D_FF), dtp)
    yp, p_lru_conv, p_lru_h, p_ssd_conv, p_ssd, p_ffn_conv = trunk(xp, N_META, z_lc, z_lh, z_sc, z_ss, z_fc, p)
    y_prompt = yp[:, N_META:]
    y_sample, s_lru_conv, s_lru_h, s_ssd_conv, s_ssd, s_ffn_conv = trunk(
        x_sample, 0, state_lru_conv, state_lru_h, state_ssd_conv, state_ssd, state_ffn_conv, p)
    return (y_prompt, y_sample, p_lru_conv, p_lru_h, p_ssd_conv, p_ssd, p_ffn_conv,
            s_lru_conv, s_lru_h, s_ssd_conv, s_ssd, s_ffn_conv)
```

```cpp
#include <hip/hip_runtime.h>
#include <hip/hip_cooperative_groups.h>
#include <cstdio>
#include <cstdint>
namespace cg = cooperative_groups;

#define LAS __attribute__((address_space(3)))
#define GAS __attribute__((address_space(1)))
template <class T> __device__ __forceinline__ T* glob(T* p) { return (T*)(GAS T*)p; }
typedef unsigned short bf16_t;
typedef short bf16x8 __attribute__((ext_vector_type(8)));
typedef float f32x4 __attribute__((ext_vector_type(4)));
typedef float f32x2 __attribute__((ext_vector_type(2)));
typedef unsigned u32x4 __attribute__((ext_vector_type(4)));
typedef unsigned u32x2 __attribute__((ext_vector_type(2)));

constexpr int D = 1024, DEPTH = 4, NB = 8, SEQ = 2048, NMETA = 16, LP = SEQ + NMETA, NS = 128, LS = 4;
constexpr int MP = NB * LP, MS = NS * LS, MT = MP + MS, MPAD = 17152;
constexpr int NH = 8, HD = 64, SST = 128, DFF = 3072, PIN = 2568, PINPAD = 2816;
constexpr int O_LX = 0, O_LG = 512, O_Z = 1024, O_XBC = 1536, PROJ_LD = 2560;
constexpr int NCH = 33;
constexpr float EPS = 1e-6f;

constexpr size_t OFF_YP = 0, OFF_YS = OFF_YP + (size_t)NB * SEQ * D, OFF_PLC = OFF_YS + (size_t)MS * D, OFF_PLH = OFF_PLC + (size_t)DEPTH * NB * 3 * 512,
                 OFF_PSC = OFF_PLH + (size_t)DEPTH * NB * 512, OFF_PSS = OFF_PSC + (size_t)DEPTH * NB * 3 * 1024, OFF_PFC = OFF_PSS + (size_t)DEPTH * NB * 8 * 8192,
                 OFF_SLC = OFF_PFC + (size_t)DEPTH * NB * 2 * 6144, OFF_SLH = OFF_SLC + (size_t)DEPTH * NS * 3 * 512, OFF_SSC = OFF_SLH + (size_t)DEPTH * NS * 512,
                 OFF_SSS = OFF_SSC + (size_t)DEPTH * NS * 3 * 1024, OFF_SFC = OFF_SSS + (size_t)DEPTH * NS * 8 * 8192, OUT_TOTAL = OFF_SFC + (size_t)DEPTH * NS * 2 * 6144;

constexpr size_t MiB = 1u << 20;
constexpr size_t WS_CTL = 0, CTL_BYTES = 1 * MiB;
constexpr size_t WS_SS = 494 * MiB;
constexpr size_t WS_LRUW = 2 * MiB;
constexpr size_t WS_DTRAW = 3 * MiB, WS_CS = 4 * MiB, WS_CDEC = 5 * MiB, WS_LRUA = 6 * MiB, WS_LRUH = 7 * MiB, WS_LRUHIN = 8 * MiB;
constexpr size_t WS_W = 9 * MiB;
constexpr size_t W_LAYER = 25 * MiB + MiB / 2, W_IN = 0, W_OUT = 5 * MiB + MiB / 2, W_UP = 7 * MiB + MiB / 2, W_DOWN = 19 * MiB + MiB / 2;
constexpr size_t WS_X = 111 * MiB;
constexpr size_t WS_XB = 178 * MiB + 8192;
constexpr size_t WS_PROJ = 212 * MiB;
constexpr size_t WS_YBUF = 296 * MiB;
constexpr size_t WS_STATES = 330 * MiB;
constexpr size_t WS_MIXED = 396 * MiB;
constexpr size_t WS_ABUF = 212 * MiB;
constexpr size_t WS_GSCR = 430 * MiB;
constexpr size_t WS_END = 504 * MiB;
static_assert(WS_W + DEPTH * W_LAYER <= WS_X && WS_X + (size_t)MPAD * D * 4 <= 178 * MiB && WS_XB + (size_t)MPAD * D * 2 <= WS_PROJ, "ws map 1");
static_assert(WS_PROJ + (size_t)MPAD * PROJ_LD * 2 <= WS_YBUF && WS_YBUF + (size_t)MT * 512 * 4 <= WS_STATES && WS_STATES + (size_t)NB * NCH * 8 * 8192 * 4 <= WS_MIXED, "ws map 2");
static_assert(WS_SS + (size_t)9 * MPAD * 16 * 4 <= WS_END && WS_MIXED + (size_t)MPAD * D * 2 <= WS_GSCR && WS_ABUF + (size_t)MPAD * DFF * 2 <= WS_STATES, "ws map 3");

__device__ __forceinline__ float bf2f(unsigned b) { return __uint_as_float(b << 16); }
__device__ __forceinline__ unsigned f2bf(float f) { unsigned u = __float_as_uint(f); return (u + 0x7fffu + ((u >> 16) & 1u)) >> 16; }
__device__ __forceinline__ unsigned pk2(float lo, float hi) { return f2bf(lo) | (f2bf(hi) << 16); }
__device__ __forceinline__ float sigmoidf_(float x) { return 1.0f / (1.0f + __expf(-x)); }
__device__ __forceinline__ float siluf_(float x) { return x / (1.0f + __expf(-x)); }
__device__ __forceinline__ float softplusf_(float x) { return x > 20.f ? x : log1pf(__expf(x)); }
__device__ __forceinline__ float gelu_tanh(float x) { const float z = 0.7978845608028654f * (x + 0.044715f * x * x * x); const float e = __expf(2.0f * z); return 0.5f * x * (2.0f - 2.0f / (1.0f + e)); }
__device__ __forceinline__ float bperm(float v, int srclane) { return __int_as_float(__builtin_amdgcn_ds_bpermute(srclane << 2, __float_as_int(v))); }
__device__ __forceinline__ float rowss(const float* ss, int row) { const f32x4* p = (const f32x4*)(ss + (size_t)row * 16); const f32x4 a = p[0], b = p[1], c = p[2], d = p[3]; return (((a[0] + a[1]) + (a[2] + a[3])) + ((b[0] + b[1]) + (b[2] + b[3]))) + (((c[0] + c[1]) + (c[2] + c[3])) + ((d[0] + d[1]) + (d[2] + d[3]))); }
#define LDS_WAIT() asm volatile("s_waitcnt lgkmcnt(0)" ::: "memory")
#define VM_WAIT() asm volatile("s_waitcnt vmcnt(0)" ::: "memory")
__device__ __forceinline__ f32x4 mfma16(bf16x8 p, bf16x8 q, f32x4 c) { return __builtin_amdgcn_mfma_f32_16x16x32_bf16(p, q, c, 0, 0, 0); }
__device__ __forceinline__ bf16x8 ldsfrag(const LAS unsigned char* img, int rs, int row, int kbyte) { return *(const LAS bf16x8*)(img + row * rs + kbyte); }

namespace pg8 {
#define PG8_LAS __attribute__((address_space(3)))
constexpr int BM = 256, BK = 64, HALF = 128, HTB = HALF * BK * 2, STAGE_BYTES = 8 * HTB, NXCD = 8, WGM = 8;
__host__ __device__ __forceinline__ int lds_byte(int r, int c) { const int st = (r >> 4) * 2 + (c >> 5), rr = r & 15, cc = c & 31, ob = rr * 64 + cc * 2; return st * 1024 + (ob ^ (((ob >> 9) & 1) << 5)); }
__host__ __device__ __forceinline__ void stage_rc(int b, int& R, int& C) { const int st = b / 1024, sb = b % 1024, swz = sb ^ (((sb >> 9) & 1) << 5); R = (st >> 1) * 16 + swz / 64; C = (st & 1) * 32 + (swz % 64) / 2; }
__host__ __device__ __forceinline__ int perm32(int rho) { const int n = rho >> 4, i = rho & 15; return 8 * (i >> 2) + 4 * n + (i & 3); }
struct Unit { int pm, pn; };
struct Gemm { const bf16_t* A; const bf16_t* Bt; int K, nM, nN; long a_tstep, a_hstep; int ovl; };
struct StaticOrder {
    int nM, nN, nwg, G, c;
    __device__ __forceinline__ void init(int nM_, int nN_, int G_, int c_) { nM = nM_; nN = nN_; nwg = nM * nN; G = G_; c = c_; }
    __device__ __forceinline__ bool next(int i, Unit& u) const {
        const long L = (long)i * G + c; if (L >= nwg) return false;
        int wgid = (int)L; { const int q = nwg / NXCD, r = nwg % NXCD, xcd = wgid % NXCD, off = wgid / NXCD; wgid = (xcd < r ? xcd * (q + 1) : r * (q + 1) + (xcd - r) * q) + off; }
        const int nig = WGM * nN, gid = wgid / nig, fm = gid * WGM, gsz = (nM - fm) < WGM ? (nM - fm) : WGM;
        u.pm = fm + ((wgid % nig) % gsz); u.pn = (wgid % nig) / gsz; return true;
    }
    __device__ __forceinline__ void a_ready(const Unit&) const {}
    __device__ __forceinline__ void done(const Unit&) const {}
};
__device__ __forceinline__ unsigned cvt_pk_bf16(float lo, float hi) { unsigned r; asm volatile("v_cvt_pk_bf16_f32 %0, %1, %2" : "=v"(r) : "v"(lo), "v"(hi)); return r; }

template <class Epi, class Sched, bool ALIGN_EPI, bool SP2>
__device__ __forceinline__ void gemm_phase(PG8_LAS unsigned char* lds, const Gemm g, const Sched& S, const Epi& E, const int tid) {
    const int wid = __builtin_amdgcn_readfirstlane(tid >> 6), lane = tid & 63, wr = wid >> 2, wc = wid & 3, fr = lane & 15, fq = lane >> 4;
    const int K = g.K, nt = K / BK;
    unsigned voffA[2], voffB[2];
#pragma unroll
    for (int i = 0; i < 2; ++i) { int R, C; stage_rc(tid * 16 + i * 8192, R, C); const int Rb = Epi::PERM ? ((R & ~31) + perm32(R & 31)) : R; const int Ra = g.ovl ? (R - 2 * (R >> 6)) : R;
        voffA[i] = (unsigned)(Ra * K + C) * 2u; voffB[i] = (unsigned)(Rb * K + C) * 2u; }
    const size_t kstep = (size_t)(BK * 2);
    const size_t hstepB = (size_t)HALF * K * 2, tstepB = 2 * hstepB;
    const size_t hstepA = (size_t)g.a_hstep, tstepA = (size_t)g.a_tstep;
    const unsigned ldsw = (unsigned)wid * 1024u;
    const int aoff = lds_byte(wr * 64 + fr, fq * 8), boff = lds_byte(wc * 32 + fr, fq * 8);
#define PG8_SA(b, h) (((b) * 2 + (h)) * HTB)
#define PG8_SB(b, h) ((4 + (b) * 2 + (h)) * HTB)
#define PG8_STAGE(bufoff, gbase, voff) do { _Pragma("unroll") for (int _i = 0; _i < 2; ++_i) \
        __builtin_amdgcn_global_load_lds((const unsigned*)((const char*)(gbase) + (voff)[_i]), (PG8_LAS unsigned*)(lds + (bufoff) + ldsw + _i * 8192), 16, 0, 0); } while (0)
#define PG8_LDA(dst, b, h) do { _Pragma("unroll") for (int m = 0; m < 4; ++m) _Pragma("unroll") for (int k = 0; k < 2; ++k) dst[m][k] = *(const PG8_LAS bf16x8*)(lds + PG8_SA(b, h) + aoff + m * 2048 + k * 1024); } while (0)
#define PG8_LDB(dst, b, h) do { _Pragma("unroll") for (int n = 0; n < 2; ++n) _Pragma("unroll") for (int k = 0; k < 2; ++k) dst[n][k] = *(const PG8_LAS bf16x8*)(lds + PG8_SB(b, h) + boff + n * 2048 + k * 1024); } while (0)
#define PG8_MMA(ai, bj, At, Bt) do { __builtin_amdgcn_s_setprio(1); _Pragma("unroll") for (int m = 0; m < 4; ++m) _Pragma("unroll") for (int n = 0; n < 2; ++n) _Pragma("unroll") for (int k = 0; k < 2; ++k) \
        acc[ai][bj][m][n] = __builtin_amdgcn_mfma_f32_16x16x32_bf16(Bt[n][k], At[m][k], acc[ai][bj][m][n], 0, 0, 0); __builtin_amdgcn_s_setprio(0); } while (0)
#define PG8_WAIT_V(n) asm volatile("s_waitcnt vmcnt(" #n ")" ::: "memory")
#define PG8_WAIT_L(n) asm volatile("s_waitcnt lgkmcnt(" #n ")" ::: "memory")
#define PG8_BAR __builtin_amdgcn_s_barrier()
#define PG8_SCHED __builtin_amdgcn_sched_barrier(0)
    Unit cur, nxt; int ui = 0;
    if (!S.next(0, cur)) return;
    f32x4 acc[2][2][4][2];
#pragma unroll
    for (int a = 0; a < 2; ++a)
#pragma unroll
        for (int b = 0; b < 2; ++b)
#pragma unroll
            for (int m = 0; m < 4; ++m)
#pragma unroll
                for (int n = 0; n < 2; ++n) acc[a][b][m][n] = (f32x4){0.f, 0.f, 0.f, 0.f};
    bf16x8 At[4][2], B0[2][2], B1[2][2];
    const char* cA = (const char*)g.A + (size_t)cur.pm * tstepA; const char* cB = (const char*)g.Bt + (size_t)cur.pn * tstepB;
    S.a_ready(cur);
    if constexpr (SP2) {
        PG8_STAGE(PG8_SB(0, 0), cB, voffB); PG8_STAGE(PG8_SB(0, 1), cB + hstepB, voffB); PG8_STAGE(PG8_SA(0, 0), cA, voffA); PG8_STAGE(PG8_SA(0, 1), cA + hstepA, voffA);
        if (wr == 1) PG8_BAR;
        PG8_WAIT_V(2); PG8_BAR;
        PG8_STAGE(PG8_SB(1, 0), cB + kstep, voffB); PG8_STAGE(PG8_SA(1, 0), cA + kstep, voffA); PG8_STAGE(PG8_SB(1, 1), cB + hstepB + kstep, voffB);
        PG8_WAIT_V(6); PG8_BAR;
    } else {
        PG8_STAGE(PG8_SB(0, 0), cB, voffB); PG8_STAGE(PG8_SA(0, 0), cA, voffA); PG8_STAGE(PG8_SB(0, 1), cB + hstepB, voffB); PG8_STAGE(PG8_SA(0, 1), cA + hstepA, voffA);
        if (wr == 1) PG8_BAR;
        PG8_WAIT_V(4); PG8_BAR;
        PG8_STAGE(PG8_SB(1, 0), cB + kstep, voffB); PG8_STAGE(PG8_SA(1, 0), cA + kstep, voffA); PG8_STAGE(PG8_SB(1, 1), cB + hstepB + kstep, voffB);
        PG8_WAIT_V(6); PG8_BAR;
    }
    for (;;) {
        const bool has_next = S.next(ui + 1, nxt);
        const char* nA = has_next ? (const char*)g.A + (size_t)nxt.pm * tstepA : cA; const char* nB = has_next ? (const char*)g.Bt + (size_t)nxt.pn * tstepB : cB;
        for (int t = 0; t < nt; t += 2) {
            const bool last = (t == nt - 2);
            const char* a1 = cA + (size_t)(t + 1) * kstep;
            const char* a2 = last ? nA : cA + (size_t)(t + 2) * kstep; const char* b2 = last ? nB : cB + (size_t)(t + 2) * kstep;
            const char* a3 = a2 + kstep; const char* b3 = b2 + kstep;
            if (last && has_next) S.a_ready(nxt);
            if constexpr (SP2) {
            PG8_LDB(B0, 0, 0); PG8_LDB(B1, 0, 1); PG8_SCHED; PG8_LDA(At, 0, 0); PG8_STAGE(PG8_SA(1, 1), a1 + hstepA, voffA);
            PG8_WAIT_V(8); PG8_WAIT_L(0); PG8_BAR; PG8_MMA(0, 0, At, B0); PG8_MMA(0, 1, At, B1); PG8_BAR; PG8_SCHED;
            PG8_LDA(At, 0, 1); PG8_STAGE(PG8_SB(0, 0), b2, voffB); PG8_STAGE(PG8_SB(0, 1), b2 + hstepB, voffB); PG8_STAGE(PG8_SA(0, 0), a2, voffA);
            PG8_WAIT_V(8); PG8_WAIT_L(0); PG8_BAR; PG8_MMA(1, 0, At, B0); PG8_MMA(1, 1, At, B1); PG8_BAR; PG8_SCHED;
            PG8_LDB(B0, 1, 0); PG8_LDB(B1, 1, 1); PG8_SCHED; PG8_LDA(At, 1, 0); PG8_STAGE(PG8_SA(0, 1), a2 + hstepA, voffA);
            PG8_WAIT_V(8); PG8_WAIT_L(0); PG8_BAR; PG8_MMA(0, 0, At, B0); PG8_MMA(0, 1, At, B1); PG8_BAR; PG8_SCHED;
            PG8_LDA(At, 1, 1); PG8_STAGE(PG8_SB(1, 0), b3, voffB); PG8_STAGE(PG8_SB(1, 1), b3 + hstepB, voffB); PG8_STAGE(PG8_SA(1, 0), a3, voffA);
            PG8_WAIT_V(8); PG8_WAIT_L(0); PG8_BAR; PG8_MMA(1, 0, At, B0); PG8_MMA(1, 1, At, B1); PG8_BAR; PG8_SCHED;
            } else {
            PG8_LDB(B0, 0, 0); PG8_SCHED; PG8_LDA(At, 0, 0); PG8_STAGE(PG8_SA(1, 1), a1 + hstepA, voffA);
            PG8_WAIT_L(8); PG8_BAR; PG8_WAIT_L(0); PG8_MMA(0, 0, At, B0); PG8_BAR; PG8_SCHED;
            PG8_LDB(B1, 0, 1); PG8_STAGE(PG8_SB(0, 0), b2, voffB);
            PG8_BAR; PG8_WAIT_L(0); PG8_MMA(0, 1, At, B1); PG8_BAR;
            PG8_LDA(At, 0, 1); PG8_STAGE(PG8_SA(0, 0), a2, voffA);
            PG8_BAR; PG8_WAIT_L(0); PG8_MMA(1, 0, At, B0); PG8_BAR; PG8_SCHED;
            PG8_STAGE(PG8_SB(0, 1), b2 + hstepB, voffB);
            PG8_WAIT_V(6); PG8_BAR; PG8_MMA(1, 1, At, B1); PG8_BAR;
            PG8_LDB(B0, 1, 0); PG8_SCHED; PG8_LDA(At, 1, 0); PG8_STAGE(PG8_SA(0, 1), a2 + hstepA, voffA);
            PG8_WAIT_L(8); PG8_BAR; PG8_WAIT_L(0); PG8_MMA(0, 0, At, B0); PG8_BAR; PG8_SCHED;
            PG8_LDB(B1, 1, 1); PG8_STAGE(PG8_SB(1, 0), b3, voffB);
            PG8_BAR; PG8_WAIT_L(0); PG8_MMA(0, 1, At, B1); PG8_BAR;
            PG8_LDA(At, 1, 1); PG8_STAGE(PG8_SA(1, 0), a3, voffA);
            PG8_BAR; PG8_WAIT_L(0); PG8_MMA(1, 0, At, B0); PG8_BAR; PG8_SCHED;
            PG8_STAGE(PG8_SB(1, 1), b3 + hstepB, voffB);
            PG8_WAIT_V(6); PG8_BAR; PG8_MMA(1, 1, At, B1); PG8_BAR;
            }
        }
        if constexpr (ALIGN_EPI) { if (wr == 0) PG8_BAR; }
        E(acc, cur, wr, wc, fr, fq); S.done(cur);
        if (!has_next) break;
#pragma unroll
        for (int a = 0; a < 2; ++a)
#pragma unroll
            for (int b = 0; b < 2; ++b)
#pragma unroll
                for (int m = 0; m < 4; ++m)
#pragma unroll
                    for (int n = 0; n < 2; ++n) acc[a][b][m][n] = (f32x4){0.f, 0.f, 0.f, 0.f};
        cur = nxt; cA = nA; cB = nB; ++ui;
        if constexpr (ALIGN_EPI) { if (wr == 1) PG8_BAR; }
    }
    PG8_WAIT_V(0);
    if constexpr (!ALIGN_EPI) { if (wr == 0) PG8_BAR; }
    PG8_BAR;
#undef PG8_SA
#undef PG8_SB
#undef PG8_STAGE
#undef PG8_LDA
#undef PG8_LDB
#undef PG8_MMA
#undef PG8_WAIT_V
#undef PG8_WAIT_L
#undef PG8_BAR
#undef PG8_SCHED
}


struct EpiIn {
    static constexpr bool PERM = true;
    bf16_t* proj; float* dtraw; const float* ss;
    __device__ __forceinline__ void operator()(const f32x4 (&acc)[2][2][4][2], const Unit& u, int wr, int wc, int fr, int fq) const {
        const int row0 = u.pm * BM + wr * 64 + fr;
        if (u.pn < 10) {
            const int col0 = u.pn * BM + wc * 32 + 8 * fq;
#pragma unroll
            for (int ai = 0; ai < 2; ++ai)
#pragma unroll
                for (int m = 0; m < 4; ++m) { const int row = row0 + ai * HALF + m * 16; const float rs = rsqrtf(rowss(ss, row) * (1.0f / 1024.0f) + EPS);
                    bf16_t* rowp = proj + (size_t)row * PROJ_LD + col0;
#pragma unroll
                    for (int bj = 0; bj < 2; ++bj) { const f32x4 v0 = acc[ai][bj][m][0] * rs, v1 = acc[ai][bj][m][1] * rs;
                        u32x4 w; w.x = cvt_pk_bf16(v0[0], v0[1]); w.y = cvt_pk_bf16(v0[2], v0[3]); w.z = cvt_pk_bf16(v1[0], v1[1]); w.w = cvt_pk_bf16(v1[2], v1[3]);
                        *(u32x4*)(rowp + bj * HALF) = w; } }
        } else if (wc == 0 && fq == 0) {
#pragma unroll
            for (int ai = 0; ai < 2; ++ai)
#pragma unroll
                for (int m = 0; m < 4; ++m) { const int row = row0 + ai * HALF + m * 16; const float rs = rsqrtf(rowss(ss, row) * (1.0f / 1024.0f) + EPS);
                    float* p = dtraw + (size_t)row * 8; *(f32x4*)p = acc[ai][0][m][0] * rs; *(f32x4*)(p + 4) = acc[ai][0][m][1] * rs; }
        }
    }
};
struct EpiRes {
    static constexpr bool PERM = true;
    float* x; bf16_t* xb; float* ssn;
    __device__ __forceinline__ void operator()(const f32x4 (&acc)[2][2][4][2], const Unit& u, int wr, int wc, int fr, int fq) const {
        const int row0 = u.pm * BM + wr * 64 + fr, col0 = u.pn * BM + wc * 32 + 8 * fq;
#pragma unroll
        for (int ai = 0; ai < 2; ++ai)
#pragma unroll
            for (int m = 0; m < 4; ++m) { const int row = row0 + ai * HALF + m * 16; float part = 0.f;
#pragma unroll
                for (int bj = 0; bj < 2; ++bj) { float* xp = x + (size_t)row * D + col0 + bj * HALF;
                    const f32x4 o0 = *(const f32x4*)xp + acc[ai][bj][m][0], o1 = *(const f32x4*)(xp + 4) + acc[ai][bj][m][1];
                    *(f32x4*)xp = o0; *(f32x4*)(xp + 4) = o1;
                    part += (o0[0] * o0[0] + o0[1] * o0[1]) + (o0[2] * o0[2] + o0[3] * o0[3]) + (o1[0] * o1[0] + o1[1] * o1[1]) + (o1[2] * o1[2] + o1[3] * o1[3]);
                    u32x4 w; w.x = cvt_pk_bf16(o0[0], o0[1]); w.y = cvt_pk_bf16(o0[2], o0[3]); w.z = cvt_pk_bf16(o1[0], o1[1]); w.w = cvt_pk_bf16(o1[2], o1[3]);
                    *(u32x4*)(xb + (size_t)row * D + col0 + bj * HALF) = w; }
                { const int ln = fr + 16 * fq; part += bperm(part, ln ^ 16); part += bperm(part, ln ^ 32); }
                if (fq == 0) ssn[(size_t)row * 16 + u.pn * 4 + wc] = part; }
    }
};
struct EpiUp {
    static constexpr bool PERM = true;
    bf16_t* a; const float* ss; const float* cw; const float* cb; const float* st; float* pf; float* sf;
    __device__ __forceinline__ void operator()(const f32x4 (&acc)[2][2][4][2], const Unit& u, int wr, int wc, int fr, int fq) const {
        const int lane = fr + 16 * fq;
        const int src1 = (lane & 48) | ((fr + 15) & 15), src2 = (lane & 48) | ((fr + 14) & 15);
        const int ch0 = u.pn * 128 + wc * 32 + 8 * fq;
#pragma unroll
        for (int ai = 0; ai < 2; ++ai) {
            const int gr0 = u.pm * 248 + 62 * (2 * ai + wr) - 2;
            float rs[4]; int tk[4];
#pragma unroll
            for (int m = 0; m < 4; ++m) { const int lr = 16 * m + fr, gr = gr0 + lr; const int idx = gr < 0 ? 0 : gr; rs[m] = rsqrtf(rowss(ss, idx) * (1.0f / 1024.0f) + EPS);
                tk[m] = (lr >= 2 && gr < MT) ? (gr < MP ? gr % LP : -1 - (gr - MP)) : (int)0x80000000; }
            unsigned pk[4][4];
#pragma unroll
            for (int n = 0; n < 2; ++n) {
                float keep[4];
#pragma unroll
                for (int j = 0; j < 4; ++j) {
                    const int col = ch0 + 4 * n + j;
                    const float wg0 = cw[col], wg1 = cw[6144 + col], wg2 = cw[2 * 6144 + col], bg = cb[col];
                    const float wv0 = cw[3072 + col], wv1 = cw[6144 + 3072 + col], wv2 = cw[2 * 6144 + 3072 + col], bv = cb[3072 + col];
                    float ug[4], uv[4], s1g[4], s2g[4], s1v[4], s2v[4];
#pragma unroll
                    for (int m = 0; m < 4; ++m) { ug[m] = acc[ai][0][m][n][j] * rs[m]; uv[m] = acc[ai][1][m][n][j] * rs[m];
                        s1g[m] = bperm(ug[m], src1); s2g[m] = bperm(ug[m], src2); s1v[m] = bperm(uv[m], src1); s2v[m] = bperm(uv[m], src2); }
#pragma unroll
                    for (int m = 0; m < 4; ++m) {
                        const int mm = m > 0 ? m - 1 : 0;
                        float p1g = fr >= 1 ? s1g[m] : (m > 0 ? s1g[mm] : 0.f), p2g = fr >= 2 ? s2g[m] : (m > 0 ? s2g[mm] : 0.f);
                        float p1v = fr >= 1 ? s1v[m] : (m > 0 ? s1v[mm] : 0.f), p2v = fr >= 2 ? s2v[m] : (m > 0 ? s2v[mm] : 0.f);
                        const int t = tk[m];
                        if (t >= 0) { if (t < 1) { p1g = 0.f; p1v = 0.f; } if (t < 2) { p2g = 0.f; p2v = 0.f; }
                            if (t >= LP - 2) { const int gr = gr0 + 16 * m + fr; float* o = pf + ((size_t)(gr / LP) * 2 + (t - (LP - 2))) * 6144 + col; o[0] = ug[m]; o[3072] = uv[m]; } }
                        else if (t != (int)0x80000000) { const int sr = -1 - t, pos = sr & 3, sq = sr >> 2;
                            if (pos < 2) { const float* s0 = st + ((size_t)sq * 2) * 6144 + col; const float g0 = s0[0], v0 = s0[3072], g1 = s0[6144], v1 = s0[6144 + 3072];
                                if (pos == 0) { p1g = g1; p1v = v1; p2g = g0; p2v = v0; } else { p2g = g1; p2v = v1; } }
                            else { float* o = sf + ((size_t)sq * 2 + (pos - 2)) * 6144 + col; o[0] = ug[m]; o[3072] = uv[m]; } }
                        const float cg_ = bg + wg0 * p2g + wg1 * p1g + wg2 * ug[m], cv_ = bv + wv0 * p2v + wv1 * p1v + wv2 * uv[m];
                        const float r_ = gelu_tanh(cg_) * cv_;
                        if (j & 1) pk[m][2 * n + (j >> 1)] = cvt_pk_bf16(keep[m], r_); else keep[m] = r_;
                    }
                }
            }
#pragma unroll
            for (int m = 0; m < 4; ++m) { if (tk[m] != (int)0x80000000) { const int gr = gr0 + 16 * m + fr; u32x4 w; w.x = pk[m][0]; w.y = pk[m][1]; w.z = pk[m][2]; w.w = pk[m][3];
                    *(u32x4*)(a + (size_t)gr * DFF + ch0) = w; } }
        }
    }
};
}

#define XB_TMO      128
#define XB_XCNT(j)  (256  + 64 * (j))
#define XB_XSUB(j)  (1280 + 64 * (j))
#define XB_XGEN(j)  (2304 + 64 * (j))
#define XB_TOP      3328
#define XB_TOPGEN   3392
#define XCD_BAR_WORDS 3456
#define XB_SPIN_CAP (1u << 18)
__device__ __forceinline__ unsigned xb_ld(unsigned* p)              { return __hip_atomic_load(p, __ATOMIC_RELAXED, __HIP_MEMORY_SCOPE_AGENT); }
__device__ __forceinline__ unsigned xb_add(unsigned* p, unsigned v) { return __hip_atomic_fetch_add(p, v, __ATOMIC_RELAXED, __HIP_MEMORY_SCOPE_AGENT); }
__device__ __forceinline__ unsigned xb_xcc_id() { return (unsigned)__builtin_amdgcn_s_getreg((3 << 11) | 20) & 0xFu; }
#define XB_SPIN(cond, bar) do { unsigned _sp = 0; while (cond) { __builtin_amdgcn_s_sleep(1); \
    if ((++_sp & 255u) == 0u) { if (xb_ld(&(bar)[XB_TMO])) break; if (_sp > XB_SPIN_CAP) { atomicAdd(&(bar)[XB_TMO], 1u); break; } } } } while (0)
struct XcdBarrier { unsigned* bar; unsigned x; volatile LAS unsigned* st; };
__device__ __forceinline__ XcdBarrier xcd_barrier_post(unsigned* bar, volatile LAS unsigned* st, const int tid) {
    XcdBarrier b; b.bar = bar; b.x = xb_xcc_id(); b.st = st;
    if (tid == 0) (void)xb_add(&bar[XB_XCNT(b.x)], 1u);
    return b;
}
__device__ __forceinline__ void xcd_barrier_complete(unsigned* bar, unsigned x, unsigned& nloc, unsigned& nx) {
    const unsigned G = gridDim.x * gridDim.y * gridDim.z;
    unsigned sum, cnt, mine, sp = 0u;
    for (;;) {
        sum = 0u; cnt = 0u; mine = 0u;
#pragma unroll
        for (unsigned j = 0; j < 16; ++j) { const unsigned c = xb_ld(&bar[XB_XCNT(j)]); sum += c; cnt += (c > 0u) ? 1u : 0u; mine = (j == x) ? c : mine; }
        if (sum == G) break;
        __builtin_amdgcn_s_sleep(1);
        if ((++sp & 255u) == 0u) { if (xb_ld(&bar[XB_TMO])) break; if (sp > XB_SPIN_CAP) { atomicAdd(&bar[XB_TMO], 1u); break; } }
    }
    nloc = mine > 0u ? mine : 1u; nx = cnt > 0u ? cnt : 1u;
}
__device__ __forceinline__ void xcd_barrier(const XcdBarrier& b, const int tid) {
    asm volatile("s_waitcnt vmcnt(0)" ::: "memory");
    __syncthreads();
    if (tid == 0) {
        unsigned* bar = b.bar;
        __builtin_amdgcn_s_waitcnt(0);
        unsigned nloc = b.st[0], nx = b.st[1];
        if (nloc == 0u) { xcd_barrier_complete(bar, b.x, nloc, nx); b.st[0] = nloc; b.st[1] = nx; }
        const unsigned old = xb_add(&bar[XB_XSUB(b.x)], 1u);
        const unsigned gen = old / nloc;
        if (old + 1u == (gen + 1u) * nloc) {
            __builtin_amdgcn_fence(__ATOMIC_RELEASE, "agent");
            asm volatile("s_waitcnt vmcnt(0)" ::: "memory");
            const unsigned og = xb_add(&bar[XB_TOP], 1u);
            const unsigned tg = og / nx;
            if (og + 1u == (tg + 1u) * nx) xb_add(&bar[XB_TOPGEN], 1u);
            else XB_SPIN(xb_ld(&bar[XB_TOPGEN]) == tg, bar);
            __builtin_amdgcn_fence(__ATOMIC_ACQUIRE, "agent");
            xb_add(&bar[XB_XGEN(b.x)], 1u);
            asm volatile("s_waitcnt vmcnt(0)" ::: "memory");
        } else {
            XB_SPIN(xb_ld(&bar[XB_XGEN(b.x)]) == gen, bar);
            __builtin_amdgcn_fence(__ATOMIC_ACQUIRE, "agent");
            asm volatile("s_waitcnt vmcnt(0)" ::: "memory");
        }
    }
    __syncthreads();
}

struct Params { const float* in[31]; float* out; unsigned char* ws; };
enum { I_XP = 0, I_XS, I_SLC, I_SLH, I_SSC, I_SSS, I_SFC, I_META, I_NMIX, I_WIN, I_LCW, I_LCB, I_WA, I_BA, I_WX, I_BX, I_APAR, I_LON, I_SCW, I_SCB, I_DTB, I_ALOG, I_SSD_D, I_SON, I_WOUT, I_NFFN, I_WUP, I_FCW, I_FCB, I_WDOWN, I_NFIN };

constexpr int LDS_MISC = 131072, LDS_BYTES = 147456;

__device__ __forceinline__ float wave_sum(float v, int lane) {
#pragma unroll
    for (int o = 1; o < 64; o <<= 1) v += bperm(v, lane ^ o);
    return v;
}

__device__ __forceinline__ void p0_transpose_item(const float* W, int ldw, int nvalid, const float* gain, bf16_t* WT, int ldt, int k0, int n0, int drow0, LAS float* scr, int lane) {
    const int nn = n0 + (lane & 31);
#pragma unroll 8
    for (int i = 0; i < 32; ++i) { const int kk = 2 * i + (lane >> 5); float v = nn < nvalid ? W[(size_t)(k0 + kk) * ldw + nn] : 0.f; if (gain) v *= gain[k0 + kk]; scr[kk * 33 + (lane & 31)] = v; }
    LDS_WAIT(); asm volatile("" ::: "memory");
    const int c = lane & 7;
#pragma unroll
    for (int j = 0; j < 4; ++j) { const int n = (lane >> 3) + 8 * j; const LAS float* s = scr + (8 * c) * 33 + n;
        u32x4 o; o.x = pk2(s[0 * 33], s[1 * 33]); o.y = pk2(s[2 * 33], s[3 * 33]); o.z = pk2(s[4 * 33], s[5 * 33]); o.w = pk2(s[6 * 33], s[7 * 33]);
        *(u32x4*)(WT + (size_t)(drow0 + n) * ldt + k0 + 8 * c) = o; }
    LDS_WAIT(); asm volatile("" ::: "memory");
}
__device__ __forceinline__ void p0_prologue(const Params& P, LAS unsigned char* lds, int wave, int lane, const int tid) {
    LAS float* scr = (LAS float*)(lds + wave * 16384);
    const int gw = blockIdx.x * 8 + wave, NGW = gridDim.x * 8;
    unsigned char* ws = P.ws;
    constexpr int I_IN = 16 * 88, I_OUT = 16 * 32, I_UP = 16 * 192, I_DN = 48 * 32, I_L = I_IN + I_OUT + I_UP + I_DN, I_LRU = DEPTH * 8 * 2 * 2;
    for (int it = gw; it < DEPTH * I_L + I_LRU; it += NGW) {
        if (it < DEPTH * I_L) {
            const int l = it / I_L; int r = it % I_L; unsigned char* wl = ws + WS_W + (size_t)l * W_LAYER;
            if (r < I_IN) { const int kb = r / 88, nb = r % 88; p0_transpose_item(P.in[I_WIN] + (size_t)l * D * PIN, PIN, PIN, P.in[I_NMIX] + l * D, (bf16_t*)(wl + W_IN), D, 64 * kb, 32 * nb, 32 * nb, scr, lane); continue; } r -= I_IN;
            if (r < I_OUT) { const int kb = r / 32, nb = r % 32; p0_transpose_item(P.in[I_WOUT] + (size_t)l * D * D, D, D, nullptr, (bf16_t*)(wl + W_OUT), D, 64 * kb, 32 * nb, 32 * nb, scr, lane); continue; } r -= I_OUT;
            if (r < I_UP) { const int kb = r / 192, nb = r % 192, n0 = 32 * nb; const int drow = n0 < DFF ? (n0 / 128) * 256 + (n0 % 128) : ((n0 - DFF) / 128) * 256 + 128 + ((n0 - DFF) % 128);
                p0_transpose_item(P.in[I_WUP] + (size_t)l * D * 2 * DFF, 2 * DFF, 2 * DFF, P.in[I_NFFN] + l * D, (bf16_t*)(wl + W_UP), D, 64 * kb, n0, drow, scr, lane); continue; } r -= I_UP;
            { const int kb = r / 32, nb = r % 32; p0_transpose_item(P.in[I_WDOWN] + (size_t)l * DFF * D, D, D, nullptr, (bf16_t*)(wl + W_DOWN), DFF, 64 * kb, 32 * nb, 32 * nb, scr, lane); }
        } else {
            const int r = it - DEPTH * I_L, lh = r >> 2, which = (r >> 1) & 1, nb = r & 1;
            p0_transpose_item(P.in[which ? I_WX : I_WA] + (size_t)lh * 4096, 64, 64, nullptr, (bf16_t*)(ws + WS_LRUW) + (size_t)which * DEPTH * 8 * 4096 + (size_t)lh * 4096, 64, 0, 32 * nb, 32 * nb, scr, lane);
        }
    }
    float* x = (float*)(ws + WS_X); bf16_t* xb = (bf16_t*)(ws + WS_XB); float* ss = (float*)(ws + WS_SS);
    for (int m = gw; m < MPAD; m += NGW) {
        const float* src = nullptr;
        if (m < MP) { const int b = m / LP, t = m % LP; src = t < NMETA ? P.in[I_META] + (size_t)t * D : P.in[I_XP] + ((size_t)b * SEQ + (t - NMETA)) * D; }
        else if (m < MT) src = P.in[I_XS] + (size_t)(m - MP) * D;
        f32x4 v[4]; float s = 0.f;
#pragma unroll
        for (int j = 0; j < 4; ++j) { v[j] = src ? *((const f32x4*)src + lane + 64 * j) : (f32x4){0.f, 0.f, 0.f, 0.f}; s += (v[j][0] * v[j][0] + v[j][1] * v[j][1]) + (v[j][2] * v[j][2] + v[j][3] * v[j][3]); }
        s = wave_sum(s, lane);
#pragma unroll
        for (int j = 0; j < 4; ++j) { *((f32x4*)(x + (size_t)m * D) + lane + 64 * j) = v[j];
            u32x2 w; w.x = pk2(v[j][0], v[j][1]); w.y = pk2(v[j][2], v[j][3]); *((u32x2*)(xb + (size_t)m * D) + lane + 64 * j) = w; }
        if (lane < 16) ss[(size_t)m * 16 + lane] = lane == 0 ? s : 0.f;
    }
    if (blockIdx.x == 0) for (int i = tid; i < 4 * D / 2; i += 512) ((unsigned*)(ws + WS_XB - 8192))[i] = 0u;
}

constexpr int M1_BG = 0, M1_CG = 17408, M1_BGT = 34816, M1_XT = 53248, M1_XST = 71680, M1_WIM = 90112, M1_SDT = 108544, M1_SCS = 109568;
constexpr int M3_XC = 0, XC_RS = 1040, M3_CG = 66560, M3_SSQS = 101376, M3_SSQL = 103424;

struct LayerPtrs {
    const float *lcw, *lcb, *ba, *bx, *apar, *lon, *scw, *scb, *dtb, *alog, *sdd, *son;
    const bf16_t *waT, *wxT;
};
__device__ __forceinline__ LayerPtrs layer_ptrs(const Params& P, int l) {
    LayerPtrs L;
    L.lcw = P.in[I_LCW] + (size_t)l * 4 * 512; L.lcb = P.in[I_LCB] + l * 512; L.ba = P.in[I_BA] + l * 512; L.bx = P.in[I_BX] + l * 512; L.apar = P.in[I_APAR] + l * 512; L.lon = P.in[I_LON] + l * 512;
    L.scw = P.in[I_SCW] + (size_t)l * 4 * 1024; L.scb = P.in[I_SCB] + l * 1024; L.dtb = P.in[I_DTB] + l * 8; L.alog = P.in[I_ALOG] + l * 8; L.sdd = P.in[I_SSD_D] + l * 8; L.son = P.in[I_SON] + l * 512;
    L.waT = (const bf16_t*)(P.ws + WS_LRUW) + (size_t)l * 8 * 4096; L.wxT = L.waT + (size_t)DEPTH * 8 * 4096;
    return L;
}

template <int CNT>
__device__ __forceinline__ void conv4_run(const bf16_t* src, size_t rowb, int tok0, float w0, float w1, float w2, float w3, float bias, bool do_silu, float (&out)[CNT]) {
    float x3 = tok0 - 3 >= 0 ? bf2f(src[(rowb + tok0 - 3) * PROJ_LD]) : 0.f, x2 = tok0 - 2 >= 0 ? bf2f(src[(rowb + tok0 - 2) * PROJ_LD]) : 0.f, x1 = tok0 - 1 >= 0 ? bf2f(src[(rowb + tok0 - 1) * PROJ_LD]) : 0.f;
#pragma unroll
    for (int i = 0; i < CNT; ++i) { const float x0 = bf2f(src[(rowb + tok0 + i) * PROJ_LD]); const float v = bias + w0 * x3 + w1 * x2 + w2 * x1 + w3 * x0; out[i] = do_silu ? siluf_(v) : v; x3 = x2; x2 = x1; x1 = x0; }
}

__device__ __forceinline__ void m1_ssd_unit(const Params& P, const LayerPtrs& L, int l, int b, int c, int g, LAS unsigned char* lds, int wave, int lane) {
    const int tid = wave * 64 + lane, fr = lane & 15, fq = lane >> 4;
    unsigned char* ws = P.ws;
    const bf16_t* proj = (const bf16_t*)(ws + WS_PROJ); const float* dtraw = (const float*)(ws + WS_DTRAW);
    float* csbuf = (float*)(ws + WS_CS); float* cdec = (float*)(ws + WS_CDEC); float* ybuf = (float*)(ws + WS_YBUF); float* states = (float*)(ws + WS_STATES);
    const size_t rowb = (size_t)b * LP; const int t0 = 64 * c;
    LAS float* SDT = (LAS float*)(lds + M1_SDT); LAS float* SCS = (LAS float*)(lds + M1_SCS);
    if (wave < 4) {
        const int head = 4 * g + wave, tok = t0 + lane; const bool ok = tok < LP;
        const float raw = ok ? dtraw[(rowb + tok) * 8 + head] : 0.f; const float dt = ok ? softplusf_(raw + L.dtb[head]) : 0.f;
        const float Ah = -__expf(L.alog[head]); float cs = dt * Ah;
#pragma unroll
        for (int o = 1; o < 64; o <<= 1) { const float v = bperm(cs, lane - o); if (lane >= o) cs += v; }
        SDT[wave * 64 + lane] = dt; SCS[wave * 64 + lane] = cs;
        if (ok) csbuf[(rowb + tok) * 8 + head] = cs;
        if (lane == 63) cdec[((size_t)b * NCH + c) * 8 + head] = __expf(cs);
    }
    {
        const int cc = tid & 255, half = tid >> 8, isC = cc >> 7, n = cc & 127, chan = 512 + 256 * isC + 128 * g + n;
        float o[32]; conv4_run<32>(proj + O_XBC + chan, rowb, t0 + 32 * half, L.scw[chan], L.scw[1024 + chan], L.scw[2048 + chan], L.scw[3072 + chan], L.scb[chan], true, o);
        LAS unsigned char* img = lds + (isC ? M1_CG : M1_BG);
#pragma unroll
        for (int i = 0; i < 32; ++i) *(LAS bf16_t*)(img + (32 * half + i) * 272 + n * 2) = (bf16_t)f2bf(o[i]);
        if (!isC) {
#pragma unroll
            for (int i = 0; i < 4; ++i) { u32x4 w; w.x = pk2(o[8 * i], o[8 * i + 1]); w.y = pk2(o[8 * i + 2], o[8 * i + 3]); w.z = pk2(o[8 * i + 4], o[8 * i + 5]); w.w = pk2(o[8 * i + 6], o[8 * i + 7]);
                *(LAS u32x4*)(lds + M1_BGT + n * 144 + (32 * half + 8 * i) * 2) = w; }
        }
        if (c == NCH - 1 && half == 0) {
#pragma unroll
            for (int k = 0; k < 3; ++k) P.out[OFF_PSC + (((size_t)l * NB + b) * 3 + k) * 1024 + chan] = bf2f(proj[(rowb + LP - 3 + k) * PROJ_LD + O_XBC + chan]);
        }
    }
    __syncthreads();
    for (int pr = 0; pr < 2; ++pr) {
        {
            const int xi = tid & 127, q = tid >> 7, hl2 = xi >> 6, p = xi & 63, hl = 2 * pr + hl2, chan = 256 * g + 64 * hl + p;
            float o[16]; conv4_run<16>(proj + O_XBC + chan, rowb, t0 + 16 * q, L.scw[chan], L.scw[1024 + chan], L.scw[2048 + chan], L.scw[3072 + chan], L.scb[chan], true, o);
            const float cl = SCS[hl * 64 + 63];
            float os[16];
#pragma unroll
            for (int i = 0; i < 16; ++i) { const int s = 16 * q + i; os[i] = o[i] * SDT[hl * 64 + s] * __expf(cl - SCS[hl * 64 + s]); }
#pragma unroll
            for (int i = 0; i < 2; ++i) { u32x4 w; w.x = pk2(o[8 * i], o[8 * i + 1]); w.y = pk2(o[8 * i + 2], o[8 * i + 3]); w.z = pk2(o[8 * i + 4], o[8 * i + 5]); w.w = pk2(o[8 * i + 6], o[8 * i + 7]);
                *(LAS u32x4*)(lds + M1_XT + hl2 * 9216 + p * 144 + (16 * q + 8 * i) * 2) = w;
                u32x4 v; v.x = pk2(os[8 * i], os[8 * i + 1]); v.y = pk2(os[8 * i + 2], os[8 * i + 3]); v.z = pk2(os[8 * i + 4], os[8 * i + 5]); v.w = pk2(os[8 * i + 6], os[8 * i + 7]);
                *(LAS u32x4*)(lds + M1_XST + hl2 * 9216 + p * 144 + (16 * q + 8 * i) * 2) = v; }
            if (c == NCH - 1 && q == 0) {
#pragma unroll
                for (int k = 0; k < 3; ++k) P.out[OFF_PSC + (((size_t)l * NB + b) * 3 + k) * 1024 + chan] = bf2f(proj[(rowb + LP - 3 + k) * PROJ_LD + O_XBC + chan]);
            }
        }
        __syncthreads();
        {
            const int hl2 = wave >> 2, tt = wave & 3, hl = 2 * pr + hl2, head = 4 * g + hl;
            LAS unsigned char* Wm = lds + M1_WIM + wave * 2304;
            const LAS unsigned char* XT = lds + M1_XT + hl2 * 9216; const LAS unsigned char* XST = lds + M1_XST + hl2 * 9216;
            const int kb0 = 16 * fq;
            const int tl = 16 * tt + fr; const float cs_t = SCS[hl * 64 + tl];
#pragma unroll
            for (int st = 0; st < 4; ++st) {
                u32x2 wpk; wpk.x = 0u; wpk.y = 0u;
                if (st <= tt) {
                    f32x4 acc = (f32x4){0.f, 0.f, 0.f, 0.f};
#pragma unroll
                    for (int ks = 0; ks < 4; ++ks) acc = mfma16(ldsfrag(lds + M1_BG, 272, 16 * st + fr, 64 * ks + kb0), ldsfrag(lds + M1_CG, 272, tl, 64 * ks + kb0), acc);
                    const f32x4 css = *(const LAS f32x4*)(SCS + hl * 64 + 16 * st + 4 * fq), dts = *(const LAS f32x4*)(SDT + hl * 64 + 16 * st + 4 * fq);
                    float w[4];
#pragma unroll
                    for (int r = 0; r < 4; ++r) { const int s = 16 * st + 4 * fq + r; w[r] = (s <= tl) ? acc[r] * __expf(cs_t - css[r]) * dts[r] : 0.f; }
                    wpk.x = pk2(w[0], w[1]); wpk.y = pk2(w[2], w[3]);
                }
                *(LAS u32x2*)(Wm + fr * 144 + (16 * st + 4 * fq) * 2) = wpk;
            }
            LDS_WAIT();
            const int tok = t0 + tl; const float Dh = L.sdd[head];
#pragma unroll
            for (int pt = 0; pt < 4; ++pt) {
                f32x4 acc = (f32x4){0.f, 0.f, 0.f, 0.f};
#pragma unroll
                for (int ks = 0; ks < 2; ++ks) acc = mfma16(ldsfrag(XT, 144, 16 * pt + fr, 64 * ks + kb0), ldsfrag(Wm, 144, fr, 64 * ks + kb0), acc);
#pragma unroll
                for (int r = 0; r < 4; ++r) acc[r] += Dh * bf2f(*(const LAS bf16_t*)(XT + (16 * pt + 4 * fq + r) * 144 + tl * 2));
                if (tok < LP) *(f32x4*)(ybuf + (rowb + tok) * 512 + head * 64 + 16 * pt + 4 * fq) = acc;
            }
            float* sdst = states + (((size_t)b * NCH + c) * 8 + head) * 8192;
#pragma unroll
            for (int n2 = 0; n2 < 2; ++n2) { const int nt = 2 * tt + n2;
#pragma unroll
                for (int pt = 0; pt < 4; ++pt) {
                    f32x4 acc = (f32x4){0.f, 0.f, 0.f, 0.f};
#pragma unroll
                    for (int ks = 0; ks < 2; ++ks) acc = mfma16(ldsfrag(lds + M1_BGT, 144, 16 * nt + fr, 64 * ks + kb0), ldsfrag(XST, 144, 16 * pt + fr, 64 * ks + kb0), acc);
                    *(f32x4*)(sdst + (16 * pt + fr) * 128 + 16 * nt + 4 * fq) = acc;
                } }
        }
        __syncthreads();
    }
}

__device__ __forceinline__ void m1_sample_ssd_unit(const Params& P, const LayerPtrs& L, int l, int sq, LAS unsigned char* lds, int wave, int lane) {
    unsigned char* ws = P.ws;
    const bf16_t* proj = (const bf16_t*)(ws + WS_PROJ); const float* dtraw = (const float*)(ws + WS_DTRAW); float* ybuf = (float*)(ws + WS_YBUF);
    const int head = wave, g = head >> 2; const size_t row0 = (size_t)MP + (size_t)sq * 4;
    LAS float* SX = (LAS float*)(lds + wave * 5120); LAS float* SB = SX + 256; LAS float* SC = SX + 768;
    const float* stc = P.in[I_SSC] + ((size_t)l * NS + sq) * 3 * 1024;
#pragma unroll 1
    for (int slot = 0; slot < 5; ++slot) {
        const int chan = slot == 0 ? head * 64 + lane : (slot < 3 ? 512 + g * 128 + lane + 64 * (slot - 1) : 768 + g * 128 + lane + 64 * (slot - 3));
        const float w0 = L.scw[chan], w1 = L.scw[1024 + chan], w2 = L.scw[2048 + chan], w3 = L.scw[3072 + chan], bs = L.scb[chan];
        const float s0 = stc[chan], s1 = stc[1024 + chan], s2 = stc[2048 + chan];
        float xr[4];
#pragma unroll
        for (int t = 0; t < 4; ++t) xr[t] = bf2f(proj[(row0 + t) * PROJ_LD + O_XBC + chan]);
        float y[4];
        y[0] = siluf_(bs + w0 * s0 + w1 * s1 + w2 * s2 + w3 * xr[0]); y[1] = siluf_(bs + w0 * s1 + w1 * s2 + w2 * xr[0] + w3 * xr[1]);
        y[2] = siluf_(bs + w0 * s2 + w1 * xr[0] + w2 * xr[1] + w3 * xr[2]); y[3] = siluf_(bs + w0 * xr[0] + w1 * xr[1] + w2 * xr[2] + w3 * xr[3]);
        LAS float* dst = slot == 0 ? SX + lane : (slot < 3 ? SB + lane + 64 * (slot - 1) : SC + lane + 64 * (slot - 3));
        const int rs = slot == 0 ? 64 : 128;
#pragma unroll
        for (int t = 0; t < 4; ++t) dst[t * rs] = y[t];
        if (slot == 0 || (head & 3) == 0) {
#pragma unroll
            for (int k = 0; k < 3; ++k) P.out[OFF_SSC + (((size_t)l * NS + sq) * 3 + k) * 1024 + chan] = xr[k + 1];
        }
    }
    const float dtb_h = L.dtb[head];
    const float Ah = -__expf(L.alog[head]), Dh = L.sdd[head];
    LDS_WAIT(); asm volatile("" ::: "memory");
    const int p8 = lane >> 3, nq = lane & 7;
    const float* sin_ = P.in[I_SSS] + (((size_t)l * NS + sq) * 8 + head) * 8192;
    float* sout = P.out + OFF_SSS + (((size_t)l * NS + sq) * 8 + head) * 8192;
#pragma unroll 1
    for (int hf = 0; hf < 2; ++hf) {
        f32x4 S[4][4];
#pragma unroll
        for (int pg = 0; pg < 4; ++pg)
#pragma unroll
            for (int k = 0; k < 4; ++k) S[pg][k] = *(const f32x4*)(sin_ + (8 * (4 * hf + pg) + p8) * 128 + 16 * nq + 4 * k);
#pragma unroll 1
        for (int t = 0; t < 4; ++t) {
            const float dtv_t = softplusf_(dtraw[(row0 + t) * 8 + head] + dtb_h);
            const float dec = __expf(dtv_t * Ah);
            f32x4 Bv[4], Cv[4];
#pragma unroll
            for (int k = 0; k < 4; ++k) { Bv[k] = *(const LAS f32x4*)(SB + t * 128 + 16 * nq + 4 * k); Cv[k] = *(const LAS f32x4*)(SC + t * 128 + 16 * nq + 4 * k); }
#pragma unroll
            for (int pg = 0; pg < 4; ++pg) {
                const int p = 8 * (4 * hf + pg) + p8; const float xv = SX[t * 64 + p]; const float xp = xv * dtv_t;
                float ys = 0.f;
#pragma unroll
                for (int k = 0; k < 4; ++k) { S[pg][k] = S[pg][k] * dec + Bv[k] * xp; const f32x4 pc = S[pg][k] * Cv[k]; ys += (pc[0] + pc[1]) + (pc[2] + pc[3]); }
                ys += bperm(ys, lane ^ 1); ys += bperm(ys, lane ^ 2); ys += bperm(ys, lane ^ 4);
                if (nq == 0) ybuf[(row0 + t) * 512 + head * 64 + p] = ys + Dh * xv;
            }
        }
#pragma unroll
        for (int pg = 0; pg < 4; ++pg)
#pragma unroll
            for (int k = 0; k < 4; ++k) *(f32x4*)(sout + (8 * (4 * hf + pg) + p8) * 128 + 16 * nq + 4 * k) = S[pg][k];
    }
    LDS_WAIT(); asm volatile("" ::: "memory");
}

template <bool SAMPLE, bool WRITE_STATE>
__device__ __forceinline__ void lru_build_xc(const Params& P, const LayerPtrs& L, int l, int b, int c, int u, LAS unsigned char* lds, const int ci) {
    const bf16_t* proj = (const bf16_t*)(P.ws + WS_PROJ);
    const float w0 = L.lcw[ci], w1 = L.lcw[512 + ci], w2 = L.lcw[1024 + ci], w3 = L.lcw[1536 + ci], bs = L.lcb[ci];
    if constexpr (!SAMPLE) {
        const size_t rowb = (size_t)b * LP; const int t0 = 64 * c;
#pragma unroll
        for (int h = 0; h < 2; ++h) { float o[32]; conv4_run<32>(proj + O_LX + ci, rowb, t0 + 32 * h, w0, w1, w2, w3, bs, false, o);
#pragma unroll
            for (int i = 0; i < 32; ++i) *(LAS bf16_t*)(lds + M3_XC + (32 * h + i) * XC_RS + ci * 2) = (bf16_t)f2bf(o[i]); }
        if (WRITE_STATE && c == NCH - 1) {
#pragma unroll
            for (int k = 0; k < 3; ++k) P.out[OFF_PLC + (((size_t)l * NB + b) * 3 + k) * 512 + ci] = bf2f(proj[(rowb + LP - 3 + k) * PROJ_LD + O_LX + ci]);
        }
    } else {
#pragma unroll 4
        for (int s = 0; s < 16; ++s) { const int sq = 16 * u + s; const size_t row0 = (size_t)MP + (size_t)sq * 4;
            const float* stc = P.in[I_SLC] + ((size_t)l * NS + sq) * 3 * 512; const float s0 = stc[ci], s1 = stc[512 + ci], s2 = stc[1024 + ci];
            float xr[4];
#pragma unroll
            for (int t = 0; t < 4; ++t) xr[t] = bf2f(proj[(row0 + t) * PROJ_LD + O_LX + ci]);
            float y[4];
            y[0] = bs + w0 * s0 + w1 * s1 + w2 * s2 + w3 * xr[0]; y[1] = bs + w0 * s1 + w1 * s2 + w2 * xr[0] + w3 * xr[1];
            y[2] = bs + w0 * s2 + w1 * xr[0] + w2 * xr[1] + w3 * xr[2]; y[3] = bs + w0 * xr[0] + w1 * xr[1] + w2 * xr[2] + w3 * xr[3];
#pragma unroll
            for (int t = 0; t < 4; ++t) *(LAS bf16_t*)(lds + M3_XC + (4 * s + t) * XC_RS + ci * 2) = (bf16_t)f2bf(y[t]);
            if (WRITE_STATE) {
#pragma unroll
                for (int k = 0; k < 3; ++k) P.out[OFF_SLC + (((size_t)l * NS + sq) * 3 + k) * 512 + ci] = xr[k + 1];
            } }
    }
}

template <bool PASSB, bool SAMPLE>
__device__ __forceinline__ void lru_wave(const Params& P, const LayerPtrs& L, int l, int b, int c, int u, int len, LAS unsigned char* lds, int wave, int lane, float* gscr, float (&sq)[4][4]) {
    const int fr = lane & 15, fq = lane >> 4, h = wave; unsigned char* ws = P.ws;
    const bf16_t* proj = (const bf16_t*)(ws + WS_PROJ);
    float* lruA = (float*)(ws + WS_LRUA); float* lruH = (float*)(ws + WS_LRUH); const float* lruHin = (const float*)(ws + WS_LRUHIN);
    const size_t rowbase = SAMPLE ? (size_t)MP + 64 * (size_t)u : (size_t)b * LP + 64 * (size_t)c;
#pragma unroll 1
    for (int jt = 0; jt < 4; ++jt) {
        const int ch = 64 * h + 16 * jt + fr;
        bf16x8 qa[2], qx[2];
#pragma unroll
        for (int ks = 0; ks < 2; ++ks) { qa[ks] = *(const bf16x8*)(L.waT + ((size_t)(h * 64 + 16 * jt + fr) * 64 + 32 * ks + 8 * fq)); qx[ks] = *(const bf16x8*)(L.wxT + ((size_t)(h * 64 + 16 * jt + fr) * 64 + 32 * ks + 8 * fq)); }
        f32x4 ar[4], ai[4];
#pragma unroll
        for (int tt = 0; tt < 4; ++tt) { ar[tt] = (f32x4){0.f, 0.f, 0.f, 0.f}; ai[tt] = (f32x4){0.f, 0.f, 0.f, 0.f};
#pragma unroll
            for (int ks = 0; ks < 2; ++ks) { const bf16x8 pf = ldsfrag(lds + M3_XC, XC_RS, 16 * tt + fr, (64 * h + 32 * ks + 8 * fq) * 2); ar[tt] = mfma16(pf, qa[ks], ar[tt]); ai[tt] = mfma16(pf, qx[ks], ai[tt]); } }
        const float bav = L.ba[ch], bxv = L.bx[ch], sp = softplusf_(-L.apar[ch]);
        float av[4][4], bv[4][4], A4[4], B4[4];
#pragma unroll
        for (int tt = 0; tt < 4; ++tt) {
#pragma unroll
            for (int r = 0; r < 4; ++r) { const int t = 16 * tt + 4 * fq + r;
                const float rg = sigmoidf_(ar[tt][r] + bav), ig = sigmoidf_(ai[tt][r] + bxv); const float la = -8.0f * rg * sp; float a_ = __expf(la);
                const float mult = sqrtf(fmaxf(-expm1f(2.0f * la), 0.f)); const float xc = bf2f(*(const LAS bf16_t*)(lds + M3_XC + t * XC_RS + ch * 2)); float bb = mult * ig * xc;
                if (t >= len) { a_ = 1.f; bb = 0.f; }
                av[tt][r] = a_; bv[tt][r] = bb; }
            float A = av[tt][0], B = bv[tt][0];
#pragma unroll
            for (int r = 1; r < 4; ++r) { B = av[tt][r] * B + bv[tt][r]; A *= av[tt][r]; }
            A4[tt] = A; B4[tt] = B; }
        float cin[4];
        if constexpr (!SAMPLE) {
            float stv = PASSB ? lruHin[((size_t)b * NCH + c) * 512 + ch] : 0.f, prd = 1.f;
#pragma unroll
            for (int tt = 0; tt < 4; ++tt)
#pragma unroll
                for (int q = 0; q < 4; ++q) { const float Aq = bperm(A4[tt], fr + 16 * q), Bq = bperm(B4[tt], fr + 16 * q); if (q == fq) cin[tt] = stv; stv = Aq * stv + Bq; prd *= Aq; }
            if (!PASSB && fq == 0) { lruA[((size_t)b * NCH + c) * 512 + ch] = prd; lruH[((size_t)b * NCH + c) * 512 + ch] = stv; }
        } else {
#pragma unroll
            for (int tt = 0; tt < 4; ++tt) cin[tt] = P.in[I_SLH][((size_t)l * NS + 16 * u + 4 * tt + fq) * 512 + ch];
        }
        if constexpr (PASSB) {
#pragma unroll
            for (int tt = 0; tt < 4; ++tt) { float s = cin[tt];
#pragma unroll
                for (int r = 0; r < 4; ++r) { const int t = 16 * tt + 4 * fq + r; s = av[tt][r] * s + bv[tt][r];
                    const float gt = bf2f(proj[(rowbase + t) * PROJ_LD + O_LG + ch]); const float gv = s * gelu_tanh(gt); sq[tt][r] += gv * gv; gscr[t * 1024 + ch] = gv; }
                if (SAMPLE) P.out[OFF_SLH + ((size_t)l * NS + 16 * u + 4 * tt + fq) * 512 + ch] = s; }
        }
    }
}

__device__ __forceinline__ void m1_lru_unit(const Params& P, const LayerPtrs& L, int l, int b, int c, LAS unsigned char* lds, int wave, int lane) {
    lru_build_xc<false, false>(P, L, l, b, c, 0, lds, wave * 64 + lane);
    __syncthreads();
    float dummy[4][4];
    const int len = (LP - 64 * c) < 64 ? (LP - 64 * c) : 64;
    lru_wave<false, false>(P, L, l, b, c, 0, len, lds, wave, lane, nullptr, dummy);
    __syncthreads();
}

template <bool SAMPLE>
__device__ __forceinline__ void m3_unit(const Params& P, const LayerPtrs& L, int l, int b, int c, int u, LAS unsigned char* lds, int wave, int lane) {
    const int tid = wave * 64 + lane, fr = lane & 15, fq = lane >> 4, h = wave; unsigned char* ws = P.ws;
    const bf16_t* proj = (const bf16_t*)(ws + WS_PROJ); const float* csbuf = (const float*)(ws + WS_CS); const float* ybuf = (const float*)(ws + WS_YBUF);
    const float* states = (const float*)(ws + WS_STATES); bf16_t* mixed = (bf16_t*)(ws + WS_MIXED);
    const size_t rowbase = SAMPLE ? (size_t)MP + 64 * (size_t)u : (size_t)b * LP + 64 * (size_t)c;
    const int len = SAMPLE ? 64 : ((LP - 64 * c) < 64 ? (LP - 64 * c) : 64);
    lru_build_xc<SAMPLE, true>(P, L, l, b, c, u, lds, tid);
    if constexpr (!SAMPLE) {
        const int cc = tid & 255, half = tid >> 8, chan = 768 + cc; const size_t rowb = (size_t)b * LP;
        float o[32]; conv4_run<32>(proj + O_XBC + chan, rowb, 64 * c + 32 * half, L.scw[chan], L.scw[1024 + chan], L.scw[2048 + chan], L.scw[3072 + chan], L.scb[chan], true, o);
#pragma unroll
        for (int i = 0; i < 32; ++i) *(LAS bf16_t*)(lds + M3_CG + (cc >> 7) * 17408 + (32 * half + i) * 272 + (cc & 127) * 2) = (bf16_t)f2bf(o[i]);
    }
    __syncthreads();
    LAS float* SSQS = (LAS float*)(lds + M3_SSQS); LAS float* SSQL = (LAS float*)(lds + M3_SSQL);
    float* gscr = (float*)(ws + WS_GSCR) + (size_t)blockIdx.x * 65536;
    {
        float sq[4][4];
#pragma unroll
        for (int tt = 0; tt < 4; ++tt)
#pragma unroll
            for (int r = 0; r < 4; ++r) sq[tt][r] = 0.f;
        lru_wave<true, SAMPLE>(P, L, l, b, c, u, len, lds, wave, lane, gscr, sq);
#pragma unroll
        for (int tt = 0; tt < 4; ++tt)
#pragma unroll
            for (int r = 0; r < 4; ++r) { float v = sq[tt][r];
                v += bperm(v, lane ^ 1); v += bperm(v, lane ^ 2); v += bperm(v, lane ^ 4); v += bperm(v, lane ^ 8);
                if (fr == 0) SSQL[h * 64 + 16 * tt + 4 * fq + r] = v; }
    }
    {
        bf16x8 pfr[4][4];
        if constexpr (!SAMPLE) {
            const float* hp = states + (((size_t)b * NCH + c) * 8 + h) * 8192;
#pragma unroll
            for (int pt = 0; pt < 4; ++pt)
#pragma unroll
                for (int ks = 0; ks < 4; ++ks) { const float* src = hp + (16 * pt + fr) * 128 + 32 * ks + 8 * fq; const f32x4 lo = *(const f32x4*)src, hi = *(const f32x4*)(src + 4);
                    u32x4 pk; pk.x = pk2(lo[0], lo[1]); pk.y = pk2(lo[2], lo[3]); pk.z = pk2(hi[0], hi[1]); pk.w = pk2(hi[2], hi[3]);
                    pfr[pt][ks] = __builtin_bit_cast(bf16x8, pk); }
        }
        const LAS unsigned char* CG = lds + M3_CG + (h >> 2) * 17408;
#pragma unroll 1
        for (int tt = 0; tt < 4; ++tt) {
            f32x4 acc[4];
#pragma unroll
            for (int pt = 0; pt < 4; ++pt) acc[pt] = (f32x4){0.f, 0.f, 0.f, 0.f};
            if constexpr (!SAMPLE) {
#pragma unroll
                for (int ks = 0; ks < 4; ++ks) { const bf16x8 cf = ldsfrag(CG, 272, 16 * tt + fr, 64 * ks + 16 * fq);
#pragma unroll
                    for (int pt = 0; pt < 4; ++pt) acc[pt] = mfma16(pfr[pt][ks], cf, acc[pt]); }
            }
            const int t = 16 * tt + fr; const size_t row = rowbase + t; const float e = SAMPLE ? 0.f : __expf(csbuf[row * 8 + h]);
            float sq = 0.f;
#pragma unroll
            for (int pt = 0; pt < 4; ++pt) {
                const f32x4 yb = *(const f32x4*)(ybuf + row * 512 + h * 64 + 16 * pt + 4 * fq);
                const u32x2 zz = *(const u32x2*)(proj + row * PROJ_LD + O_Z + h * 64 + 16 * pt + 4 * fq);
                const float z0 = bf2f(zz.x & 0xffffu), z1 = bf2f(zz.x >> 16), z2 = bf2f(zz.y & 0xffffu), z3 = bf2f(zz.y >> 16);
                f32x4 y = yb + acc[pt] * e;
                y[0] *= siluf_(z0); y[1] *= siluf_(z1); y[2] *= siluf_(z2); y[3] *= siluf_(z3);
                sq += (y[0] * y[0] + y[1] * y[1]) + (y[2] * y[2] + y[3] * y[3]);
                *(f32x4*)(gscr + t * 1024 + 512 + h * 64 + 16 * pt + 4 * fq) = y;
            }
            sq += bperm(sq, lane ^ 16); sq += bperm(sq, lane ^ 32);
            if (fq == 0) SSQS[h * 64 + t] = sq;
        }
    }
    VM_WAIT(); LDS_WAIT();
    __syncthreads();
    LAS float* RSTD = (LAS float*)(lds + M3_XC);
    if (tid < 128) { const int which = tid >> 6, t = tid & 63; const LAS float* src = which ? SSQS : SSQL; float sm = 0.f;
#pragma unroll
        for (int w = 0; w < 8; ++w) sm += src[w * 64 + t];
        RSTD[which * 64 + t] = rsqrtf(sm * (1.0f / 512.0f) + EPS); }
    __syncthreads();
#pragma unroll 4
    for (int i = 0; i < 16; ++i) {
        const int seg = tid + 512 * i, row = seg >> 7, c8 = (seg & 127) * 8;
        if (row < len) {
            const float rs = RSTD[(c8 >> 9) * 64 + row]; const float* gp = (c8 < 512 ? L.lon + c8 : L.son + (c8 - 512));
            const f32x4 a0 = *(const f32x4*)(gscr + row * 1024 + c8), a1 = *(const f32x4*)(gscr + row * 1024 + c8 + 4), g0 = *(const f32x4*)gp, g1 = *(const f32x4*)(gp + 4);
            const f32x4 o0 = a0 * rs * g0, o1 = a1 * rs * g1;
            u32x4 w; w.x = pk2(o0[0], o0[1]); w.y = pk2(o0[2], o0[3]); w.z = pk2(o1[0], o1[1]); w.w = pk2(o1[2], o1[3]);
            *(u32x4*)(mixed + (rowbase + row) * D + c8) = w;
        }
    }
    __syncthreads();
}

__device__ __forceinline__ void m2_phase(const Params& P, int l, const int tid) {
    unsigned char* ws = P.ws; float* states = (float*)(ws + WS_STATES); const float* cdec = (const float*)(ws + WS_CDEC);
    for (int e4 = blockIdx.x * 512 + tid; e4 < NB * 8 * 2048; e4 += gridDim.x * 512) {
        const int bh = e4 >> 11, off = (e4 & 2047) * 4, b = bh >> 3, h = bh & 7;
        f32x4 run = (f32x4){0.f, 0.f, 0.f, 0.f};
#pragma unroll 3
        for (int c = 0; c < NCH; ++c) { float* p = states + (((size_t)b * NCH + c) * 8 + h) * 8192 + off; const f32x4 sc = *(const f32x4*)p; *(f32x4*)p = run; const float d = cdec[((size_t)b * NCH + c) * 8 + h]; run = run * d + sc; }
        *(f32x4*)(P.out + OFF_PSS + (((size_t)l * NB + b) * 8 + h) * 8192 + off) = run;
    }
    const float* lruA = (const float*)(ws + WS_LRUA); const float* lruH = (const float*)(ws + WS_LRUH); float* lruHin = (float*)(ws + WS_LRUHIN);
    for (int i = blockIdx.x * 512 + tid; i < NB * 512; i += gridDim.x * 512) {
        const int b = i >> 9, ch = i & 511; float hv = 0.f;
        for (int c = 0; c < NCH; ++c) { const size_t o = ((size_t)b * NCH + c) * 512 + ch; lruHin[o] = hv; hv = lruA[o] * hv + lruH[o]; }
        P.out[OFF_PLH + ((size_t)l * NB + b) * 512 + ch] = hv;
    }
}

__device__ __forceinline__ void final_phase(const Params& P, int wave, int lane) {
    const float* x = (const float*)(P.ws + WS_X); const float* gn = P.in[I_NFIN];
    const int gw = blockIdx.x * 8 + wave, NGW = gridDim.x * 8;
    for (int m = gw; m < MT; m += NGW) {
        float* dst;
        if (m < MP) { const int b = m / LP, t = m % LP; if (t < NMETA) continue; dst = P.out + OFF_YP + ((size_t)b * SEQ + (t - NMETA)) * D; }
        else dst = P.out + OFF_YS + (size_t)(m - MP) * D;
        f32x4 v[4]; float s = 0.f;
#pragma unroll
        for (int j = 0; j < 4; ++j) { v[j] = *((const f32x4*)(x + (size_t)m * D) + lane + 64 * j); s += (v[j][0] * v[j][0] + v[j][1] * v[j][1]) + (v[j][2] * v[j][2] + v[j][3] * v[j][3]); }
        const float rs = rsqrtf(wave_sum(s, lane) * (1.0f / 1024.0f) + EPS);
#pragma unroll
        for (int j = 0; j < 4; ++j) { const f32x4 g4 = *((const f32x4*)gn + lane + 64 * j); *((f32x4*)dst + lane + 64 * j) = v[j] * rs * g4; }
    }
}

#ifndef PH_MASK
#define PH_MASK 0xFFF
#endif
__global__ void __launch_bounds__(512, 2) hymba_fwd(Params P) {
    extern __shared__ __attribute__((aligned(16))) unsigned char lds_raw[];
    LAS unsigned char* lds = (LAS unsigned char*)lds_raw;
    int wave0 = __builtin_amdgcn_readfirstlane((int)threadIdx.x >> 6);
    asm volatile("" : "+s"(wave0));
#define MYTID() (wave0 * 64 + (int)__builtin_amdgcn_mbcnt_hi(~0u, __builtin_amdgcn_mbcnt_lo(~0u, 0u)))
    const int G = gridDim.x;
    { const int tid = MYTID(); for (int i = tid; i < (LDS_BYTES - LDS_MISC) / 4; i += 512) ((LAS unsigned*)(lds + LDS_MISC))[i] = 0u; }
    __syncthreads();
    { unsigned char* w_ = P.ws; asm volatile("" : "+s"(w_)); w_ = glob(w_); (void)xcd_barrier_post((unsigned*)(w_ + WS_CTL) + 4096, (volatile LAS unsigned*)(lds + LDS_MISC) + 8, MYTID()); }
#define GRID_BAR() do { unsigned char* w_ = P.ws; asm volatile("" : "+s"(w_)); w_ = glob(w_); XcdBarrier b_; b_.bar = (unsigned*)(w_ + WS_CTL) + 4096; b_.x = xb_xcc_id(); b_.st = (volatile LAS unsigned*)(lds + LDS_MISC) + 8; \
        int t_ = MYTID(); asm volatile("" : "+v"(t_)); xcd_barrier(b_, t_); } while (0)
#define PHASE_ENV() Params Q = P; asm volatile("" : "+s"(Q.ws), "+s"(Q.out)); Q.ws = glob(Q.ws); Q.out = glob(Q.out); _Pragma("unroll") for (int i_ = 0; i_ < 31; ++i_) Q.in[i_] = glob(Q.in[i_]); unsigned char* ws = Q.ws; (void)ws; int ptid = MYTID(); asm volatile("" : "+v"(ptid)); const int lane = ptid & 63, wave = __builtin_amdgcn_readfirstlane(ptid >> 6); (void)lane; (void)wave

    if (PH_MASK & 1) { PHASE_ENV(); p0_prologue(Q, lds, wave, lane, ptid); }
    { cg::grid_group grid = cg::this_grid(); grid.sync(); }
    GRID_BAR();

#pragma unroll 1
    for (int l = 0; l < DEPTH; ++l) {
        if (PH_MASK & 2) {
            PHASE_ENV();
            pg8::Gemm g{(const bf16_t*)(ws + WS_XB), (const bf16_t*)(ws + WS_W + (size_t)l * W_LAYER + W_IN), D, 67, 11, (long)256 * D * 2, (long)128 * D * 2, 0};
            pg8::StaticOrder S; S.init(67, 11, G, (int)blockIdx.x);
            pg8::EpiIn E{(bf16_t*)(ws + WS_PROJ), (float*)(ws + WS_DTRAW), (const float*)(ws + WS_SS) + (size_t)(2 * l) * MPAD * 16};
            pg8::gemm_phase<pg8::EpiIn, pg8::StaticOrder, true, true>(lds, g, S, E, ptid);
        }
        GRID_BAR();
        {
            PHASE_ENV();
            const LayerPtrs L = layer_ptrs(Q, l);
            constexpr int N_SSD = NB * NCH * 2, N_LRU = NB * NCH, N_SMP = NS;
            for (int it = blockIdx.x; it < N_SSD + N_LRU + N_SMP; it += G) {
                if (it < N_SSD) { if (PH_MASK & 4) { const int b = it / (NCH * 2), r = it % (NCH * 2); m1_ssd_unit(Q, L, l, b, r >> 1, r & 1, lds, wave, lane); } }
                else if (it < N_SSD + N_LRU) { const int r = it - N_SSD; if (PH_MASK & 8) m1_lru_unit(Q, L, l, r / NCH, r % NCH, lds, wave, lane); }
                else { if (PH_MASK & 16) m1_sample_ssd_unit(Q, L, l, it - N_SSD - N_LRU, lds, wave, lane); __syncthreads(); }
            }
        }
        GRID_BAR();
        if (PH_MASK & 32) { PHASE_ENV(); m2_phase(Q, l, ptid); }
        GRID_BAR();
        {
            PHASE_ENV();
            const LayerPtrs L = layer_ptrs(Q, l);
            constexpr int N_PR = NB * NCH, N_SM = MS / 64;
            for (int it = blockIdx.x; it < N_PR + N_SM; it += G) {
                if (it < N_PR) { if (PH_MASK & 64) m3_unit<false>(Q, L, l, it / NCH, it % NCH, 0, lds, wave, lane); }
                else if (PH_MASK & 128) m3_unit<true>(Q, L, l, 0, 0, it - N_PR, lds, wave, lane);
            }
        }
        GRID_BAR();
        if (PH_MASK & 256) {
            PHASE_ENV();
            pg8::Gemm g{(const bf16_t*)(ws + WS_MIXED), (const bf16_t*)(ws + WS_W + (size_t)l * W_LAYER + W_OUT), D, 67, 4, (long)256 * D * 2, (long)128 * D * 2, 0};
            pg8::StaticOrder S; S.init(67, 4, G, (int)blockIdx.x);
            pg8::EpiRes E{(float*)(ws + WS_X), (bf16_t*)(ws + WS_XB), (float*)(ws + WS_SS) + (size_t)(2 * l + 1) * MPAD * 16};
            pg8::gemm_phase<pg8::EpiRes, pg8::StaticOrder, true, true>(lds, g, S, E, ptid);
        }
        GRID_BAR();
        if (PH_MASK & 512) {
            PHASE_ENV();
            pg8::Gemm g{(const bf16_t*)(ws + WS_XB) - 2 * D, (const bf16_t*)(ws + WS_W + (size_t)l * W_LAYER + W_UP), D, 69, 24, (long)248 * D * 2, (long)124 * D * 2, 1};
            pg8::StaticOrder S; S.init(69, 24, G, (int)blockIdx.x);
            pg8::EpiUp E{(bf16_t*)(ws + WS_ABUF), (const float*)(ws + WS_SS) + (size_t)(2 * l + 1) * MPAD * 16, Q.in[I_FCW] + (size_t)l * 3 * 6144, Q.in[I_FCB] + (size_t)l * 6144, Q.in[I_SFC] + (size_t)l * NS * 2 * 6144,
                         Q.out + OFF_PFC + (size_t)l * NB * 2 * 6144, Q.out + OFF_SFC + (size_t)l * NS * 2 * 6144};
            pg8::gemm_phase<pg8::EpiUp, pg8::StaticOrder, true, true>(lds, g, S, E, ptid);
        }
        GRID_BAR();
        if (PH_MASK & 1024) {
            PHASE_ENV();
            pg8::Gemm g{(const bf16_t*)(ws + WS_ABUF), (const bf16_t*)(ws + WS_W + (size_t)l * W_LAYER + W_DOWN), DFF, 67, 4, (long)256 * DFF * 2, (long)128 * DFF * 2, 0};
            pg8::StaticOrder S; S.init(67, 4, G, (int)blockIdx.x);
            pg8::EpiRes E{(float*)(ws + WS_X), (bf16_t*)(ws + WS_XB), (float*)(ws + WS_SS) + (size_t)(2 * l + 2) * MPAD * 16};
            pg8::gemm_phase<pg8::EpiRes, pg8::StaticOrder, true, true>(lds, g, S, E, ptid);
        }
        GRID_BAR();
    }
    if (PH_MASK & 2048) { PHASE_ENV(); final_phase(Q, wave, lane); }
}

extern "C" void kernel_launch(void* const* d_in, const int* in_sizes, int n_in, void* d_out, int out_size, void* d_ws, size_t ws_size, hipStream_t stream) {
    static int grid = 0;
    if (grid == 0) {
        if (n_in != 31 || (size_t)out_size != OUT_TOTAL || ws_size < WS_END) { fprintf(stderr, "kernel_launch: unexpected problem (n_in %d, out %d, ws %zu)\n", n_in, out_size, ws_size); grid = -1; return; }
        int dev = 0, cus = 0, per_cu = 0;
        if (hipGetDevice(&dev) != hipSuccess || hipDeviceGetAttribute(&cus, hipDeviceAttributeMultiprocessorCount, dev) != hipSuccess) { grid = -1; return; }
        if (hipFuncSetAttribute((const void*)hymba_fwd, hipFuncAttributeMaxDynamicSharedMemorySize, LDS_BYTES) != hipSuccess) { fprintf(stderr, "kernel_launch: hipFuncSetAttribute failed\n"); grid = -1; return; }
        if (hipOccupancyMaxActiveBlocksPerMultiprocessor(&per_cu, (const void*)hymba_fwd, 512, LDS_BYTES) != hipSuccess || per_cu < 1) { fprintf(stderr, "kernel_launch: occupancy query says %d\n", per_cu); per_cu = 1; }
        (void)hipGetLastError();
        grid = cus * (per_cu > 1 ? 1 : per_cu);
    }
    if (grid < 0) return;
    (void)hipMemsetAsync((char*)d_ws + WS_CTL, 0, CTL_BYTES, stream);
    Params p{};
    for (int i = 0; i < 31; ++i) p.in[i] = (const float*)d_in[i];
    p.out = (float*)d_out; p.ws = (unsigned char*)d_ws;
    void* args[] = {&p};
    hipError_t e = hipLaunchCooperativeKernel((const void*)hymba_fwd, dim3(grid), dim3(512), args, LDS_BYTES, stream);
    if (e != hipSuccess) fprintf(stderr, "kernel_launch: cooperative launch failed: %s (grid %d)\n", hipGetErrorString(e), grid);
}
```

```cpp
#include <hip/hip_runtime.h>
#include <hip/hip_cooperative_groups.h>
#include <cstdio>
#include <cstdint>
namespace cg = cooperative_groups;
#ifndef PH_MASK
#define PH_MASK 0xFFF
#endif
#ifndef REP_MASK
#define REP_MASK 0
#endif

#define LAS __attribute__((address_space(3)))
#define GAS __attribute__((address_space(1)))
template <class T> __device__ __forceinline__ T* glob(T* p) { return (T*)(GAS T*)p; }
typedef unsigned short bf16_t;
typedef short bf16x8 __attribute__((ext_vector_type(8)));
typedef float f32x4 __attribute__((ext_vector_type(4)));
typedef float f32x2 __attribute__((ext_vector_type(2)));
typedef unsigned u32x4 __attribute__((ext_vector_type(4)));
typedef unsigned u32x2 __attribute__((ext_vector_type(2)));

constexpr int D = 1024, DEPTH = 4, NB = 8, SEQ = 2048, NMETA = 16, LP = SEQ + NMETA, NS = 128, LS = 4;
constexpr int MP = NB * LP, MS = NS * LS, MT = MP + MS, MPAD = 17152;
constexpr int NH = 8, HD = 64, SST = 128, DFF = 3072, PIN = 2568, PINPAD = 2816;
constexpr int O_LX = 0, O_LG = 512, O_Z = 1024, O_XBC = 1536, PROJ_LD = 2560;
constexpr int NCH = 33;
constexpr float EPS = 1e-6f;

constexpr size_t OFF_YP = 0, OFF_YS = OFF_YP + (size_t)NB * SEQ * D, OFF_PLC = OFF_YS + (size_t)MS * D, OFF_PLH = OFF_PLC + (size_t)DEPTH * NB * 3 * 512,
                 OFF_PSC = OFF_PLH + (size_t)DEPTH * NB * 512, OFF_PSS = OFF_PSC + (size_t)DEPTH * NB * 3 * 1024, OFF_PFC = OFF_PSS + (size_t)DEPTH * NB * 8 * 8192,
                 OFF_SLC = OFF_PFC + (size_t)DEPTH * NB * 2 * 6144, OFF_SLH = OFF_SLC + (size_t)DEPTH * NS * 3 * 512, OFF_SSC = OFF_SLH + (size_t)DEPTH * NS * 512,
                 OFF_SSS = OFF_SSC + (size_t)DEPTH * NS * 3 * 1024, OFF_SFC = OFF_SSS + (size_t)DEPTH * NS * 8 * 8192, OUT_TOTAL = OFF_SFC + (size_t)DEPTH * NS * 2 * 6144;

constexpr size_t MiB = 1u << 20;
constexpr size_t WS_CTL = 0, CTL_BYTES = 1 * MiB;
constexpr size_t WS_SS = 494 * MiB;
constexpr size_t WS_LRUW = 2 * MiB;
constexpr size_t WS_DTRAW = 3 * MiB, WS_CS = 4 * MiB, WS_CDEC = 5 * MiB, WS_LRUA = 6 * MiB, WS_LRUH = 7 * MiB, WS_LRUHIN = 8 * MiB;
constexpr size_t WS_W = 9 * MiB;
constexpr size_t W_LAYER = 25 * MiB + MiB / 2, W_IN = 0, W_OUT = 5 * MiB + MiB / 2, W_UP = 7 * MiB + MiB / 2, W_DOWN = 19 * MiB + MiB / 2;
constexpr size_t WS_X = 111 * MiB;
constexpr size_t WS_XB = 178 * MiB + 8192;
constexpr size_t WS_PROJ = 212 * MiB;
constexpr size_t WS_YBUF = 296 * MiB;
constexpr size_t WS_STATES = 330 * MiB;
constexpr size_t WS_MIXED = 396 * MiB;
constexpr size_t WS_ABUF = 212 * MiB;
constexpr size_t WS_GSCR = 430 * MiB;
constexpr size_t WS_USAMP = WS_GSCR;
constexpr size_t WS_END = 504 * MiB;
static_assert(WS_W + DEPTH * W_LAYER <= WS_X && WS_X + (size_t)MPAD * D * 4 <= 178 * MiB && WS_XB + (size_t)MPAD * D * 2 <= WS_PROJ, "ws map 1");
static_assert(WS_PROJ + (size_t)MPAD * PROJ_LD * 2 <= WS_YBUF && WS_YBUF + (size_t)MT * 512 * 4 <= WS_STATES && WS_STATES + (size_t)NB * NCH * 8 * 8192 * 4 <= WS_MIXED, "ws map 2");
static_assert(WS_SS + (size_t)9 * MPAD * 16 * 4 <= WS_END && WS_USAMP + (size_t)MS * 6144 * 4 <= WS_SS && WS_MIXED + (size_t)MPAD * D * 2 <= WS_GSCR && WS_ABUF + (size_t)MPAD * DFF * 2 <= WS_STATES, "ws map 3");

__device__ __forceinline__ float bf2f(unsigned b) { return __uint_as_float(b << 16); }
__device__ __forceinline__ unsigned f2bf(float f) { unsigned u = __float_as_uint(f); return (u + 0x7fffu + ((u >> 16) & 1u)) >> 16; }
__device__ __forceinline__ unsigned pk2(float lo, float hi) { return f2bf(lo) | (f2bf(hi) << 16); }
__device__ __forceinline__ float sigmoidf_(float x) { return __builtin_amdgcn_rcpf(1.0f + __builtin_amdgcn_exp2f(-1.4426950408889634f * x)); }
__device__ __forceinline__ float siluf_(float x) { return x * sigmoidf_(x); }
__device__ __forceinline__ float softplusf_(float x) { return x > 20.f ? x : log1pf(__expf(x)); }
__device__ __forceinline__ float gelu_tanh(float x) { const float e = __builtin_amdgcn_exp2f(x * __builtin_fmaf(-0.10294324f, x * x, -2.3022082f)); return x * __builtin_amdgcn_rcpf(1.0f + e); }
__device__ __forceinline__ float neg_expm1(float y) { const float p = -y * (1.0f + y * (0.5f + y * (0.16666667f + y * (0.041666668f + y * (0.0083333338f + y * 0.0013888889f))))); const float q = 1.0f - __builtin_amdgcn_exp2f(1.4426950408889634f * y); return y > -0.25f ? p : q; }
__device__ __forceinline__ float dpp_ror1(float v) { return __int_as_float(__builtin_amdgcn_mov_dpp(__float_as_int(v), 0x121, 0xF, 0xF, false)); }
__device__ __forceinline__ float dpp_ror2(float v) { return __int_as_float(__builtin_amdgcn_mov_dpp(__float_as_int(v), 0x122, 0xF, 0xF, false)); }
__device__ __forceinline__ float bperm(float v, int srclane) { return __int_as_float(__builtin_amdgcn_ds_bpermute(srclane << 2, __float_as_int(v))); }
__device__ __forceinline__ float rowss(const float* ss, int row) { const f32x4* p = (const f32x4*)(ss + (size_t)row * 16); const f32x4 a = p[0], b = p[1], c = p[2], d = p[3]; return (((a[0] + a[1]) + (a[2] + a[3])) + ((b[0] + b[1]) + (b[2] + b[3]))) + (((c[0] + c[1]) + (c[2] + c[3])) + ((d[0] + d[1]) + (d[2] + d[3]))); }
#define LDS_WAIT() asm volatile("s_waitcnt lgkmcnt(0)" ::: "memory")
#define VM_WAIT() asm volatile("s_waitcnt vmcnt(0)" ::: "memory")
__device__ __forceinline__ f32x4 mfma16(bf16x8 p, bf16x8 q, f32x4 c) { return __builtin_amdgcn_mfma_f32_16x16x32_bf16(p, q, c, 0, 0, 0); }
__device__ __forceinline__ bf16x8 ldsfrag(const LAS unsigned char* img, int rs, int row, int kbyte) { return *(const LAS bf16x8*)(img + row * rs + kbyte); }

namespace pg8 {
#define PG8_LAS __attribute__((address_space(3)))
constexpr int BM = 256, BK = 64, HALF = 128, HTB = HALF * BK * 2, STAGE_BYTES = 8 * HTB, NXCD = 8, WGM = 8;
__host__ __device__ __forceinline__ int lds_byte(int r, int c) { const int st = (r >> 4) * 2 + (c >> 5), rr = r & 15, cc = c & 31, ob = rr * 64 + cc * 2; return st * 1024 + (ob ^ (((ob >> 9) & 1) << 5)); }
__host__ __device__ __forceinline__ void stage_rc(int b, int& R, int& C) { const int st = b / 1024, sb = b % 1024, swz = sb ^ (((sb >> 9) & 1) << 5); R = (st >> 1) * 16 + swz / 64; C = (st & 1) * 32 + (swz % 64) / 2; }
__host__ __device__ __forceinline__ int perm32(int rho) { const int n = rho >> 4, i = rho & 15; return 8 * (i >> 2) + 4 * n + (i & 3); }
struct Unit { int pm, pn, dry; };
struct Gemm { const bf16_t* A; const bf16_t* Bt; int K, nM, nN; long a_tstep, a_hstep; int ovl; };
struct StaticOrder {
    int nM, nN, nwg, G, c, rep;
    __device__ __forceinline__ void init(int nM_, int nN_, int G_, int c_, int rep_ = 1) { nM = nM_; nN = nN_; nwg = nM * nN; G = G_; c = c_; rep = rep_; }
    __device__ __forceinline__ bool next(int i, Unit& u) const {
        const long L = (long)i * G + c; if (L >= (long)nwg * rep) return false;
        int wgid = (int)(L % nwg); u.dry = (L >= nwg) ? 1 : 0; { const int q = nwg / NXCD, r = nwg % NXCD, xcd = wgid % NXCD, off = wgid / NXCD; wgid = (xcd < r ? xcd * (q + 1) : r * (q + 1) + (xcd - r) * q) + off; }
        const int nig = WGM * nN, gid = wgid / nig, fm = gid * WGM, gsz = (nM - fm) < WGM ? (nM - fm) : WGM;
        u.pm = fm + ((wgid % nig) % gsz); u.pn = (wgid % nig) / gsz; return true;
    }
    __device__ __forceinline__ void a_ready(const Unit&) const {}
    __device__ __forceinline__ void done(const Unit&) const {}
};
__device__ __forceinline__ unsigned cvt_pk_bf16(float lo, float hi) { unsigned r; asm volatile("v_cvt_pk_bf16_f32 %0, %1, %2" : "=v"(r) : "v"(lo), "v"(hi)); return r; }

template <class Epi, class Sched, bool ALIGN_EPI, bool SP2>
__device__ __forceinline__ void gemm_phase(PG8_LAS unsigned char* lds, const Gemm g, const Sched& S, const Epi& E, const int tid) {
    const int wid = __builtin_amdgcn_readfirstlane(tid >> 6), lane = tid & 63, wr = wid >> 2, wc = wid & 3, fr = lane & 15, fq = lane >> 4;
    const int K = g.K, nt = K / BK;
    unsigned voffA[2], voffB[2];
#pragma unroll
    for (int i = 0; i < 2; ++i) { int R, C; stage_rc(tid * 16 + i * 8192, R, C); const int Rb = Epi::PERM ? ((R & ~31) + perm32(R & 31)) : R; const int Ra = g.ovl ? (R - 2 * (R >> 6)) : R;
        voffA[i] = (unsigned)(Ra * K + C) * 2u; voffB[i] = (unsigned)(Rb * K + C) * 2u; }
    const size_t kstep = (size_t)(BK * 2);
    const size_t hstepB = (size_t)HALF * K * 2, tstepB = 2 * hstepB;
    const size_t hstepA = (size_t)g.a_hstep, tstepA = (size_t)g.a_tstep;
    const unsigned ldsw = (unsigned)wid * 1024u;
    const int aoff = lds_byte(wr * 64 + fr, fq * 8), boff = lds_byte(wc * 32 + fr, fq * 8);
#define PG8_SA(b, h) (((b) * 2 + (h)) * HTB)
#define PG8_SB(b, h) ((4 + (b) * 2 + (h)) * HTB)
#define PG8_STAGE(bufoff, gbase, voff) do { _Pragma("unroll") for (int _i = 0; _i < 2; ++_i) \
        __builtin_amdgcn_global_load_lds((const unsigned*)((const char*)(gbase) + (voff)[_i]), (PG8_LAS unsigned*)(lds + (bufoff) + ldsw + _i * 8192), 16, 0, 0); } while (0)
#define PG8_LDA(dst, b, h) do { _Pragma("unroll") for (int m = 0; m < 4; ++m) _Pragma("unroll") for (int k = 0; k < 2; ++k) dst[m][k] = *(const PG8_LAS bf16x8*)(lds + PG8_SA(b, h) + aoff + m * 2048 + k * 1024); } while (0)
#define PG8_LDB(dst, b, h) do { _Pragma("unroll") for (int n = 0; n < 2; ++n) _Pragma("unroll") for (int k = 0; k < 2; ++k) dst[n][k] = *(const PG8_LAS bf16x8*)(lds + PG8_SB(b, h) + boff + n * 2048 + k * 1024); } while (0)
#define PG8_MMA(ai, bj, At, Bt) do { __builtin_amdgcn_s_setprio(1); _Pragma("unroll") for (int m = 0; m < 4; ++m) _Pragma("unroll") for (int n = 0; n < 2; ++n) _Pragma("unroll") for (int k = 0; k < 2; ++k) \
        acc[ai][bj][m][n] = __builtin_amdgcn_mfma_f32_16x16x32_bf16(Bt[n][k], At[m][k], acc[ai][bj][m][n], 0, 0, 0); __builtin_amdgcn_s_setprio(0); } while (0)
#define PG8_WAIT_V(n) asm volatile("s_waitcnt vmcnt(" #n ")" ::: "memory")
#define PG8_WAIT_L(n) asm volatile("s_waitcnt lgkmcnt(" #n ")" ::: "memory")
#define PG8_BAR __builtin_amdgcn_s_barrier()
#define PG8_SCHED __builtin_amdgcn_sched_barrier(0)
    Unit cur, nxt; int ui = 0;
    if (!S.next(0, cur)) return;
    f32x4 acc[2][2][4][2];
#pragma unroll
    for (int a = 0; a < 2; ++a)
#pragma unroll
        for (int b = 0; b < 2; ++b)
#pragma unroll
            for (int m = 0; m < 4; ++m)
#pragma unroll
                for (int n = 0; n < 2; ++n) acc[a][b][m][n] = (f32x4){0.f, 0.f, 0.f, 0.f};
    bf16x8 At[4][2], B0[2][2], B1[2][2];
    const char* cA = (const char*)g.A + (size_t)cur.pm * tstepA; const char* cB = (const char*)g.Bt + (size_t)cur.pn * tstepB;
    S.a_ready(cur);
    E.prefetch(lds, cur, 0, wid, lane);
    if constexpr (SP2) {
        PG8_STAGE(PG8_SB(0, 0), cB, voffB); PG8_STAGE(PG8_SB(0, 1), cB + hstepB, voffB); PG8_STAGE(PG8_SA(0, 0), cA, voffA); PG8_STAGE(PG8_SA(0, 1), cA + hstepA, voffA);
        if (wr == 1) PG8_BAR;
        PG8_WAIT_V(2); PG8_BAR;
        PG8_STAGE(PG8_SB(1, 0), cB + kstep, voffB); PG8_STAGE(PG8_SA(1, 0), cA + kstep, voffA); PG8_STAGE(PG8_SB(1, 1), cB + hstepB + kstep, voffB);
        PG8_WAIT_V(6); PG8_BAR;
    } else {
        PG8_STAGE(PG8_SB(0, 0), cB, voffB); PG8_STAGE(PG8_SA(0, 0), cA, voffA); PG8_STAGE(PG8_SB(0, 1), cB + hstepB, voffB); PG8_STAGE(PG8_SA(0, 1), cA + hstepA, voffA);
        if (wr == 1) PG8_BAR;
        PG8_WAIT_V(4); PG8_BAR;
        PG8_STAGE(PG8_SB(1, 0), cB + kstep, voffB); PG8_STAGE(PG8_SA(1, 0), cA + kstep, voffA); PG8_STAGE(PG8_SB(1, 1), cB + hstepB + kstep, voffB);
        PG8_WAIT_V(6); PG8_BAR;
    }
    for (;;) {
        const bool has_next = S.next(ui + 1, nxt);
        const char* nA = has_next ? (const char*)g.A + (size_t)nxt.pm * tstepA : cA; const char* nB = has_next ? (const char*)g.Bt + (size_t)nxt.pn * tstepB : cB;
        for (int t = 0; t < nt; t += 2) {
            const bool last = (t == nt - 2);
            const char* a1 = cA + (size_t)(t + 1) * kstep;
            const char* a2 = last ? nA : cA + (size_t)(t + 2) * kstep; const char* b2 = last ? nB : cB + (size_t)(t + 2) * kstep;
            const char* a3 = a2 + kstep; const char* b3 = b2 + kstep;
            if (last && has_next) { S.a_ready(nxt); E.prefetch(lds, nxt, (ui + 1) & 1, wid, lane); }
            if constexpr (SP2) {
            PG8_LDB(B0, 0, 0); PG8_LDB(B1, 0, 1); PG8_SCHED; PG8_LDA(At, 0, 0); PG8_STAGE(PG8_SA(1, 1), a1 + hstepA, voffA);
            PG8_WAIT_V(8); PG8_WAIT_L(0); PG8_BAR; PG8_MMA(0, 0, At, B0); PG8_MMA(0, 1, At, B1); PG8_BAR; PG8_SCHED;
            PG8_LDA(At, 0, 1); PG8_STAGE(PG8_SB(0, 0), b2, voffB); PG8_STAGE(PG8_SB(0, 1), b2 + hstepB, voffB); PG8_STAGE(PG8_SA(0, 0), a2, voffA);
            PG8_WAIT_V(8); PG8_WAIT_L(0); PG8_BAR; PG8_MMA(1, 0, At, B0); PG8_MMA(1, 1, At, B1); PG8_BAR; PG8_SCHED;
            PG8_LDB(B0, 1, 0); PG8_LDB(B1, 1, 1); PG8_SCHED; PG8_LDA(At, 1, 0); PG8_STAGE(PG8_SA(0, 1), a2 + hstepA, voffA);
            PG8_WAIT_V(8); PG8_WAIT_L(0); PG8_BAR; PG8_MMA(0, 0, At, B0); PG8_MMA(0, 1, At, B1); PG8_BAR; PG8_SCHED;
            PG8_LDA(At, 1, 1); PG8_STAGE(PG8_SB(1, 0), b3, voffB); PG8_STAGE(PG8_SB(1, 1), b3 + hstepB, voffB); PG8_STAGE(PG8_SA(1, 0), a3, voffA);
            PG8_WAIT_V(8); PG8_WAIT_L(0); PG8_BAR; PG8_MMA(1, 0, At, B0); PG8_MMA(1, 1, At, B1); PG8_BAR; PG8_SCHED;
            } else {
            PG8_LDB(B0, 0, 0); PG8_SCHED; PG8_LDA(At, 0, 0); PG8_STAGE(PG8_SA(1, 1), a1 + hstepA, voffA);
            PG8_WAIT_L(8); PG8_BAR; PG8_WAIT_L(0); PG8_MMA(0, 0, At, B0); PG8_BAR; PG8_SCHED;
            PG8_LDB(B1, 0, 1); PG8_STAGE(PG8_SB(0, 0), b2, voffB);
            PG8_BAR; PG8_WAIT_L(0); PG8_MMA(0, 1, At, B1); PG8_BAR;
            PG8_LDA(At, 0, 1); PG8_STAGE(PG8_SA(0, 0), a2, voffA);
            PG8_BAR; PG8_WAIT_L(0); PG8_MMA(1, 0, At, B0); PG8_BAR; PG8_SCHED;
            PG8_STAGE(PG8_SB(0, 1), b2 + hstepB, voffB);
            PG8_WAIT_V(6); PG8_BAR; PG8_MMA(1, 1, At, B1); PG8_BAR;
            PG8_LDB(B0, 1, 0); PG8_SCHED; PG8_LDA(At, 1, 0); PG8_STAGE(PG8_SA(0, 1), a2 + hstepA, voffA);
            PG8_WAIT_L(8); PG8_BAR; PG8_WAIT_L(0); PG8_MMA(0, 0, At, B0); PG8_BAR; PG8_SCHED;
            PG8_LDB(B1, 1, 1); PG8_STAGE(PG8_SB(1, 0), b3, voffB);
            PG8_BAR; PG8_WAIT_L(0); PG8_MMA(0, 1, At, B1); PG8_BAR;
            PG8_LDA(At, 1, 1); PG8_STAGE(PG8_SA(1, 0), a3, voffA);
            PG8_BAR; PG8_WAIT_L(0); PG8_MMA(1, 0, At, B0); PG8_BAR; PG8_SCHED;
            PG8_STAGE(PG8_SB(1, 1), b3 + hstepB, voffB);
            PG8_WAIT_V(6); PG8_BAR; PG8_MMA(1, 1, At, B1); PG8_BAR;
            }
        }
        if constexpr (ALIGN_EPI) { if (wr == 0) PG8_BAR; }
        E(acc, cur, wr, wc, fr, fq, lds, ui & 1); S.done(cur);
        if (!has_next) break;
#pragma unroll
        for (int a = 0; a < 2; ++a)
#pragma unroll
            for (int b = 0; b < 2; ++b)
#pragma unroll
                for (int m = 0; m < 4; ++m)
#pragma unroll
                    for (int n = 0; n < 2; ++n) acc[a][b][m][n] = (f32x4){0.f, 0.f, 0.f, 0.f};
        cur = nxt; cA = nA; cB = nB; ++ui;
        if constexpr (ALIGN_EPI) { if (wr == 1) PG8_BAR; }
    }
    PG8_WAIT_V(0);
    if constexpr (!ALIGN_EPI) { if (wr == 0) PG8_BAR; }
    PG8_BAR;
#undef PG8_SA
#undef PG8_SB
#undef PG8_STAGE
#undef PG8_LDA
#undef PG8_LDB
#undef PG8_MMA
#undef PG8_WAIT_V
#undef PG8_WAIT_L
#undef PG8_BAR
#undef PG8_SCHED
}


struct EpiIn {
    static constexpr bool PERM = true;
    bf16_t* proj; float* dtraw; const float* ss;
    __device__ __forceinline__ void prefetch(PG8_LAS unsigned char*, const Unit&, int, int, int) const {}
    __device__ __forceinline__ void operator()(const f32x4 (&acc)[2][2][4][2], const Unit& u, int wr, int wc, int fr, int fq, PG8_LAS unsigned char*, int) const {
        const int row0 = u.pm * BM + wr * 64 + fr;
        if (u.pn < 10) {
            const int col0 = u.pn * BM + wc * 32 + 8 * fq;
#pragma unroll
            for (int ai = 0; ai < 2; ++ai)
#pragma unroll
                for (int m = 0; m < 4; ++m) { const int row = row0 + ai * HALF + m * 16; const float rs = rsqrtf(rowss(ss, row) * (1.0f / 1024.0f) + EPS);
                    bf16_t* rowp = proj + (size_t)row * PROJ_LD + col0;
#pragma unroll
                    for (int bj = 0; bj < 2; ++bj) { const f32x4 v0 = acc[ai][bj][m][0] * rs, v1 = acc[ai][bj][m][1] * rs;
                        u32x4 w; w.x = cvt_pk_bf16(v0[0], v0[1]); w.y = cvt_pk_bf16(v0[2], v0[3]); w.z = cvt_pk_bf16(v1[0], v1[1]); w.w = cvt_pk_bf16(v1[2], v1[3]);
                        *(u32x4*)(rowp + bj * HALF) = w; } }
        } else if (wc == 0 && fq == 0) {
#pragma unroll
            for (int ai = 0; ai < 2; ++ai)
#pragma unroll
                for (int m = 0; m < 4; ++m) { const int row = row0 + ai * HALF + m * 16; const float rs = rsqrtf(rowss(ss, row) * (1.0f / 1024.0f) + EPS);
                    float* p = dtraw + (size_t)row * 8; *(f32x4*)p = acc[ai][0][m][0] * rs; *(f32x4*)(p + 4) = acc[ai][0][m][1] * rs; }
        }
    }
};
struct EpiRes {
    static constexpr bool PERM = true;
    bf16_t* xb; float* ssn;
    __device__ __forceinline__ void prefetch(PG8_LAS unsigned char*, const Unit&, int, int, int) const {}
    __device__ __forceinline__ void operator()(const f32x4 (&acc)[2][2][4][2], const Unit& u, int wr, int wc, int fr, int fq, PG8_LAS unsigned char*, int) const {
        const int row0 = u.pm * BM + wr * 64 + fr, col0 = u.pn * BM + wc * 32 + 8 * fq;
#pragma unroll
        for (int ai = 0; ai < 2; ++ai)
#pragma unroll
            for (int m = 0; m < 4; ++m) { const int row = row0 + ai * HALF + m * 16; float part = 0.f;
#pragma unroll
                for (int bj = 0; bj < 2; ++bj) { bf16_t* xp = xb + (size_t)row * D + col0 + bj * HALF; const u32x4 old = *(const u32x4*)xp;
                    f32x4 o0, o1;
                    o0[0] = bf2f(old.x & 0xffffu) + acc[ai][bj][m][0][0]; o0[1] = bf2f(old.x >> 16) + acc[ai][bj][m][0][1]; o0[2] = bf2f(old.y & 0xffffu) + acc[ai][bj][m][0][2]; o0[3] = bf2f(old.y >> 16) + acc[ai][bj][m][0][3];
                    o1[0] = bf2f(old.z & 0xffffu) + acc[ai][bj][m][1][0]; o1[1] = bf2f(old.z >> 16) + acc[ai][bj][m][1][1]; o1[2] = bf2f(old.w & 0xffffu) + acc[ai][bj][m][1][2]; o1[3] = bf2f(old.w >> 16) + acc[ai][bj][m][1][3];
                    part += (o0[0] * o0[0] + o0[1] * o0[1]) + (o0[2] * o0[2] + o0[3] * o0[3]) + (o1[0] * o1[0] + o1[1] * o1[1]) + (o1[2] * o1[2] + o1[3] * o1[3]);
                    u32x4 w; w.x = cvt_pk_bf16(o0[0], o0[1]); w.y = cvt_pk_bf16(o0[2], o0[3]); w.z = cvt_pk_bf16(o1[0], o1[1]); w.w = cvt_pk_bf16(o1[2], o1[3]);
                    *(u32x4*)xp = w; }
                { const int ln = fr + 16 * fq; part += bperm(part, ln ^ 16); part += bperm(part, ln ^ 32); }
                if (fq == 0) ssn[(size_t)row * 16 + u.pn * 4 + wc] = part; }
    }
};
struct EpiUp {
    static constexpr bool PERM = true;
    bf16_t* a; const float* ss; const float* cw; const float* cb; float* pf; float* usamp;
    static constexpr int CWS_OFF = 131072 + 512;
    __device__ __forceinline__ void prefetch(PG8_LAS unsigned char* lds, const Unit& u, int slot, int wid, int lane) const {
        if (wid < 4) { const int seg = 2 * wid + (lane >> 5), k = seg & 3, el = (lane & 31) * 4;
            const float* src = (k < 3 ? cw + k * 6144 : cb) + (seg >> 2) * 3072 + u.pn * 128 + el;
            __builtin_amdgcn_global_load_lds((const unsigned*)src, (PG8_LAS unsigned*)(lds + CWS_OFF + slot * 4096 + wid * 1024), 16, 0, 0); }
    }
    __device__ __forceinline__ void operator()(const f32x4 (&acc)[2][2][4][2], const Unit& u, int wr, int wc, int fr, int fq, PG8_LAS unsigned char* lds, int slot) const {
        const int ch0 = u.pn * 128 + wc * 32 + 8 * fq;
        const PG8_LAS float* cws = (const PG8_LAS float*)(lds + CWS_OFF + slot * 4096) + wc * 32 + 8 * fq;
        if ((REP_MASK & 512) && u.dry) return;
        constexpr int INV = (int)0x80000000;
#pragma unroll
        for (int ai = 0; ai < 2; ++ai) {
            const int gr0 = u.pm * 248 + 62 * (2 * ai + wr) - 2;
            float rs[4]; int tk[4];
            bool plain = true;
#pragma unroll
            for (int m = 0; m < 4; ++m) { const int lr = 16 * m + fr, gr = gr0 + lr; const int idx = gr < 0 ? 0 : gr; rs[m] = rsqrtf(rowss(ss, idx) * (1.0f / 1024.0f) + EPS);
                tk[m] = (lr >= 2 && gr < MT) ? (gr < MP ? gr % LP : -1 - (gr - MP)) : INV;
                plain = plain && (tk[m] == INV || (tk[m] >= 2 && tk[m] < LP - 2)); }
            const bool all_plain = __builtin_amdgcn_ballot_w64(!plain) == 0ull;
            unsigned pk[4][4];
#pragma unroll
            for (int n = 0; n < 2; ++n) {
                float keep[4];
                const f32x4 wg0_ = *(const PG8_LAS f32x4*)(cws + 4 * n), wg1_ = *(const PG8_LAS f32x4*)(cws + 128 + 4 * n), wg2_ = *(const PG8_LAS f32x4*)(cws + 256 + 4 * n), bg_ = *(const PG8_LAS f32x4*)(cws + 384 + 4 * n);
                const f32x4 wv0_ = *(const PG8_LAS f32x4*)(cws + 512 + 4 * n), wv1_ = *(const PG8_LAS f32x4*)(cws + 640 + 4 * n), wv2_ = *(const PG8_LAS f32x4*)(cws + 768 + 4 * n), bv_ = *(const PG8_LAS f32x4*)(cws + 896 + 4 * n);
#pragma unroll
                for (int j = 0; j < 4; ++j) {
                    const int col = ch0 + 4 * n + j;
                    const float wg0 = wg0_[j], wg1 = wg1_[j], wg2 = wg2_[j], bg = bg_[j];
                    const float wv0 = wv0_[j], wv1 = wv1_[j], wv2 = wv2_[j], bv = bv_[j];
                    float ug[4], uv[4], s1g[4], s2g[4], s1v[4], s2v[4];
#pragma unroll
                    for (int m = 0; m < 4; ++m) { ug[m] = acc[ai][0][m][n][j] * rs[m]; uv[m] = acc[ai][1][m][n][j] * rs[m];
                        s1g[m] = dpp_ror1(ug[m]); s2g[m] = dpp_ror2(ug[m]); s1v[m] = dpp_ror1(uv[m]); s2v[m] = dpp_ror2(uv[m]); }
#pragma unroll
                    for (int m = 0; m < 4; ++m) {
                        const int mm = m > 0 ? m - 1 : 0;
                        float p1g = fr >= 1 ? s1g[m] : (m > 0 ? s1g[mm] : 0.f), p2g = fr >= 2 ? s2g[m] : (m > 0 ? s2g[mm] : 0.f);
                        float p1v = fr >= 1 ? s1v[m] : (m > 0 ? s1v[mm] : 0.f), p2v = fr >= 2 ? s2v[m] : (m > 0 ? s2v[mm] : 0.f);
                        if (!all_plain) {
                            const int t = tk[m];
                            if (t >= 0) { if (t < 1) { p1g = 0.f; p1v = 0.f; } if (t < 2) { p2g = 0.f; p2v = 0.f; }
                                if (t >= LP - 2) { const int gr = gr0 + 16 * m + fr; float* o = pf + ((size_t)(gr / LP) * 2 + (t - (LP - 2))) * 6144 + col; o[0] = ug[m]; o[3072] = uv[m]; } }
                            else if (t != INV) { float* o = usamp + (size_t)(-1 - t) * 6144 + col; o[0] = ug[m]; o[3072] = uv[m]; }
                        }
                        const float cg_ = bg + wg0 * p2g + wg1 * p1g + wg2 * ug[m], cv_ = bv + wv0 * p2v + wv1 * p1v + wv2 * uv[m];
                        const float r_ = gelu_tanh(cg_) * cv_;
                        if (j & 1) pk[m][2 * n + (j >> 1)] = cvt_pk_bf16(keep[m], r_); else keep[m] = r_;
                    }
                }
            }
#pragma unroll
            for (int m = 0; m < 4; ++m) { if (tk[m] >= 0) { const int gr = gr0 + 16 * m + fr; u32x4 w; w.x = pk[m][0]; w.y = pk[m][1]; w.z = pk[m][2]; w.w = pk[m][3];
                    *(u32x4*)(a + (size_t)gr * DFF + ch0) = w; } }
        }
    }
};
}

#define XB_TMO      128
#define XB_XCNT(j)  (256  + 64 * (j))
#define XB_XSUB(j)  (1280 + 64 * (j))
#define XB_XGEN(j)  (2304 + 64 * (j))
#define XB_TOP      3328
#define XB_TOPGEN   3392
#define XCD_BAR_WORDS 3456
#define XB_SPIN_CAP (1u << 18)
__device__ __forceinline__ unsigned xb_ld(unsigned* p)              { return __hip_atomic_load(p, __ATOMIC_RELAXED, __HIP_MEMORY_SCOPE_AGENT); }
__device__ __forceinline__ unsigned xb_add(unsigned* p, unsigned v) { return __hip_atomic_fetch_add(p, v, __ATOMIC_RELAXED, __HIP_MEMORY_SCOPE_AGENT); }
__device__ __forceinline__ unsigned xb_xcc_id() { return (unsigned)__builtin_amdgcn_s_getreg((3 << 11) | 20) & 0xFu; }
#define XB_SPIN(cond, bar) do { unsigned _sp = 0; while (cond) { __builtin_amdgcn_s_sleep(1); \
    if ((++_sp & 255u) == 0u) { if (xb_ld(&(bar)[XB_TMO])) break; if (_sp > XB_SPIN_CAP) { atomicAdd(&(bar)[XB_TMO], 1u); break; } } } } while (0)
struct XcdBarrier { unsigned* bar; unsigned x; volatile LAS unsigned* st; };
__device__ __forceinline__ XcdBarrier xcd_barrier_post(unsigned* bar, volatile LAS unsigned* st, const int tid) {
    XcdBarrier b; b.bar = bar; b.x = xb_xcc_id(); b.st = st;
    if (tid == 0) (void)xb_add(&bar[XB_XCNT(b.x)], 1u);
    return b;
}
__device__ __forceinline__ void xcd_barrier_complete(unsigned* bar, unsigned x, unsigned& nloc, unsigned& nx) {
    const unsigned G = gridDim.x * gridDim.y * gridDim.z;
    unsigned sum, cnt, mine, sp = 0u;
    for (;;) {
        sum = 0u; cnt = 0u; mine = 0u;
#pragma unroll
        for (unsigned j = 0; j < 16; ++j) { const unsigned c = xb_ld(&bar[XB_XCNT(j)]); sum += c; cnt += (c > 0u) ? 1u : 0u; mine = (j == x) ? c : mine; }
        if (sum == G) break;
        __builtin_amdgcn_s_sleep(1);
        if ((++sp & 255u) == 0u) { if (xb_ld(&bar[XB_TMO])) break; if (sp > XB_SPIN_CAP) { atomicAdd(&bar[XB_TMO], 1u); break; } }
    }
    nloc = mine > 0u ? mine : 1u; nx = cnt > 0u ? cnt : 1u;
}
__device__ __forceinline__ void xcd_barrier(const XcdBarrier& b, const int tid) {
    asm volatile("s_waitcnt vmcnt(0)" ::: "memory");
    __syncthreads();
    if (tid == 0) {
        unsigned* bar = b.bar;
        __builtin_amdgcn_s_waitcnt(0);
        unsigned nloc = b.st[0], nx = b.st[1];
        if (nloc == 0u) { xcd_barrier_complete(bar, b.x, nloc, nx); b.st[0] = nloc; b.st[1] = nx; }
        const unsigned old = xb_add(&bar[XB_XSUB(b.x)], 1u);
        const unsigned gen = old / nloc;
        if (old + 1u == (gen + 1u) * nloc) {
            __builtin_amdgcn_fence(__ATOMIC_RELEASE, "agent");
            asm volatile("s_waitcnt vmcnt(0)" ::: "memory");
            const unsigned og = xb_add(&bar[XB_TOP], 1u);
            const unsigned tg = og / nx;
            if (og + 1u == (tg + 1u) * nx) xb_add(&bar[XB_TOPGEN], 1u);
            else XB_SPIN(xb_ld(&bar[XB_TOPGEN]) == tg, bar);
            __builtin_amdgcn_fence(__ATOMIC_ACQUIRE, "agent");
            xb_add(&bar[XB_XGEN(b.x)], 1u);
            asm volatile("s_waitcnt vmcnt(0)" ::: "memory");
        } else {
            XB_SPIN(xb_ld(&bar[XB_XGEN(b.x)]) == gen, bar);
            __builtin_amdgcn_fence(__ATOMIC_ACQUIRE, "agent");
            asm volatile("s_waitcnt vmcnt(0)" ::: "memory");
        }
    }
    __syncthreads();
}

struct Params { const float* in[31]; float* out; unsigned char* ws; };
enum { I_XP = 0, I_XS, I_SLC, I_SLH, I_SSC, I_SSS, I_SFC, I_META, I_NMIX, I_WIN, I_LCW, I_LCB, I_WA, I_BA, I_WX, I_BX, I_APAR, I_LON, I_SCW, I_SCB, I_DTB, I_ALOG, I_SSD_D, I_SON, I_WOUT, I_NFFN, I_WUP, I_FCW, I_FCB, I_WDOWN, I_NFIN };

constexpr int LDS_MISC = 131072, LDS_BYTES = 147456;

__device__ __forceinline__ float wave_sum(float v, int lane) {
#pragma unroll
    for (int o = 1; o < 64; o <<= 1) v += bperm(v, lane ^ o);
    return v;
}

__device__ __forceinline__ void p0_transpose_item(const float* W, int ldw, int nvalid, const float* gain, bf16_t* WT, int ldt, int k0, int n0, int drow0, LAS float* scr, int lane) {
    const int nn = n0 + (lane & 31);
#pragma unroll 8
    for (int i = 0; i < 32; ++i) { const int kk = 2 * i + (lane >> 5); float v = nn < nvalid ? W[(size_t)(k0 + kk) * ldw + nn] : 0.f; if (gain) v *= gain[k0 + kk]; scr[kk * 33 + (lane & 31)] = v; }
    LDS_WAIT(); asm volatile("" ::: "memory");
    const int c = lane & 7;
#pragma unroll
    for (int j = 0; j < 4; ++j) { const int n = (lane >> 3) + 8 * j; const LAS float* s = scr + (8 * c) * 33 + n;
        u32x4 o; o.x = pk2(s[0 * 33], s[1 * 33]); o.y = pk2(s[2 * 33], s[3 * 33]); o.z = pk2(s[4 * 33], s[5 * 33]); o.w = pk2(s[6 * 33], s[7 * 33]);
        *(u32x4*)(WT + (size_t)(drow0 + n) * ldt + k0 + 8 * c) = o; }
    LDS_WAIT(); asm volatile("" ::: "memory");
}
__device__ __forceinline__ void p0_prologue(const Params& P, LAS unsigned char* lds, int wave, int lane, const int tid) {
    LAS float* scr = (LAS float*)(lds + wave * 16384);
    const int gw = blockIdx.x * 8 + wave, NGW = gridDim.x * 8;
    unsigned char* ws = P.ws;
    constexpr int I_IN = 16 * 88, I_OUT = 16 * 32, I_UP = 16 * 192, I_DN = 48 * 32, I_L = I_IN + I_OUT + I_UP + I_DN, I_LRU = DEPTH * 8 * 2 * 2;
    for (int it = gw; it < DEPTH * I_L + I_LRU; it += NGW) {
        if (it < DEPTH * I_L) {
            const int l = it / I_L; int r = it % I_L; unsigned char* wl = ws + WS_W + (size_t)l * W_LAYER;
            if (r < I_IN) { const int kb = r / 88, nb = r % 88; p0_transpose_item(P.in[I_WIN] + (size_t)l * D * PIN, PIN, PIN, P.in[I_NMIX] + l * D, (bf16_t*)(wl + W_IN), D, 64 * kb, 32 * nb, 32 * nb, scr, lane); continue; } r -= I_IN;
            if (r < I_OUT) { const int kb = r / 32, nb = r % 32; p0_transpose_item(P.in[I_WOUT] + (size_t)l * D * D, D, D, nullptr, (bf16_t*)(wl + W_OUT), D, 64 * kb, 32 * nb, 32 * nb, scr, lane); continue; } r -= I_OUT;
            if (r < I_UP) { const int kb = r / 192, nb = r % 192, n0 = 32 * nb; const int drow = n0 < DFF ? (n0 / 128) * 256 + (n0 % 128) : ((n0 - DFF) / 128) * 256 + 128 + ((n0 - DFF) % 128);
                p0_transpose_item(P.in[I_WUP] + (size_t)l * D * 2 * DFF, 2 * DFF, 2 * DFF, P.in[I_NFFN] + l * D, (bf16_t*)(wl + W_UP), D, 64 * kb, n0, drow, scr, lane); continue; } r -= I_UP;
            { const int kb = r / 32, nb = r % 32; p0_transpose_item(P.in[I_WDOWN] + (size_t)l * DFF * D, D, D, nullptr, (bf16_t*)(wl + W_DOWN), DFF, 64 * kb, 32 * nb, 32 * nb, scr, lane); }
        } else {
            const int r = it - DEPTH * I_L, lh = r >> 2, which = (r >> 1) & 1, nb = r & 1;
            p0_transpose_item(P.in[which ? I_WX : I_WA] + (size_t)lh * 4096, 64, 64, nullptr, (bf16_t*)(ws + WS_LRUW) + (size_t)which * DEPTH * 8 * 4096 + (size_t)lh * 4096, 64, 0, 32 * nb, 32 * nb, scr, lane);
        }
    }
    bf16_t* xb = (bf16_t*)(ws + WS_XB); float* ss = (float*)(ws + WS_SS);
    for (int m = gw; m < MPAD; m += NGW) {
        const float* src = nullptr;
        if (m < MP) { const int b = m / LP, t = m % LP; src = t < NMETA ? P.in[I_META] + (size_t)t * D : P.in[I_XP] + ((size_t)b * SEQ + (t - NMETA)) * D; }
        else if (m < MT) src = P.in[I_XS] + (size_t)(m - MP) * D;
        f32x4 v[4]; float s = 0.f;
#pragma unroll
        for (int j = 0; j < 4; ++j) { v[j] = src ? *((const f32x4*)src + lane + 64 * j) : (f32x4){0.f, 0.f, 0.f, 0.f}; s += (v[j][0] * v[j][0] + v[j][1] * v[j][1]) + (v[j][2] * v[j][2] + v[j][3] * v[j][3]); }
        s = wave_sum(s, lane);
#pragma unroll
        for (int j = 0; j < 4; ++j) {
            u32x2 w; w.x = pk2(v[j][0], v[j][1]); w.y = pk2(v[j][2], v[j][3]); *((u32x2*)(xb + (size_t)m * D) + lane + 64 * j) = w; }
        if (lane < 16) ss[(size_t)m * 16 + lane] = lane == 0 ? s : 0.f;
    }
    if (blockIdx.x == 0) for (int i = tid; i < 4 * D / 2; i += 512) ((unsigned*)(ws + WS_XB - 8192))[i] = 0u;
}

constexpr int M1_BG = 0, M1_CG = 17408, M1_BGT = 34816, M1_XT = 53248, M1_XST = 71680, M1_WIM = 90112, M1_SDT = 108544, M1_SCS = 109568;
constexpr int M3_XC = 0, XC_RS = 1040, M3_CG = 66560, M3_SSQS = 101376, M3_SSQL = 103424;

struct LayerPtrs {
    const float *lcw, *lcb, *ba, *bx, *apar, *lon, *scw, *scb, *dtb, *alog, *sdd, *son;
    const bf16_t *waT, *wxT;
};
__device__ __forceinline__ LayerPtrs layer_ptrs(const Params& P, int l) {
    LayerPtrs L;
    L.lcw = P.in[I_LCW] + (size_t)l * 4 * 512; L.lcb = P.in[I_LCB] + l * 512; L.ba = P.in[I_BA] + l * 512; L.bx = P.in[I_BX] + l * 512; L.apar = P.in[I_APAR] + l * 512; L.lon = P.in[I_LON] + l * 512;
    L.scw = P.in[I_SCW] + (size_t)l * 4 * 1024; L.scb = P.in[I_SCB] + l * 1024; L.dtb = P.in[I_DTB] + l * 8; L.alog = P.in[I_ALOG] + l * 8; L.sdd = P.in[I_SSD_D] + l * 8; L.son = P.in[I_SON] + l * 512;
    L.waT = (const bf16_t*)(P.ws + WS_LRUW) + (size_t)l * 8 * 4096; L.wxT = L.waT + (size_t)DEPTH * 8 * 4096;
    return L;
}

template <int CNT>
__device__ __forceinline__ void conv4_run(const bf16_t* src, size_t rowb, int tok0, float w0, float w1, float w2, float w3, float bias, bool do_silu, float (&out)[CNT]) {
    float x3 = tok0 - 3 >= 0 ? bf2f(src[(rowb + tok0 - 3) * PROJ_LD]) : 0.f, x2 = tok0 - 2 >= 0 ? bf2f(src[(rowb + tok0 - 2) * PROJ_LD]) : 0.f, x1 = tok0 - 1 >= 0 ? bf2f(src[(rowb + tok0 - 1) * PROJ_LD]) : 0.f;
#pragma unroll
    for (int i = 0; i < CNT; ++i) { const float x0 = bf2f(src[(rowb + tok0 + i) * PROJ_LD]); const float v = bias + w0 * x3 + w1 * x2 + w2 * x1 + w3 * x0; out[i] = do_silu ? siluf_(v) : v; x3 = x2; x2 = x1; x1 = x0; }
}

__device__ __forceinline__ void m1_ssd_unit(const Params& P, const LayerPtrs& L, int l, int b, int c, int g, LAS unsigned char* lds, int wave, int lane) {
    const int tid = wave * 64 + lane, fr = lane & 15, fq = lane >> 4;
    unsigned char* ws = P.ws;
    const bf16_t* proj = (const bf16_t*)(ws + WS_PROJ); const float* dtraw = (const float*)(ws + WS_DTRAW);
    float* csbuf = (float*)(ws + WS_CS); float* cdec = (float*)(ws + WS_CDEC); float* ybuf = (float*)(ws + WS_YBUF); float* states = (float*)(ws + WS_STATES);
    const size_t rowb = (size_t)b * LP; const int t0 = 64 * c;
    LAS float* SDT = (LAS float*)(lds + M1_SDT); LAS float* SCS = (LAS float*)(lds + M1_SCS);
    if (wave < 4) {
        const int head = 4 * g + wave, tok = t0 + lane; const bool ok = tok < LP;
        const float raw = ok ? dtraw[(rowb + tok) * 8 + head] : 0.f; const float dt = ok ? softplusf_(raw + L.dtb[head]) : 0.f;
        const float Ah = -__expf(L.alog[head]); float cs = dt * Ah;
#pragma unroll
        for (int o = 1; o < 64; o <<= 1) { const float v = bperm(cs, lane - o); if (lane >= o) cs += v; }
        SDT[wave * 64 + lane] = dt; SCS[wave * 64 + lane] = cs;
        if (ok) csbuf[(rowb + tok) * 8 + head] = cs;
        if (lane == 63) cdec[((size_t)b * NCH + c) * 8 + head] = __expf(cs);
    }
    {
        const int cc = tid & 255, half = tid >> 8, isC = cc >> 7, n = cc & 127, chan = 512 + 256 * isC + 128 * g + n;
        float o[32]; conv4_run<32>(proj + O_XBC + chan, rowb, t0 + 32 * half, L.scw[chan], L.scw[1024 + chan], L.scw[2048 + chan], L.scw[3072 + chan], L.scb[chan], true, o);
        LAS unsigned char* img = lds + (isC ? M1_CG : M1_BG);
#pragma unroll
        for (int i = 0; i < 32; ++i) *(LAS bf16_t*)(img + (32 * half + i) * 272 + n * 2) = (bf16_t)f2bf(o[i]);
        if (!isC) {
#pragma unroll
            for (int i = 0; i < 4; ++i) { u32x4 w; w.x = pk2(o[8 * i], o[8 * i + 1]); w.y = pk2(o[8 * i + 2], o[8 * i + 3]); w.z = pk2(o[8 * i + 4], o[8 * i + 5]); w.w = pk2(o[8 * i + 6], o[8 * i + 7]);
                *(LAS u32x4*)(lds + M1_BGT + n * 144 + (32 * half + 8 * i) * 2) = w; }
        }
        if (c == NCH - 1 && half == 0) {
#pragma unroll
            for (int k = 0; k < 3; ++k) P.out[OFF_PSC + (((size_t)l * NB + b) * 3 + k) * 1024 + chan] = bf2f(proj[(rowb + LP - 3 + k) * PROJ_LD + O_XBC + chan]);
        }
    }
    __syncthreads();
    for (int pr = 0; pr < 2; ++pr) {
        {
            const int xi = tid & 127, q = tid >> 7, hl2 = xi >> 6, p = xi & 63, hl = 2 * pr + hl2, chan = 256 * g + 64 * hl + p;
            float o[16]; conv4_run<16>(proj + O_XBC + chan, rowb, t0 + 16 * q, L.scw[chan], L.scw[1024 + chan], L.scw[2048 + chan], L.scw[3072 + chan], L.scb[chan], true, o);
            const float cl = SCS[hl * 64 + 63];
            float os[16];
#pragma unroll
            for (int i = 0; i < 16; ++i) { const int s = 16 * q + i; os[i] = o[i] * SDT[hl * 64 + s] * __expf(cl - SCS[hl * 64 + s]); }
#pragma unroll
            for (int i = 0; i < 2; ++i) { u32x4 w; w.x = pk2(o[8 * i], o[8 * i + 1]); w.y = pk2(o[8 * i + 2], o[8 * i + 3]); w.z = pk2(o[8 * i + 4], o[8 * i + 5]); w.w = pk2(o[8 * i + 6], o[8 * i + 7]);
                *(LAS u32x4*)(lds + M1_XT + hl2 * 9216 + p * 144 + (16 * q + 8 * i) * 2) = w;
                u32x4 v; v.x = pk2(os[8 * i], os[8 * i + 1]); v.y = pk2(os[8 * i + 2], os[8 * i + 3]); v.z = pk2(os[8 * i + 4], os[8 * i + 5]); v.w = pk2(os[8 * i + 6], os[8 * i + 7]);
                *(LAS u32x4*)(lds + M1_XST + hl2 * 9216 + p * 144 + (16 * q + 8 * i) * 2) = v; }
            if (c == NCH - 1 && q == 0) {
#pragma unroll
                for (int k = 0; k < 3; ++k) P.out[OFF_PSC + (((size_t)l * NB + b) * 3 + k) * 1024 + chan] = bf2f(proj[(rowb + LP - 3 + k) * PROJ_LD + O_XBC + chan]);
            }
        }
        __syncthreads();
        {
            const int hl2 = wave >> 2, tt = wave & 3, hl = 2 * pr + hl2, head = 4 * g + hl;
            LAS unsigned char* Wm = lds + M1_WIM + wave * 2304;
            const LAS unsigned char* XT = lds + M1_XT + hl2 * 9216; const LAS unsigned char* XST = lds + M1_XST + hl2 * 9216;
            const int kb0 = 16 * fq;
            const int tl = 16 * tt + fr; const float cs_t = SCS[hl * 64 + tl];
#pragma unroll
            for (int st = 0; st < 4; ++st) {
                u32x2 wpk; wpk.x = 0u; wpk.y = 0u;
                if (st <= tt) {
                    f32x4 acc = (f32x4){0.f, 0.f, 0.f, 0.f};
#pragma unroll
                    for (int ks = 0; ks < 4; ++ks) acc = mfma16(ldsfrag(lds + M1_BG, 272, 16 * st + fr, 64 * ks + kb0), ldsfrag(lds + M1_CG, 272, tl, 64 * ks + kb0), acc);
                    const f32x4 css = *(const LAS f32x4*)(SCS + hl * 64 + 16 * st + 4 * fq), dts = *(const LAS f32x4*)(SDT + hl * 64 + 16 * st + 4 * fq);
                    float w[4];
#pragma unroll
                    for (int r = 0; r < 4; ++r) { const int s = 16 * st + 4 * fq + r; w[r] = (s <= tl) ? acc[r] * __expf(cs_t - css[r]) * dts[r] : 0.f; }
                    wpk.x = pk2(w[0], w[1]); wpk.y = pk2(w[2], w[3]);
                }
                *(LAS u32x2*)(Wm + fr * 144 + (16 * st + 4 * fq) * 2) = wpk;
            }
            LDS_WAIT();
            const int tok = t0 + tl; const float Dh = L.sdd[head];
#pragma unroll
            for (int pt = 0; pt < 4; ++pt) {
                f32x4 acc = (f32x4){0.f, 0.f, 0.f, 0.f};
#pragma unroll
                for (int ks = 0; ks < 2; ++ks) acc = mfma16(ldsfrag(XT, 144, 16 * pt + fr, 64 * ks + kb0), ldsfrag(Wm, 144, fr, 64 * ks + kb0), acc);
#pragma unroll
                for (int r = 0; r < 4; ++r) acc[r] += Dh * bf2f(*(const LAS bf16_t*)(XT + (16 * pt + 4 * fq + r) * 144 + tl * 2));
                if (tok < LP) *(f32x4*)(ybuf + (rowb + tok) * 512 + head * 64 + 16 * pt + 4 * fq) = acc;
            }
            float* sdst = states + (((size_t)b * NCH + c) * 8 + head) * 8192;
#pragma unroll
            for (int n2 = 0; n2 < 2; ++n2) { const int nt = 2 * tt + n2;
#pragma unroll
                for (int pt = 0; pt < 4; ++pt) {
                    f32x4 acc = (f32x4){0.f, 0.f, 0.f, 0.f};
#pragma unroll
                    for (int ks = 0; ks < 2; ++ks) acc = mfma16(ldsfrag(lds + M1_BGT, 144, 16 * nt + fr, 64 * ks + kb0), ldsfrag(XST, 144, 16 * pt + fr, 64 * ks + kb0), acc);
                    *(f32x4*)(sdst + (16 * pt + fr) * 128 + 16 * nt + 4 * fq) = acc;
                } }
        }
        __syncthreads();
    }
}

__device__ __forceinline__ void m1_sample_ssd_unit(const Params& P, const LayerPtrs& L, int l, int sq, LAS unsigned char* lds, int wave, int lane) {
    unsigned char* ws = P.ws;
    const bf16_t* proj = (const bf16_t*)(ws + WS_PROJ); const float* dtraw = (const float*)(ws + WS_DTRAW); float* ybuf = (float*)(ws + WS_YBUF);
    const int head = wave, g = head >> 2; const size_t row0 = (size_t)MP + (size_t)sq * 4;
    LAS float* SX = (LAS float*)(lds + wave * 5120); LAS float* SB = SX + 256; LAS float* SC = SX + 768;
    const float* stc = P.in[I_SSC] + ((size_t)l * NS + sq) * 3 * 1024;
#pragma unroll 1
    for (int slot = 0; slot < 5; ++slot) {
        const int chan = slot == 0 ? head * 64 + lane : (slot < 3 ? 512 + g * 128 + lane + 64 * (slot - 1) : 768 + g * 128 + lane + 64 * (slot - 3));
        const float w0 = L.scw[chan], w1 = L.scw[1024 + chan], w2 = L.scw[2048 + chan], w3 = L.scw[3072 + chan], bs = L.scb[chan];
        const float s0 = stc[chan], s1 = stc[1024 + chan], s2 = stc[2048 + chan];
        float xr[4];
#pragma unroll
        for (int t = 0; t < 4; ++t) xr[t] = bf2f(proj[(row0 + t) * PROJ_LD + O_XBC + chan]);
        float y[4];
        y[0] = siluf_(bs + w0 * s0 + w1 * s1 + w2 * s2 + w3 * xr[0]); y[1] = siluf_(bs + w0 * s1 + w1 * s2 + w2 * xr[0] + w3 * xr[1]);
        y[2] = siluf_(bs + w0 * s2 + w1 * xr[0] + w2 * xr[1] + w3 * xr[2]); y[3] = siluf_(bs + w0 * xr[0] + w1 * xr[1] + w2 * xr[2] + w3 * xr[3]);
        LAS float* dst = slot == 0 ? SX + lane : (slot < 3 ? SB + lane + 64 * (slot - 1) : SC + lane + 64 * (slot - 3));
        const int rs = slot == 0 ? 64 : 128;
#pragma unroll
        for (int t = 0; t < 4; ++t) dst[t * rs] = y[t];
        if (slot == 0 || (head & 3) == 0) {
#pragma unroll
            for (int k = 0; k < 3; ++k) P.out[OFF_SSC + (((size_t)l * NS + sq) * 3 + k) * 1024 + chan] = xr[k + 1];
        }
    }
    const float dtb_h = L.dtb[head];
    const float Ah = -__expf(L.alog[head]), Dh = L.sdd[head];
    LDS_WAIT(); asm volatile("" ::: "memory");
    const int p8 = lane >> 3, nq = lane & 7;
    const float* sin_ = P.in[I_SSS] + (((size_t)l * NS + sq) * 8 + head) * 8192;
    float* sout = P.out + OFF_SSS + (((size_t)l * NS + sq) * 8 + head) * 8192;
#pragma unroll 1
    for (int hf = 0; hf < 2; ++hf) {
        f32x4 S[4][4];
#pragma unroll
        for (int pg = 0; pg < 4; ++pg)
#pragma unroll
            for (int k = 0; k < 4; ++k) S[pg][k] = *(const f32x4*)(sin_ + (8 * (4 * hf + pg) + p8) * 128 + 16 * nq + 4 * k);
#pragma unroll 1
        for (int t = 0; t < 4; ++t) {
            const float dtv_t = softplusf_(dtraw[(row0 + t) * 8 + head] + dtb_h);
            const float dec = __expf(dtv_t * Ah);
            f32x4 Bv[4], Cv[4];
#pragma unroll
            for (int k = 0; k < 4; ++k) { Bv[k] = *(const LAS f32x4*)(SB + t * 128 + 16 * nq + 4 * k); Cv[k] = *(const LAS f32x4*)(SC + t * 128 + 16 * nq + 4 * k); }
#pragma unroll
            for (int pg = 0; pg < 4; ++pg) {
                const int p = 8 * (4 * hf + pg) + p8; const float xv = SX[t * 64 + p]; const float xp = xv * dtv_t;
                float ys = 0.f;
#pragma unroll
                for (int k = 0; k < 4; ++k) { S[pg][k] = S[pg][k] * dec + Bv[k] * xp; const f32x4 pc = S[pg][k] * Cv[k]; ys += (pc[0] + pc[1]) + (pc[2] + pc[3]); }
                ys += bperm(ys, lane ^ 1); ys += bperm(ys, lane ^ 2); ys += bperm(ys, lane ^ 4);
                if (nq == 0) ybuf[(row0 + t) * 512 + head * 64 + p] = ys + Dh * xv;
            }
        }
#pragma unroll
        for (int pg = 0; pg < 4; ++pg)
#pragma unroll
            for (int k = 0; k < 4; ++k) *(f32x4*)(sout + (8 * (4 * hf + pg) + p8) * 128 + 16 * nq + 4 * k) = S[pg][k];
    }
    LDS_WAIT(); asm volatile("" ::: "memory");
}

template <bool SAMPLE, bool WRITE_STATE>
__device__ __forceinline__ void lru_build_xc(const Params& P, const LayerPtrs& L, int l, int b, int c, int u, LAS unsigned char* lds, const int ci) {
    const bf16_t* proj = (const bf16_t*)(P.ws + WS_PROJ);
    const float w0 = L.lcw[ci], w1 = L.lcw[512 + ci], w2 = L.lcw[1024 + ci], w3 = L.lcw[1536 + ci], bs = L.lcb[ci];
    if constexpr (!SAMPLE) {
        const size_t rowb = (size_t)b * LP; const int t0 = 64 * c;
#pragma unroll
        for (int h = 0; h < 2; ++h) { float o[32]; conv4_run<32>(proj + O_LX + ci, rowb, t0 + 32 * h, w0, w1, w2, w3, bs, false, o);
#pragma unroll
            for (int i = 0; i < 32; ++i) *(LAS bf16_t*)(lds + M3_XC + (32 * h + i) * XC_RS + ci * 2) = (bf16_t)f2bf(o[i]); }
        if (WRITE_STATE && c == NCH - 1) {
#pragma unroll
            for (int k = 0; k < 3; ++k) P.out[OFF_PLC + (((size_t)l * NB + b) * 3 + k) * 512 + ci] = bf2f(proj[(rowb + LP - 3 + k) * PROJ_LD + O_LX + ci]);
        }
    } else {
#pragma unroll 4
        for (int s = 0; s < 16; ++s) { const int sq = 16 * u + s; const size_t row0 = (size_t)MP + (size_t)sq * 4;
            const float* stc = P.in[I_SLC] + ((size_t)l * NS + sq) * 3 * 512; const float s0 = stc[ci], s1 = stc[512 + ci], s2 = stc[1024 + ci];
            float xr[4];
#pragma unroll
            for (int t = 0; t < 4; ++t) xr[t] = bf2f(proj[(row0 + t) * PROJ_LD + O_LX + ci]);
            float y[4];
            y[0] = bs + w0 * s0 + w1 * s1 + w2 * s2 + w3 * xr[0]; y[1] = bs + w0 * s1 + w1 * s2 + w2 * xr[0] + w3 * xr[1];
            y[2] = bs + w0 * s2 + w1 * xr[0] + w2 * xr[1] + w3 * xr[2]; y[3] = bs + w0 * xr[0] + w1 * xr[1] + w2 * xr[2] + w3 * xr[3];
#pragma unroll
            for (int t = 0; t < 4; ++t) *(LAS bf16_t*)(lds + M3_XC + (4 * s + t) * XC_RS + ci * 2) = (bf16_t)f2bf(y[t]);
            if (WRITE_STATE) {
#pragma unroll
                for (int k = 0; k < 3; ++k) P.out[OFF_SLC + (((size_t)l * NS + sq) * 3 + k) * 512 + ci] = xr[k + 1];
            } }
    }
}

template <bool PASSB, bool SAMPLE>
__device__ __forceinline__ void lru_wave(const Params& P, const LayerPtrs& L, int l, int b, int c, int u, int len, LAS unsigned char* lds, int wave, int lane, float* gscr, float (&sq)[4][4]) {
    const int fr = lane & 15, fq = lane >> 4, h = wave; unsigned char* ws = P.ws;
    const bf16_t* proj = (const bf16_t*)(ws + WS_PROJ);
    float* lruA = (float*)(ws + WS_LRUA); float* lruH = (float*)(ws + WS_LRUH); const float* lruHin = (const float*)(ws + WS_LRUHIN);
    const size_t rowbase = SAMPLE ? (size_t)MP + 64 * (size_t)u : (size_t)b * LP + 64 * (size_t)c;
#pragma unroll 1
    for (int jt = 0; jt < 4; ++jt) {
        const int ch = 64 * h + 16 * jt + fr;
        bf16x8 qa[2], qx[2];
#pragma unroll
        for (int ks = 0; ks < 2; ++ks) { qa[ks] = *(const bf16x8*)(L.waT + ((size_t)(h * 64 + 16 * jt + fr) * 64 + 32 * ks + 8 * fq)); qx[ks] = *(const bf16x8*)(L.wxT + ((size_t)(h * 64 + 16 * jt + fr) * 64 + 32 * ks + 8 * fq)); }
        f32x4 ar[4], ai[4];
#pragma unroll
        for (int tt = 0; tt < 4; ++tt) { ar[tt] = (f32x4){0.f, 0.f, 0.f, 0.f}; ai[tt] = (f32x4){0.f, 0.f, 0.f, 0.f};
#pragma unroll
            for (int ks = 0; ks < 2; ++ks) { const bf16x8 pf = ldsfrag(lds + M3_XC, XC_RS, 16 * tt + fr, (64 * h + 32 * ks + 8 * fq) * 2); ar[tt] = mfma16(pf, qa[ks], ar[tt]); ai[tt] = mfma16(pf, qx[ks], ai[tt]); } }
        const float bav = L.ba[ch], bxv = L.bx[ch], sp = softplusf_(-L.apar[ch]);
        float av[4][4], bv[4][4], A4[4], B4[4];
#pragma unroll
        for (int tt = 0; tt < 4; ++tt) {
#pragma unroll
            for (int r = 0; r < 4; ++r) { const int t = 16 * tt + 4 * fq + r;
                const float rg = sigmoidf_(ar[tt][r] + bav), ig = sigmoidf_(ai[tt][r] + bxv); const float la = -8.0f * rg * sp; float a_ = __expf(la);
                const float mult = __builtin_amdgcn_sqrtf(fmaxf(neg_expm1(2.0f * la), 0.f)); const float xc = bf2f(*(const LAS bf16_t*)(lds + M3_XC + t * XC_RS + ch * 2)); float bb = mult * ig * xc;
                if (t >= len) { a_ = 1.f; bb = 0.f; }
                av[tt][r] = a_; bv[tt][r] = bb; }
            float A = av[tt][0], B = bv[tt][0];
#pragma unroll
            for (int r = 1; r < 4; ++r) { B = av[tt][r] * B + bv[tt][r]; A *= av[tt][r]; }
            A4[tt] = A; B4[tt] = B; }
        float cin[4];
        if constexpr (!SAMPLE) {
            float stv = PASSB ? lruHin[((size_t)b * NCH + c) * 512 + ch] : 0.f, prd = 1.f;
#pragma unroll
            for (int tt = 0; tt < 4; ++tt)
#pragma unroll
                for (int q = 0; q < 4; ++q) { const float Aq = bperm(A4[tt], fr + 16 * q), Bq = bperm(B4[tt], fr + 16 * q); if (q == fq) cin[tt] = stv; stv = Aq * stv + Bq; prd *= Aq; }
            if (!PASSB && fq == 0) { lruA[((size_t)b * NCH + c) * 512 + ch] = prd; lruH[((size_t)b * NCH + c) * 512 + ch] = stv; }
        } else {
#pragma unroll
            for (int tt = 0; tt < 4; ++tt) cin[tt] = P.in[I_SLH][((size_t)l * NS + 16 * u + 4 * tt + fq) * 512 + ch];
        }
        if constexpr (PASSB) {
#pragma unroll
            for (int tt = 0; tt < 4; ++tt) { float s = cin[tt];
#pragma unroll
                for (int r = 0; r < 4; ++r) { const int t = 16 * tt + 4 * fq + r; s = av[tt][r] * s + bv[tt][r];
                    const float gt = bf2f(proj[(rowbase + t) * PROJ_LD + O_LG + ch]); const float gv = s * gelu_tanh(gt); sq[tt][r] += gv * gv; gscr[t * 1024 + ch] = gv; }
                if (SAMPLE) P.out[OFF_SLH + ((size_t)l * NS + 16 * u + 4 * tt + fq) * 512 + ch] = s; }
        }
    }
}

__device__ __forceinline__ void m1_lru_unit(const Params& P, const LayerPtrs& L, int l, int b, int c, LAS unsigned char* lds, int wave, int lane) {
    lru_build_xc<false, false>(P, L, l, b, c, 0, lds, wave * 64 + lane);
    __syncthreads();
    float dummy[4][4];
    const int len = (LP - 64 * c) < 64 ? (LP - 64 * c) : 64;
    lru_wave<false, false>(P, L, l, b, c, 0, len, lds, wave, lane, nullptr, dummy);
    __syncthreads();
}

template <bool SAMPLE>
__device__ __forceinline__ void m3_unit(const Params& P, const LayerPtrs& L, int l, int b, int c, int u, LAS unsigned char* lds, int wave, int lane) {
    const int tid = wave * 64 + lane, fr = lane & 15, fq = lane >> 4, h = wave; unsigned char* ws = P.ws;
    const bf16_t* proj = (const bf16_t*)(ws + WS_PROJ); const float* csbuf = (const float*)(ws + WS_CS); const float* ybuf = (const float*)(ws + WS_YBUF);
    const float* states = (const float*)(ws + WS_STATES); bf16_t* mixed = (bf16_t*)(ws + WS_MIXED);
    const size_t rowbase = SAMPLE ? (size_t)MP + 64 * (size_t)u : (size_t)b * LP + 64 * (size_t)c;
    const int len = SAMPLE ? 64 : ((LP - 64 * c) < 64 ? (LP - 64 * c) : 64);
    lru_build_xc<SAMPLE, true>(P, L, l, b, c, u, lds, tid);
    if constexpr (!SAMPLE) {
        const int cc = tid & 255, half = tid >> 8, chan = 768 + cc; const size_t rowb = (size_t)b * LP;
        float o[32]; conv4_run<32>(proj + O_XBC + chan, rowb, 64 * c + 32 * half, L.scw[chan], L.scw[1024 + chan], L.scw[2048 + chan], L.scw[3072 + chan], L.scb[chan], true, o);
#pragma unroll
        for (int i = 0; i < 32; ++i) *(LAS bf16_t*)(lds + M3_CG + (cc >> 7) * 17408 + (32 * half + i) * 272 + (cc & 127) * 2) = (bf16_t)f2bf(o[i]);
    }
    __syncthreads();
    LAS float* SSQS = (LAS float*)(lds + M3_SSQS); LAS float* SSQL = (LAS float*)(lds + M3_SSQL);
    float* gscr = (float*)(ws + WS_GSCR) + (size_t)blockIdx.x * 65536;
    {
        float sq[4][4];
#pragma unroll
        for (int tt = 0; tt < 4; ++tt)
#pragma unroll
            for (int r = 0; r < 4; ++r) sq[tt][r] = 0.f;
        lru_wave<true, SAMPLE>(P, L, l, b, c, u, len, lds, wave, lane, gscr, sq);
#pragma unroll
        for (int tt = 0; tt < 4; ++tt)
#pragma unroll
            for (int r = 0; r < 4; ++r) { float v = sq[tt][r];
                v += bperm(v, lane ^ 1); v += bperm(v, lane ^ 2); v += bperm(v, lane ^ 4); v += bperm(v, lane ^ 8);
                if (fr == 0) SSQL[h * 64 + 16 * tt + 4 * fq + r] = v; }
    }
    {
        bf16x8 pfr[4][4];
        if constexpr (!SAMPLE) {
            const float* hp = states + (((size_t)b * NCH + c) * 8 + h) * 8192;
#pragma unroll
            for (int pt = 0; pt < 4; ++pt)
#pragma unroll
                for (int ks = 0; ks < 4; ++ks) { const float* src = hp + (16 * pt + fr) * 128 + 32 * ks + 8 * fq; const f32x4 lo = *(const f32x4*)src, hi = *(const f32x4*)(src + 4);
                    u32x4 pk; pk.x = pk2(lo[0], lo[1]); pk.y = pk2(lo[2], lo[3]); pk.z = pk2(hi[0], hi[1]); pk.w = pk2(hi[2], hi[3]);
                    pfr[pt][ks] = __builtin_bit_cast(bf16x8, pk); }
        }
        const LAS unsigned char* CG = lds + M3_CG + (h >> 2) * 17408;
#pragma unroll 1
        for (int tt = 0; tt < 4; ++tt) {
            f32x4 acc[4];
#pragma unroll
            for (int pt = 0; pt < 4; ++pt) acc[pt] = (f32x4){0.f, 0.f, 0.f, 0.f};
            if constexpr (!SAMPLE) {
#pragma unroll
                for (int ks = 0; ks < 4; ++ks) { const bf16x8 cf = ldsfrag(CG, 272, 16 * tt + fr, 64 * ks + 16 * fq);
#pragma unroll
                    for (int pt = 0; pt < 4; ++pt) acc[pt] = mfma16(pfr[pt][ks], cf, acc[pt]); }
            }
            const int t = 16 * tt + fr; const size_t row = rowbase + t; const float e = SAMPLE ? 0.f : __expf(csbuf[row * 8 + h]);
            float sq = 0.f;
#pragma unroll
            for (int pt = 0; pt < 4; ++pt) {
                const f32x4 yb = *(const f32x4*)(ybuf + row * 512 + h * 64 + 16 * pt + 4 * fq);
                const u32x2 zz = *(const u32x2*)(proj + row * PROJ_LD + O_Z + h * 64 + 16 * pt + 4 * fq);
                const float z0 = bf2f(zz.x & 0xffffu), z1 = bf2f(zz.x >> 16), z2 = bf2f(zz.y & 0xffffu), z3 = bf2f(zz.y >> 16);
                f32x4 y = yb + acc[pt] * e;
                y[0] *= siluf_(z0); y[1] *= siluf_(z1); y[2] *= siluf_(z2); y[3] *= siluf_(z3);
                sq += (y[0] * y[0] + y[1] * y[1]) + (y[2] * y[2] + y[3] * y[3]);
                *(f32x4*)(gscr + t * 1024 + 512 + h * 64 + 16 * pt + 4 * fq) = y;
            }
            sq += bperm(sq, lane ^ 16); sq += bperm(sq, lane ^ 32);
            if (fq == 0) SSQS[h * 64 + t] = sq;
        }
    }
    VM_WAIT(); LDS_WAIT();
    __syncthreads();
    LAS float* RSTD = (LAS float*)(lds + M3_XC);
    if (tid < 128) { const int which = tid >> 6, t = tid & 63; const LAS float* src = which ? SSQS : SSQL; float sm = 0.f;
#pragma unroll
        for (int w = 0; w < 8; ++w) sm += src[w * 64 + t];
        RSTD[which * 64 + t] = rsqrtf(sm * (1.0f / 512.0f) + EPS); }
    __syncthreads();
#pragma unroll 4
    for (int i = 0; i < 16; ++i) {
        const int seg = tid + 512 * i, row = seg >> 7, c8 = (seg & 127) * 8;
        if (row < len) {
            const float rs = RSTD[(c8 >> 9) * 64 + row]; const float* gp = (c8 < 512 ? L.lon + c8 : L.son + (c8 - 512));
            const f32x4 a0 = *(const f32x4*)(gscr + row * 1024 + c8), a1 = *(const f32x4*)(gscr + row * 1024 + c8 + 4), g0 = *(const f32x4*)gp, g1 = *(const f32x4*)(gp + 4);
            const f32x4 o0 = a0 * rs * g0, o1 = a1 * rs * g1;
            u32x4 w; w.x = pk2(o0[0], o0[1]); w.y = pk2(o0[2], o0[3]); w.z = pk2(o1[0], o1[1]); w.w = pk2(o1[2], o1[3]);
            *(u32x4*)(mixed + (rowbase + row) * D + c8) = w;
        }
    }
    __syncthreads();
}

__device__ __forceinline__ void m2_phase(const Params& P, int l, const int tid, const int dry) {
    unsigned char* ws = P.ws; float* states = (float*)(ws + WS_STATES); const float* cdec = (const float*)(ws + WS_CDEC);
    for (int e4 = blockIdx.x * 512 + tid; e4 < NB * 8 * 2048; e4 += gridDim.x * 512) {
        const int bh = e4 >> 11, off = (e4 & 2047) * 4, b = bh >> 3, h = bh & 7;
        f32x4 run = (f32x4){0.f, 0.f, 0.f, 0.f};
#pragma unroll 3
        for (int c = 0; c < NCH; ++c) { float* p = states + (((size_t)b * NCH + c) * 8 + h) * 8192 + off; const f32x4 sc = *(const f32x4*)p; if (!dry) *(f32x4*)p = run; else *(f32x4*)((float*)(ws + WS_GSCR) + ((size_t)(p - states) & ((size_t)(1u << 24) - 4))) = run; const float d = cdec[((size_t)b * NCH + c) * 8 + h]; run = run * d + sc; }
        if (!dry || run[0] == 12345.678f) *(f32x4*)(P.out + OFF_PSS + (((size_t)l * NB + b) * 8 + h) * 8192 + off) = run;
    }
    if (dry) return;
    const float* lruA = (const float*)(ws + WS_LRUA); const float* lruH = (const float*)(ws + WS_LRUH); float* lruHin = (float*)(ws + WS_LRUHIN);
    for (int i = blockIdx.x * 512 + tid; i < NB * 512; i += gridDim.x * 512) {
        const int b = i >> 9, ch = i & 511; float hv = 0.f;
        for (int c = 0; c < NCH; ++c) { const size_t o = ((size_t)b * NCH + c) * 512 + ch; lruHin[o] = hv; hv = lruA[o] * hv + lruH[o]; }
        P.out[OFF_PLH + ((size_t)l * NB + b) * 512 + ch] = hv;
    }
}


__device__ __forceinline__ void ffn_sample_phase(const Params& P, int l, const int tid) {
    unsigned char* ws = P.ws; const float* us = (const float*)(ws + WS_USAMP); bf16_t* abuf = (bf16_t*)(ws + WS_ABUF);
    const float* cw = P.in[I_FCW] + (size_t)l * 3 * 6144; const float* cb = P.in[I_FCB] + (size_t)l * 6144; const float* st = P.in[I_SFC] + (size_t)l * NS * 2 * 6144;
    float* sf = P.out + OFF_SFC + (size_t)l * NS * 2 * 6144;
    for (int i = blockIdx.x * 512 + tid; i < NS * 768; i += gridDim.x * 512) {
        const int sq = i / 768, c = (i % 768) * 4;
        f32x4 res[4];
#pragma unroll
        for (int half = 0; half < 2; ++half) {
            const int col = c + 3072 * half;
            const f32x4 w0 = *(const f32x4*)(cw + col), w1 = *(const f32x4*)(cw + 6144 + col), w2 = *(const f32x4*)(cw + 2 * 6144 + col), bb = *(const f32x4*)(cb + col);
            f32x4 p2 = *(const f32x4*)(st + ((size_t)sq * 2) * 6144 + col), p1 = *(const f32x4*)(st + ((size_t)sq * 2 + 1) * 6144 + col);
#pragma unroll
            for (int t = 0; t < 4; ++t) {
                const f32x4 uu = *(const f32x4*)(us + ((size_t)sq * 4 + t) * 6144 + col);
                f32x4 cv = bb + w0 * p2 + w1 * p1 + w2 * uu;
                if (half == 0) { cv[0] = gelu_tanh(cv[0]); cv[1] = gelu_tanh(cv[1]); cv[2] = gelu_tanh(cv[2]); cv[3] = gelu_tanh(cv[3]); res[t] = cv; } else res[t] = res[t] * cv;
                if (t >= 2) *(f32x4*)(sf + ((size_t)sq * 2 + (t - 2)) * 6144 + col) = uu;
                p2 = p1; p1 = uu;
            }
        }
#pragma unroll
        for (int t = 0; t < 4; ++t) { u32x2 w; w.x = pk2(res[t][0], res[t][1]); w.y = pk2(res[t][2], res[t][3]); *(u32x2*)(abuf + ((size_t)MP + (size_t)sq * 4 + t) * DFF + c) = w; }
    }
}

__device__ __forceinline__ void final_phase(const Params& P, int wave, int lane) {
    const bf16_t* xb = (const bf16_t*)(P.ws + WS_XB); const float* gn = P.in[I_NFIN];
    const int gw = blockIdx.x * 8 + wave, NGW = gridDim.x * 8;
    for (int m = gw; m < MT; m += NGW) {
        float* dst;
        if (m < MP) { const int b = m / LP, t = m % LP; if (t < NMETA) continue; dst = P.out + OFF_YP + ((size_t)b * SEQ + (t - NMETA)) * D; }
        else dst = P.out + OFF_YS + (size_t)(m - MP) * D;
        f32x4 v[4]; float s = 0.f;
#pragma unroll
        for (int j = 0; j < 4; ++j) { const u32x2 w = *((const u32x2*)(xb + (size_t)m * D) + lane + 64 * j); v[j][0] = bf2f(w.x & 0xffffu); v[j][1] = bf2f(w.x >> 16); v[j][2] = bf2f(w.y & 0xffffu); v[j][3] = bf2f(w.y >> 16);
            s += (v[j][0] * v[j][0] + v[j][1] * v[j][1]) + (v[j][2] * v[j][2] + v[j][3] * v[j][3]); }
        const float rs = rsqrtf(wave_sum(s, lane) * (1.0f / 1024.0f) + EPS);
#pragma unroll
        for (int j = 0; j < 4; ++j) { const f32x4 g4 = *((const f32x4*)gn + lane + 64 * j); *((f32x4*)dst + lane + 64 * j) = v[j] * rs * g4; }
    }
}

__global__ void __launch_bounds__(512, 2) hymba_fwd(Params P) {
    extern __shared__ __attribute__((aligned(16))) unsigned char lds_raw[];
    LAS unsigned char* lds = (LAS unsigned char*)lds_raw;
    int wave0 = __builtin_amdgcn_readfirstlane((int)threadIdx.x >> 6);
    asm volatile("" : "+s"(wave0));
#define MYTID() (wave0 * 64 + (int)__builtin_amdgcn_mbcnt_hi(~0u, __builtin_amdgcn_mbcnt_lo(~0u, 0u)))
    const int G = gridDim.x;
    { const int tid = MYTID(); for (int i = tid; i < (LDS_BYTES - LDS_MISC) / 4; i += 512) ((LAS unsigned*)(lds + LDS_MISC))[i] = 0u; }
    __syncthreads();
    { unsigned char* w_ = P.ws; asm volatile("" : "+s"(w_)); w_ = glob(w_); (void)xcd_barrier_post((unsigned*)(w_ + WS_CTL) + 4096, (volatile LAS unsigned*)(lds + LDS_MISC) + 8, MYTID()); }
#define GRID_BAR() do { unsigned char* w_ = P.ws; asm volatile("" : "+s"(w_)); w_ = glob(w_); XcdBarrier b_; b_.bar = (unsigned*)(w_ + WS_CTL) + 4096; b_.x = xb_xcc_id(); b_.st = (volatile LAS unsigned*)(lds + LDS_MISC) + 8; \
        int t_ = MYTID(); asm volatile("" : "+v"(t_)); xcd_barrier(b_, t_); } while (0)
#define PHASE_ENV() Params Q = P; asm volatile("" : "+s"(Q.ws), "+s"(Q.out)); Q.ws = glob(Q.ws); Q.out = glob(Q.out); _Pragma("unroll") for (int i_ = 0; i_ < 31; ++i_) Q.in[i_] = glob(Q.in[i_]); unsigned char* ws = Q.ws; (void)ws; int ptid = MYTID(); asm volatile("" : "+v"(ptid)); const int lane = ptid & 63, wave = __builtin_amdgcn_readfirstlane(ptid >> 6); (void)lane; (void)wave

    if (PH_MASK & 1) { PHASE_ENV(); if (REP_MASK & 256) p0_prologue(Q, lds, wave, lane, ptid); p0_prologue(Q, lds, wave, lane, ptid); }
    { cg::grid_group grid = cg::this_grid(); grid.sync(); }
    GRID_BAR();

#pragma unroll 1
    for (int l = 0; l < DEPTH; ++l) {
        if (PH_MASK & 2) {
            PHASE_ENV();
            pg8::Gemm g{(const bf16_t*)(ws + WS_XB), (const bf16_t*)(ws + WS_W + (size_t)l * W_LAYER + W_IN), D, 67, 11, (long)256 * D * 2, (long)128 * D * 2, 0};
            pg8::StaticOrder S; S.init(67, 11, G, (int)blockIdx.x, (REP_MASK & 1) ? 2 : 1);
            pg8::EpiIn E{(bf16_t*)(ws + WS_PROJ), (float*)(ws + WS_DTRAW), (const float*)(ws + WS_SS) + (size_t)(2 * l) * MPAD * 16};
            pg8::gemm_phase<pg8::EpiIn, pg8::StaticOrder, true, true>(lds, g, S, E, ptid);
        }
        GRID_BAR();
        {
            PHASE_ENV();
            const LayerPtrs L = layer_ptrs(Q, l);
            constexpr int N_SSD = NB * NCH * 2, N_LRU = NB * NCH, N_SMP = NS;
            for (int it_ = blockIdx.x; it_ < (N_SSD + N_LRU + N_SMP) * ((REP_MASK & 2) ? 2 : 1); it_ += G) {
                const int it = it_ % (N_SSD + N_LRU + N_SMP);
                if (it < N_SSD) { if (PH_MASK & 4) { const int b = it / (NCH * 2), r = it % (NCH * 2); m1_ssd_unit(Q, L, l, b, r >> 1, r & 1, lds, wave, lane); } }
                else if (it < N_SSD + N_LRU) { const int r = it - N_SSD; if (PH_MASK & 8) m1_lru_unit(Q, L, l, r / NCH, r % NCH, lds, wave, lane); }
                else { if (PH_MASK & 16) m1_sample_ssd_unit(Q, L, l, it - N_SSD - N_LRU, lds, wave, lane); __syncthreads(); }
            }
        }
        GRID_BAR();
        if (REP_MASK & 128) { for (int eb_ = 0; eb_ < 10; ++eb_) GRID_BAR(); }
        if (PH_MASK & 32) { PHASE_ENV(); if (REP_MASK & 64) m2_phase(Q, l, ptid, 1); m2_phase(Q, l, ptid, 0); }
        GRID_BAR();
        {
            PHASE_ENV();
            const LayerPtrs L = layer_ptrs(Q, l);
            constexpr int N_PR = NB * NCH, N_SM = MS / 64;
            for (int it_ = blockIdx.x; it_ < (N_PR + N_SM) * ((REP_MASK & 4) ? 2 : 1); it_ += G) {
                const int it = it_ % (N_PR + N_SM);
                if (it < N_PR) { if (PH_MASK & 64) m3_unit<false>(Q, L, l, it / NCH, it % NCH, 0, lds, wave, lane); }
                else if (PH_MASK & 128) m3_unit<true>(Q, L, l, 0, 0, it - N_PR, lds, wave, lane);
            }
        }
        GRID_BAR();
        if (PH_MASK & 256) {
            PHASE_ENV();
            pg8::Gemm g{(const bf16_t*)(ws + WS_MIXED), (const bf16_t*)(ws + WS_W + (size_t)l * W_LAYER + W_OUT), D, 67, 4, (long)256 * D * 2, (long)128 * D * 2, 0};
            pg8::StaticOrder S; S.init(67, 4, G, (int)blockIdx.x);
            pg8::EpiRes E{(bf16_t*)(ws + WS_XB), (float*)(ws + WS_SS) + (size_t)(2 * l + 1) * MPAD * 16};
            pg8::gemm_phase<pg8::EpiRes, pg8::StaticOrder, true, true>(lds, g, S, E, ptid);
        }
        GRID_BAR();
        if (PH_MASK & 512) {
            PHASE_ENV();
            pg8::Gemm g{(const bf16_t*)(ws + WS_XB) - 2 * D, (const bf16_t*)(ws + WS_W + (size_t)l * W_LAYER + W_UP), D, 69, 24, (long)248 * D * 2, (long)124 * D * 2, 1};
            pg8::StaticOrder S; S.init(69, 24, G, (int)blockIdx.x, (REP_MASK & (8 | 512)) ? 2 : 1);
            pg8::EpiUp E{(bf16_t*)(ws + WS_ABUF), (const float*)(ws + WS_SS) + (size_t)(2 * l + 1) * MPAD * 16, Q.in[I_FCW] + (size_t)l * 3 * 6144, Q.in[I_FCB] + (size_t)l * 6144,
                         Q.out + OFF_PFC + (size_t)l * NB * 2 * 6144, (float*)(ws + WS_USAMP)};
            pg8::gemm_phase<pg8::EpiUp, pg8::StaticOrder, true, true>(lds, g, S, E, ptid);
        }
        GRID_BAR();
        if (PH_MASK & 512) { PHASE_ENV(); ffn_sample_phase(Q, l, ptid); }
        GRID_BAR();
        if (PH_MASK & 1024) {
            PHASE_ENV();
            pg8::Gemm g{(const bf16_t*)(ws + WS_ABUF), (const bf16_t*)(ws + WS_W + (size_t)l * W_LAYER + W_DOWN), DFF, 67, 4, (long)256 * DFF * 2, (long)128 * DFF * 2, 0};
            pg8::StaticOrder S; S.init(67, 4, G, (int)blockIdx.x);
            pg8::EpiRes E{(bf16_t*)(ws + WS_XB), (float*)(ws + WS_SS) + (size_t)(2 * l + 2) * MPAD * 16};
            pg8::gemm_phase<pg8::EpiRes, pg8::StaticOrder, true, true>(lds, g, S, E, ptid);
        }
        GRID_BAR();
    }
    if (PH_MASK & 2048) { PHASE_ENV(); final_phase(Q, wave, lane); }
}

extern "C" void kernel_launch(void* const* d_in, const int* in_sizes, int n_in, void* d_out, int out_size, void* d_ws, size_t ws_size, hipStream_t stream) {
    static int grid = 0;
    if (grid == 0) {
        if (n_in != 31 || (size_t)out_size != OUT_TOTAL || ws_size < WS_END) { fprintf(stderr, "kernel_launch: unexpected problem (n_in %d, out %d, ws %zu)\n", n_in, out_size, ws_size); grid = -1; return; }
        int dev = 0, cus = 0, per_cu = 0;
        if (hipGetDevice(&dev) != hipSuccess || hipDeviceGetAttribute(&cus, hipDeviceAttributeMultiprocessorCount, dev) != hipSuccess) { grid = -1; return; }
        if (hipFuncSetAttribute((const void*)hymba_fwd, hipFuncAttributeMaxDynamicSharedMemorySize, LDS_BYTES) != hipSuccess) { fprintf(stderr, "kernel_launch: hipFuncSetAttribute failed\n"); grid = -1; return; }
        if (hipOccupancyMaxActiveBlocksPerMultiprocessor(&per_cu, (const void*)hymba_fwd, 512, LDS_BYTES) != hipSuccess || per_cu < 1) { fprintf(stderr, "kernel_launch: occupancy query says %d\n", per_cu); per_cu = 1; }
        (void)hipGetLastError();
        grid = cus * (per_cu > 1 ? 1 : per_cu);
    }
    if (grid < 0) return;
    (void)hipMemsetAsync((char*)d_ws + WS_CTL, 0, CTL_BYTES, stream);
    Params p{};
    for (int i = 0; i < 31; ++i) p.in[i] = (const float*)d_in[i];
    p.out = (float*)d_out; p.ws = (unsigned char*)d_ws;
    void* args[] = {&p};
    hipError_t e = hipLaunchCooperativeKernel((const void*)hymba_fwd, dim3(grid), dim3(512), args, LDS_BYTES, stream);
    if (e != hipSuccess) fprintf(stderr, "kernel_launch: cooperative launch failed: %s (grid %d)\n", hipGetErrorString(e), grid);
}
```

```cpp
#include <hip/hip_runtime.h>
#include <hip/hip_cooperative_groups.h>
#include <cstdio>
#include <cstdint>
namespace cg = cooperative_groups;
#ifndef PH_MASK
#define PH_MASK 0xFFF
#endif
#ifndef REP_MASK
#define REP_MASK 0
#endif

#define LAS __attribute__((address_space(3)))
#define GAS __attribute__((address_space(1)))
template <class T> __device__ __forceinline__ T* glob(T* p) { return (T*)(GAS T*)p; }
typedef unsigned short bf16_t;
typedef short bf16x8 __attribute__((ext_vector_type(8)));
typedef float f32x4 __attribute__((ext_vector_type(4)));
typedef float f32x2 __attribute__((ext_vector_type(2)));
typedef unsigned u32x4 __attribute__((ext_vector_type(4)));
typedef unsigned u32x2 __attribute__((ext_vector_type(2)));

constexpr int D = 1024, DEPTH = 4, NB = 8, SEQ = 2048, NMETA = 16, LP = SEQ + NMETA, NS = 128, LS = 4;
constexpr int MP = NB * LP, MS = NS * LS, MT = MP + MS, MPAD = 17152;
constexpr int NH = 8, HD = 64, SST = 128, DFF = 3072, PIN = 2568, PINPAD = 2816;
constexpr int O_LX = 0, O_LG = 512, O_Z = 1024, O_XBC = 1536, PROJ_LD = 2560;
constexpr int NCH = 33;
constexpr float EPS = 1e-6f;

constexpr size_t OFF_YP = 0, OFF_YS = OFF_YP + (size_t)NB * SEQ * D, OFF_PLC = OFF_YS + (size_t)MS * D, OFF_PLH = OFF_PLC + (size_t)DEPTH * NB * 3 * 512,
                 OFF_PSC = OFF_PLH + (size_t)DEPTH * NB * 512, OFF_PSS = OFF_PSC + (size_t)DEPTH * NB * 3 * 1024, OFF_PFC = OFF_PSS + (size_t)DEPTH * NB * 8 * 8192,
                 OFF_SLC = OFF_PFC + (size_t)DEPTH * NB * 2 * 6144, OFF_SLH = OFF_SLC + (size_t)DEPTH * NS * 3 * 512, OFF_SSC = OFF_SLH + (size_t)DEPTH * NS * 512,
                 OFF_SSS = OFF_SSC + (size_t)DEPTH * NS * 3 * 1024, OFF_SFC = OFF_SSS + (size_t)DEPTH * NS * 8 * 8192, OUT_TOTAL = OFF_SFC + (size_t)DEPTH * NS * 2 * 6144;

constexpr size_t MiB = 1u << 20;
constexpr size_t WS_CTL = 0, CTL_BYTES = 1 * MiB;
constexpr size_t WS_SS = 495 * MiB;
constexpr size_t WS_LRUW = 2 * MiB;
constexpr size_t WS_DTRAW = 3 * MiB, WS_CS = 4 * MiB, WS_CDEC = 5 * MiB, WS_LRUA = 6 * MiB, WS_LRUH = 7 * MiB, WS_LRUHIN = 8 * MiB;
constexpr size_t WS_W = 9 * MiB;
constexpr size_t W_LAYER = 25 * MiB + MiB / 2, W_IN = 0, W_OUT = 5 * MiB + MiB / 2, W_UP = 7 * MiB + MiB / 2, W_DOWN = 19 * MiB + MiB / 2;
constexpr size_t WS_X = 111 * MiB;
constexpr size_t WS_SINB = WS_X;
constexpr size_t WS_XB = 178 * MiB + 8192;
constexpr size_t WS_PROJ = 212 * MiB;
constexpr size_t WS_YBUF = 296 * MiB;
constexpr size_t WS_STATES = 330 * MiB;
constexpr size_t WS_MIXED = 397 * MiB;
constexpr size_t WS_ABUF = 296 * MiB;
constexpr size_t WS_GSCR = 431 * MiB;
constexpr size_t WS_USAMP = WS_GSCR;
constexpr size_t WS_END = 505 * MiB;
static_assert(WS_W + DEPTH * W_LAYER <= WS_X && WS_X + (size_t)MPAD * D * 4 <= 178 * MiB && WS_XB + (size_t)MPAD * D * 2 <= WS_PROJ, "ws map 1");
static_assert(WS_PROJ + (size_t)MPAD * PROJ_LD * 2 <= WS_YBUF && WS_YBUF + (size_t)MT * 512 * 4 <= WS_STATES && WS_STATES + (size_t)NB * NCH * 8 * 8192 * 4 <= WS_MIXED, "ws map 2");
static_assert(WS_SS + (size_t)9 * MPAD * 16 * 4 <= WS_END && WS_GSCR + 64 * MiB <= WS_SS && WS_USAMP + (size_t)MS * 6144 * 4 <= WS_SS && WS_MIXED + (size_t)MPAD * D * 2 <= WS_GSCR && WS_ABUF + (size_t)MPAD * DFF * 2 <= WS_MIXED, "ws map 3");

__device__ __forceinline__ float bf2f(unsigned b) { return __uint_as_float(b << 16); }
__device__ __forceinline__ unsigned f2bf(float f) { unsigned u = __float_as_uint(f); return (u + 0x7fffu + ((u >> 16) & 1u)) >> 16; }
__device__ __forceinline__ unsigned pk2(float lo, float hi) { return f2bf(lo) | (f2bf(hi) << 16); }
__device__ __forceinline__ float sigmoidf_(float x) { return __builtin_amdgcn_rcpf(1.0f + __builtin_amdgcn_exp2f(-1.4426950408889634f * x)); }
__device__ __forceinline__ float siluf_(float x) { return x * sigmoidf_(x); }
__device__ __forceinline__ float softplusf_(float x) { const float e = __builtin_amdgcn_exp2f(-1.4426950408889634f * __builtin_fabsf(x)); const float p = e * (1.0f - e * (0.5f - e * (0.33333334f - e * (0.25f - e * 0.2f)))); const float q = 0.6931471805599453f * __builtin_amdgcn_logf(1.0f + e); return fmaxf(x, 0.f) + (e < 0.0625f ? p : q); }
__device__ __forceinline__ float gelu_tanh(float x) { const float e = __builtin_amdgcn_exp2f(x * __builtin_fmaf(-0.10294324f, x * x, -2.3022082f)); return x * __builtin_amdgcn_rcpf(1.0f + e); }
__device__ __forceinline__ float neg_expm1(float y) { const float p = -y * (1.0f + y * (0.5f + y * (0.16666667f + y * (0.041666668f + y * (0.0083333338f + y * 0.0013888889f))))); const float q = 1.0f - __builtin_amdgcn_exp2f(1.4426950408889634f * y); return y > -0.25f ? p : q; }
__device__ __forceinline__ float dpp_ror1(float v) { return __int_as_float(__builtin_amdgcn_mov_dpp(__float_as_int(v), 0x121, 0xF, 0xF, false)); }
__device__ __forceinline__ float dpp_ror2(float v) { return __int_as_float(__builtin_amdgcn_mov_dpp(__float_as_int(v), 0x122, 0xF, 0xF, false)); }
__device__ __forceinline__ float bperm(float v, int srclane) { return __int_as_float(__builtin_amdgcn_ds_bpermute(srclane << 2, __float_as_int(v))); }
__device__ __forceinline__ float rowss(const float* ss, int row) { const f32x4* p = (const f32x4*)(ss + (size_t)row * 16); const f32x4 a = p[0], b = p[1], c = p[2], d = p[3]; return (((a[0] + a[1]) + (a[2] + a[3])) + ((b[0] + b[1]) + (b[2] + b[3]))) + (((c[0] + c[1]) + (c[2] + c[3])) + ((d[0] + d[1]) + (d[2] + d[3]))); }
__device__ __forceinline__ float conv3_dpp(float um, float upm, float w0, float w1, float w2, float b) {
    float o = __builtin_fmaf(w2, um, b);
    asm("s_nop 1\n\t"
        "v_fmac_f32_dpp %0, %1, %3 row_shr:1 row_mask:0xf bank_mask:0xf\n\t"
        "v_fmac_f32_dpp %0, %2, %3 row_shl:15 row_mask:0xf bank_mask:0xf\n\t"
        "v_fmac_f32_dpp %0, %1, %4 row_shr:2 row_mask:0xf bank_mask:0xf\n\t"
        "v_fmac_f32_dpp %0, %2, %4 row_shl:14 row_mask:0xf bank_mask:0xf"
        : "+v"(o) : "v"(um), "v"(upm), "v"(w1), "v"(w0));
    return o;
}
__device__ __forceinline__ float conv3_dpp_first(float um, float w0, float w1, float w2, float b) {
    float o = __builtin_fmaf(w2, um, b);
    asm("s_nop 1\n\t"
        "v_fmac_f32_dpp %0, %1, %2 row_shr:1 row_mask:0xf bank_mask:0xf\n\t"
        "v_fmac_f32_dpp %0, %1, %3 row_shr:2 row_mask:0xf bank_mask:0xf"
        : "+v"(o) : "v"(um), "v"(w1), "v"(w0));
    return o;
}
__device__ __forceinline__ float wave_sum(float v, int lane) {
#pragma unroll
    for (int o = 1; o < 64; o <<= 1) v += bperm(v, lane ^ o);
    return v;
}
#define LDS_WAIT() asm volatile("s_waitcnt lgkmcnt(0)" ::: "memory")
#define VM_WAIT() asm volatile("s_waitcnt vmcnt(0)" ::: "memory")
__device__ __forceinline__ f32x4 mfma16(bf16x8 p, bf16x8 q, f32x4 c) { return __builtin_amdgcn_mfma_f32_16x16x32_bf16(p, q, c, 0, 0, 0); }
__device__ __forceinline__ bf16x8 ldsfrag(const LAS unsigned char* img, int rs, int row, int kbyte) { return *(const LAS bf16x8*)(img + row * rs + kbyte); }

namespace pg8 {
#define PG8_LAS __attribute__((address_space(3)))
constexpr int BM = 256, BK = 64, HALF = 128, HTB = HALF * BK * 2, STAGE_BYTES = 8 * HTB, NXCD = 8, WGM = 8;
__host__ __device__ __forceinline__ int lds_byte(int r, int c) { const int st = (r >> 4) * 2 + (c >> 5), rr = r & 15, cc = c & 31, ob = rr * 64 + cc * 2; return st * 1024 + (ob ^ (((ob >> 9) & 1) << 5)); }
__host__ __device__ __forceinline__ void stage_rc(int b, int& R, int& C) { const int st = b / 1024, sb = b % 1024, swz = sb ^ (((sb >> 9) & 1) << 5); R = (st >> 1) * 16 + swz / 64; C = (st & 1) * 32 + (swz % 64) / 2; }
__host__ __device__ __forceinline__ int perm32(int rho) { const int n = rho >> 4, i = rho & 15; return 8 * (i >> 2) + 4 * n + (i & 3); }
struct Unit { int pm, pn, dry; };
struct Gemm { const bf16_t* A; const bf16_t* Bt; int K, nM, nN; long a_tstep, a_hstep; int ovl; };
struct StaticOrder {
    int nM, nN, nwg, G, c, rep;
    __device__ __forceinline__ void init(int nM_, int nN_, int G_, int c_, int rep_ = 1) { nM = nM_; nN = nN_; nwg = nM * nN; G = G_; c = c_; rep = rep_; }
    __device__ __forceinline__ bool next(int i, Unit& u) const {
        const long L = (long)i * G + c; if (L >= (long)nwg * rep) return false;
        int wgid = (int)(L % nwg); u.dry = (L >= nwg) ? 1 : 0; { const int q = nwg / NXCD, r = nwg % NXCD, xcd = wgid % NXCD, off = wgid / NXCD; wgid = (xcd < r ? xcd * (q + 1) : r * (q + 1) + (xcd - r) * q) + off; }
        const int nig = WGM * nN, gid = wgid / nig, fm = gid * WGM, gsz = (nM - fm) < WGM ? (nM - fm) : WGM;
        u.pm = fm + ((wgid % nig) % gsz); u.pn = (wgid % nig) / gsz; return true;
    }
    __device__ __forceinline__ void a_ready(const Unit&) const {}
    __device__ __forceinline__ void done(const Unit&) const {}
};
struct ProdOrder : StaticOrder {
    unsigned* cnt; int tid;
    __device__ __forceinline__ bool next(int i, Unit& u) const {
        const long L = (long)i * G + c; if (L >= nwg) return false;
        u.dry = 0;
        const int n0 = 64 * nN;
        if (L < n0) { int wgid = (int)L; { const int q = n0 / NXCD, xcd = wgid % NXCD, off = wgid / NXCD; wgid = xcd * q + off; }
            const int nig = WGM * nN; u.pm = (wgid / nig) * WGM + ((wgid % nig) % WGM); u.pn = (wgid % nig) / WGM; }
        else { const int t = (int)L - n0; u.pm = 64 + t / nN; u.pn = t % nN; }
        return true;
    }
    __device__ __forceinline__ void done(const Unit& u) const {
        asm volatile("s_waitcnt vmcnt(0)" ::: "memory");
        __builtin_amdgcn_s_barrier();
        if (tid == 0) { __builtin_amdgcn_fence(__ATOMIC_RELEASE, "agent"); asm volatile("s_waitcnt vmcnt(0)" ::: "memory");
            __hip_atomic_fetch_add(cnt + 64 * u.pm, 1u, __ATOMIC_RELAXED, __HIP_MEMORY_SCOPE_AGENT); }
    }
};
struct ConsOrder : StaticOrder {
    unsigned* cnt; unsigned need; unsigned* tmo; int ovl, wid, nP;
    __device__ __forceinline__ void a_ready(const Unit& u) const {
        if (need == 0u) return;
        if (wid == 0) {
            int p0 = u.pm, p1 = u.pm;
            if (ovl) { int r0 = 248 * u.pm - 2; r0 = r0 < 0 ? 0 : r0; p0 = r0 >> 8; p1 = (248 * u.pm + 253) >> 8; p1 = p1 > nP - 1 ? nP - 1 : p1; }
            unsigned spins = 0;
            for (int p = p0; p <= p1; ++p) {
                while ((unsigned)__builtin_amdgcn_readfirstlane((int)__hip_atomic_load(cnt + 64 * p, __ATOMIC_RELAXED, __HIP_MEMORY_SCOPE_AGENT)) < need) {
                    if (++spins > (1u << 15)) { __hip_atomic_store(tmo, 1u, __ATOMIC_RELAXED, __HIP_MEMORY_SCOPE_AGENT); break; }
                    if ((spins & 255u) == 0u && __builtin_amdgcn_readfirstlane((int)__hip_atomic_load(tmo, __ATOMIC_RELAXED, __HIP_MEMORY_SCOPE_AGENT)) != 0) break;
                    __builtin_amdgcn_s_sleep(4); }
            }
            __builtin_amdgcn_fence(__ATOMIC_ACQUIRE, "agent");
            asm volatile("s_waitcnt vmcnt(0)" ::: "memory");
        }
        asm volatile("" ::: "memory"); __builtin_amdgcn_s_barrier(); asm volatile("" ::: "memory");
    }
};
__device__ __forceinline__ unsigned cvt_pk_bf16(float lo, float hi) { unsigned r; asm volatile("v_cvt_pk_bf16_f32 %0, %1, %2" : "=v"(r) : "v"(lo), "v"(hi)); return r; }

template <class Epi, class Sched, bool ALIGN_EPI, bool SP2>
__device__ __forceinline__ void gemm_phase(PG8_LAS unsigned char* lds, const Gemm g, const Sched& S, const Epi& E, const int tid) {
    const int wid = __builtin_amdgcn_readfirstlane(tid >> 6), lane = tid & 63, wr = wid >> 2, wc = wid & 3, fr = lane & 15, fq = lane >> 4;
    const int K = g.K, nt = K / BK;
    unsigned voffA[2], voffB[2];
#pragma unroll
    for (int i = 0; i < 2; ++i) { int R, C; stage_rc(tid * 16 + i * 8192, R, C); const int Rb = Epi::PERM ? ((R & ~31) + perm32(R & 31)) : R; const int Ra = g.ovl ? (R - 2 * (R >> 6)) : R;
        voffA[i] = (unsigned)(Ra * K + C) * 2u; voffB[i] = (unsigned)(Rb * K + C) * 2u; }
    const size_t kstep = (size_t)(BK * 2);
    const size_t hstepB = (size_t)HALF * K * 2, tstepB = 2 * hstepB;
    const size_t hstepA = (size_t)g.a_hstep, tstepA = (size_t)g.a_tstep;
    const unsigned ldsw = (unsigned)wid * 1024u;
    const int aoff = lds_byte(wr * 64 + fr, fq * 8), boff = lds_byte(wc * 32 + fr, fq * 8);
#define PG8_SA(b, h) (((b) * 2 + (h)) * HTB)
#define PG8_SB(b, h) ((4 + (b) * 2 + (h)) * HTB)
#define PG8_STAGE(bufoff, gbase, voff) do { _Pragma("unroll") for (int _i = 0; _i < 2; ++_i) \
        __builtin_amdgcn_global_load_lds((const unsigned*)((const char*)(gbase) + (voff)[_i]), (PG8_LAS unsigned*)(lds + (bufoff) + ldsw + _i * 8192), 16, 0, 0); } while (0)
#define PG8_LDA(dst, b, h) do { _Pragma("unroll") for (int m = 0; m < 4; ++m) _Pragma("unroll") for (int k = 0; k < 2; ++k) dst[m][k] = *(const PG8_LAS bf16x8*)(lds + PG8_SA(b, h) + aoff + m * 2048 + k * 1024); } while (0)
#define PG8_LDB(dst, b, h) do { _Pragma("unroll") for (int n = 0; n < 2; ++n) _Pragma("unroll") for (int k = 0; k < 2; ++k) dst[n][k] = *(const PG8_LAS bf16x8*)(lds + PG8_SB(b, h) + boff + n * 2048 + k * 1024); } while (0)
#define PG8_MMA(ai, bj, At, Bt) do { __builtin_amdgcn_s_setprio(1); _Pragma("unroll") for (int m = 0; m < 4; ++m) _Pragma("unroll") for (int n = 0; n < 2; ++n) _Pragma("unroll") for (int k = 0; k < 2; ++k) \
        acc[ai][bj][m][n] = __builtin_amdgcn_mfma_f32_16x16x32_bf16(Bt[n][k], At[m][k], acc[ai][bj][m][n], 0, 0, 0); __builtin_amdgcn_s_setprio(0); } while (0)
#define PG8_WAIT_V(n) asm volatile("s_waitcnt vmcnt(" #n ")" ::: "memory")
#define PG8_WAIT_L(n) asm volatile("s_waitcnt lgkmcnt(" #n ")" ::: "memory")
#define PG8_BAR __builtin_amdgcn_s_barrier()
#define PG8_SCHED __builtin_amdgcn_sched_barrier(0)
    Unit cur, nxt; int ui = 0;
    if (!S.next(0, cur)) return;
    f32x4 acc[2][2][4][2];
#pragma unroll
    for (int a = 0; a < 2; ++a)
#pragma unroll
        for (int b = 0; b < 2; ++b)
#pragma unroll
            for (int m = 0; m < 4; ++m)
#pragma unroll
                for (int n = 0; n < 2; ++n) acc[a][b][m][n] = (f32x4){0.f, 0.f, 0.f, 0.f};
    bf16x8 At[4][2], B0[2][2], B1[2][2];
    const char* cA = (const char*)g.A + (size_t)cur.pm * tstepA; const char* cB = (const char*)g.Bt + (size_t)cur.pn * tstepB;
    S.a_ready(cur);
    E.prefetch(lds, cur, 0, wid, lane);
    if constexpr (SP2) {
        PG8_STAGE(PG8_SB(0, 0), cB, voffB); PG8_STAGE(PG8_SB(0, 1), cB + hstepB, voffB); PG8_STAGE(PG8_SA(0, 0), cA, voffA); PG8_STAGE(PG8_SA(0, 1), cA + hstepA, voffA);
        if (wr == 1) PG8_BAR;
        PG8_WAIT_V(2); PG8_BAR;
        PG8_STAGE(PG8_SB(1, 0), cB + kstep, voffB); PG8_STAGE(PG8_SA(1, 0), cA + kstep, voffA); PG8_STAGE(PG8_SB(1, 1), cB + hstepB + kstep, voffB);
        PG8_WAIT_V(6); PG8_BAR;
    } else {
        PG8_STAGE(PG8_SB(0, 0), cB, voffB); PG8_STAGE(PG8_SA(0, 0), cA, voffA); PG8_STAGE(PG8_SB(0, 1), cB + hstepB, voffB); PG8_STAGE(PG8_SA(0, 1), cA + hstepA, voffA);
        if (wr == 1) PG8_BAR;
        PG8_WAIT_V(4); PG8_BAR;
        PG8_STAGE(PG8_SB(1, 0), cB + kstep, voffB); PG8_STAGE(PG8_SA(1, 0), cA + kstep, voffA); PG8_STAGE(PG8_SB(1, 1), cB + hstepB + kstep, voffB);
        PG8_WAIT_V(6); PG8_BAR;
    }
    for (;;) {
        const bool has_next = S.next(ui + 1, nxt);
        const char* nA = has_next ? (const char*)g.A + (size_t)nxt.pm * tstepA : cA; const char* nB = has_next ? (const char*)g.Bt + (size_t)nxt.pn * tstepB : cB;
        for (int t = 0; t < nt; t += 2) {
            const bool last = (t == nt - 2);
            const char* a1 = cA + (size_t)(t + 1) * kstep;
            const char* a2 = last ? nA : cA + (size_t)(t + 2) * kstep; const char* b2 = last ? nB : cB + (size_t)(t + 2) * kstep;
            const char* a3 = a2 + kstep; const char* b3 = b2 + kstep;
            if (last && has_next) { S.a_ready(nxt); E.prefetch(lds, nxt, (ui + 1) & 1, wid, lane); }
            if constexpr (SP2) {
            PG8_LDB(B0, 0, 0); PG8_LDB(B1, 0, 1); PG8_SCHED; PG8_LDA(At, 0, 0); PG8_STAGE(PG8_SA(1, 1), a1 + hstepA, voffA);
            PG8_WAIT_V(8); PG8_WAIT_L(0); PG8_BAR; PG8_MMA(0, 0, At, B0); PG8_MMA(0, 1, At, B1); PG8_BAR; PG8_SCHED;
            PG8_LDA(At, 0, 1); PG8_STAGE(PG8_SB(0, 0), b2, voffB); PG8_STAGE(PG8_SB(0, 1), b2 + hstepB, voffB); PG8_STAGE(PG8_SA(0, 0), a2, voffA);
            PG8_WAIT_V(8); PG8_WAIT_L(0); PG8_BAR; PG8_MMA(1, 0, At, B0); PG8_MMA(1, 1, At, B1); PG8_BAR; PG8_SCHED;
            PG8_LDB(B0, 1, 0); PG8_LDB(B1, 1, 1); PG8_SCHED; PG8_LDA(At, 1, 0); PG8_STAGE(PG8_SA(0, 1), a2 + hstepA, voffA);
            PG8_WAIT_V(8); PG8_WAIT_L(0); PG8_BAR; PG8_MMA(0, 0, At, B0); PG8_MMA(0, 1, At, B1); PG8_BAR; PG8_SCHED;
            PG8_LDA(At, 1, 1); PG8_STAGE(PG8_SB(1, 0), b3, voffB); PG8_STAGE(PG8_SB(1, 1), b3 + hstepB, voffB); PG8_STAGE(PG8_SA(1, 0), a3, voffA);
            PG8_WAIT_V(8); PG8_WAIT_L(0); PG8_BAR; PG8_MMA(1, 0, At, B0); PG8_MMA(1, 1, At, B1); PG8_BAR; PG8_SCHED;
            } else {
            PG8_LDB(B0, 0, 0); PG8_SCHED; PG8_LDA(At, 0, 0); PG8_STAGE(PG8_SA(1, 1), a1 + hstepA, voffA);
            PG8_WAIT_L(8); PG8_BAR; PG8_WAIT_L(0); PG8_MMA(0, 0, At, B0); PG8_BAR; PG8_SCHED;
            PG8_LDB(B1, 0, 1); PG8_STAGE(PG8_SB(0, 0), b2, voffB);
            PG8_BAR; PG8_WAIT_L(0); PG8_MMA(0, 1, At, B1); PG8_BAR;
            PG8_LDA(At, 0, 1); PG8_STAGE(PG8_SA(0, 0), a2, voffA);
            PG8_BAR; PG8_WAIT_L(0); PG8_MMA(1, 0, At, B0); PG8_BAR; PG8_SCHED;
            PG8_STAGE(PG8_SB(0, 1), b2 + hstepB, voffB);
            PG8_WAIT_V(6); PG8_BAR; PG8_MMA(1, 1, At, B1); PG8_BAR;
            PG8_LDB(B0, 1, 0); PG8_SCHED; PG8_LDA(At, 1, 0); PG8_STAGE(PG8_SA(0, 1), a2 + hstepA, voffA);
            PG8_WAIT_L(8); PG8_BAR; PG8_WAIT_L(0); PG8_MMA(0, 0, At, B0); PG8_BAR; PG8_SCHED;
            PG8_LDB(B1, 1, 1); PG8_STAGE(PG8_SB(1, 0), b3, voffB);
            PG8_BAR; PG8_WAIT_L(0); PG8_MMA(0, 1, At, B1); PG8_BAR;
            PG8_LDA(At, 1, 1); PG8_STAGE(PG8_SA(1, 0), a3, voffA);
            PG8_BAR; PG8_WAIT_L(0); PG8_MMA(1, 0, At, B0); PG8_BAR; PG8_SCHED;
            PG8_STAGE(PG8_SB(1, 1), b3 + hstepB, voffB);
            PG8_WAIT_V(6); PG8_BAR; PG8_MMA(1, 1, At, B1); PG8_BAR;
            }
        }
        if constexpr (ALIGN_EPI) { if (wr == 0) PG8_BAR; }
        if constexpr (Epi::TWICE) { int nrep_ = 2; asm volatile("" : "+s"(nrep_));
_Pragma("unroll 1") for (int rep_ = 0; rep_ < nrep_; ++rep_) { asm volatile("" ::: "memory"); E(acc, cur, wr, wc, fr, fq, lds, ui & 1); } }
        else E(acc, cur, wr, wc, fr, fq, lds, ui & 1);
        S.done(cur);
        if (!has_next) break;
#pragma unroll
        for (int a = 0; a < 2; ++a)
#pragma unroll
            for (int b = 0; b < 2; ++b)
#pragma unroll
                for (int m = 0; m < 4; ++m)
#pragma unroll
                    for (int n = 0; n < 2; ++n) acc[a][b][m][n] = (f32x4){0.f, 0.f, 0.f, 0.f};
        cur = nxt; cA = nA; cB = nB; ++ui;
        if constexpr (ALIGN_EPI) { if (wr == 1) PG8_BAR; }
    }
    PG8_WAIT_V(0);
    if constexpr (!ALIGN_EPI) { if (wr == 0) PG8_BAR; }
    PG8_BAR;
#undef PG8_SA
#undef PG8_SB
#undef PG8_STAGE
#undef PG8_LDA
#undef PG8_LDB
#undef PG8_MMA
#undef PG8_WAIT_V
#undef PG8_WAIT_L
#undef PG8_BAR
#undef PG8_SCHED
}


struct EpiIn {
    static constexpr bool PERM = true, TWICE = false;
    bf16_t* proj; float* dtraw; const float* ss;
    __device__ __forceinline__ void prefetch(PG8_LAS unsigned char*, const Unit&, int, int, int) const {}
    __device__ __forceinline__ void operator()(const f32x4 (&acc)[2][2][4][2], const Unit& u, int wr, int wc, int fr, int fq, PG8_LAS unsigned char*, int) const {
        const int row0 = u.pm * BM + wr * 64 + fr;
        if (u.pn < 10) {
            const int col0 = u.pn * BM + wc * 32 + 8 * fq;
#pragma unroll
            for (int ai = 0; ai < 2; ++ai)
#pragma unroll
                for (int m = 0; m < 4; ++m) { const int row = row0 + ai * HALF + m * 16; const float rs = __builtin_amdgcn_rsqf(rowss(ss, row) * (1.0f / 1024.0f) + EPS);
                    bf16_t* rowp = proj + (size_t)row * PROJ_LD + col0;
#pragma unroll
                    for (int bj = 0; bj < 2; ++bj) { const f32x4 v0 = acc[ai][bj][m][0] * rs, v1 = acc[ai][bj][m][1] * rs;
                        u32x4 w; w.x = cvt_pk_bf16(v0[0], v0[1]); w.y = cvt_pk_bf16(v0[2], v0[3]); w.z = cvt_pk_bf16(v1[0], v1[1]); w.w = cvt_pk_bf16(v1[2], v1[3]);
                        *(u32x4*)(rowp + bj * HALF) = w; } }
        } else if (wc == 0 && fq == 0) {
#pragma unroll
            for (int ai = 0; ai < 2; ++ai)
#pragma unroll
                for (int m = 0; m < 4; ++m) { const int row = row0 + ai * HALF + m * 16; const float rs = __builtin_amdgcn_rsqf(rowss(ss, row) * (1.0f / 1024.0f) + EPS);
                    float* p = dtraw + (size_t)row * 8; *(f32x4*)p = acc[ai][0][m][0] * rs; *(f32x4*)(p + 4) = acc[ai][0][m][1] * rs; }
        }
    }
};
struct EpiRes {
    static constexpr bool PERM = true, TWICE = false;
    bf16_t* xb; float* ssn;
    __device__ __forceinline__ void prefetch(PG8_LAS unsigned char*, const Unit&, int, int, int) const {}
    __device__ __forceinline__ void operator()(const f32x4 (&acc)[2][2][4][2], const Unit& u, int wr, int wc, int fr, int fq, PG8_LAS unsigned char*, int) const {
        const int row0 = u.pm * BM + wr * 64 + fr, col0 = u.pn * BM + wc * 32 + 8 * fq;
#pragma unroll
        for (int ai = 0; ai < 2; ++ai)
#pragma unroll
            for (int m = 0; m < 4; ++m) { const int row = row0 + ai * HALF + m * 16; float part = 0.f;
#pragma unroll
                for (int bj = 0; bj < 2; ++bj) { bf16_t* xp = xb + (size_t)row * D + col0 + bj * HALF; const u32x4 old = *(const u32x4*)xp;
                    f32x4 o0, o1;
                    o0[0] = bf2f(old.x & 0xffffu) + acc[ai][bj][m][0][0]; o0[1] = bf2f(old.x >> 16) + acc[ai][bj][m][0][1]; o0[2] = bf2f(old.y & 0xffffu) + acc[ai][bj][m][0][2]; o0[3] = bf2f(old.y >> 16) + acc[ai][bj][m][0][3];
                    o1[0] = bf2f(old.z & 0xffffu) + acc[ai][bj][m][1][0]; o1[1] = bf2f(old.z >> 16) + acc[ai][bj][m][1][1]; o1[2] = bf2f(old.w & 0xffffu) + acc[ai][bj][m][1][2]; o1[3] = bf2f(old.w >> 16) + acc[ai][bj][m][1][3];
                    part += (o0[0] * o0[0] + o0[1] * o0[1]) + (o0[2] * o0[2] + o0[3] * o0[3]) + (o1[0] * o1[0] + o1[1] * o1[1]) + (o1[2] * o1[2] + o1[3] * o1[3]);
                    u32x4 w; w.x = cvt_pk_bf16(o0[0], o0[1]); w.y = cvt_pk_bf16(o0[2], o0[3]); w.z = cvt_pk_bf16(o1[0], o1[1]); w.w = cvt_pk_bf16(o1[2], o1[3]);
                    *(u32x4*)xp = w; }
                { const int ln = fr + 16 * fq; part += bperm(part, ln ^ 16); part += bperm(part, ln ^ 32); }
                if (fq == 0) ssn[(size_t)row * 16 + u.pn * 4 + wc] = part; }
    }
};
struct EpiUp {
    static constexpr bool PERM = true, TWICE = (REP_MASK & 1024) != 0;
    bf16_t* a; const float* ss; const float* cw; const float* cb; float* pf; float* usamp; void* dummy;
    static constexpr int CWS_OFF = 131072 + 512;
    __device__ __forceinline__ void prefetch(PG8_LAS unsigned char* lds, const Unit& u, int slot, int wid, int lane) const {
        if (wid < 4) { const int seg = 2 * wid + (lane >> 5), k = seg & 3, el = (lane & 31) * 4;
            const float* src = (k < 3 ? cw + k * 6144 : cb) + (seg >> 2) * 3072 + u.pn * 128 + el;
            __builtin_amdgcn_global_load_lds((const unsigned*)src, (PG8_LAS unsigned*)(lds + CWS_OFF + slot * 4096 + wid * 1024), 16, 0, 0); }
    }
    __device__ __forceinline__ void operator()(const f32x4 (&acc)[2][2][4][2], const Unit& u, int wr, int wc, int fr, int fq, PG8_LAS unsigned char* lds, int slot) const {
        const int ch0 = u.pn * 128 + wc * 32 + 8 * fq;
        const PG8_LAS float* cws = (const PG8_LAS float*)(lds + CWS_OFF + slot * 4096) + wc * 32 + 8 * fq;
        if ((REP_MASK & 512) && u.dry) return;
        bf16_t* a = this->a;
        int rmask = 0x7fffffff;
        if ((REP_MASK & (8192 | 16384)) && u.dry) { a = (bf16_t*)dummy; rmask = 8191; }
        if ((REP_MASK & 16384) && u.dry) {
#pragma unroll
            for (int ai = 0; ai < 2; ++ai) { const int gr0 = u.pm * 248 + 62 * (2 * ai + wr) - 2;
#pragma unroll
                for (int m = 0; m < 4; ++m) { const int gr = gr0 + 16 * m + fr; const int idx = gr < 0 ? 0 : gr; const float rs = __builtin_amdgcn_rsqf(rowss(ss, idx) * (1.0f / 1024.0f) + EPS);
#pragma unroll
                    for (int n = 0; n < 2; ++n) { const f32x4 g4 = acc[ai][0][m][n] * rs, v4 = acc[ai][1][m][n] * rs; u32x2 w; w.x = cvt_pk_bf16(g4[0] * v4[0], g4[1] * v4[1]); w.y = cvt_pk_bf16(g4[2] * v4[2], g4[3] * v4[3]);
                        if (gr >= 0 && gr < MP) *(u32x2*)(a + (size_t)(gr & rmask) * DFF + ch0 + 4 * n) = w; } } }
            return;
        }
        constexpr int INV = (int)0x80000000;
#pragma unroll
        for (int ai = 0; ai < 2; ++ai) {
            const int gr0 = u.pm * 248 + 62 * (2 * ai + wr) - 2;
            float rs[4]; int tk[4];
            bool plain = true;
#pragma unroll
            for (int m = 0; m < 4; ++m) { const int lr = 16 * m + fr, gr = gr0 + lr; const int idx = gr < 0 ? 0 : gr; rs[m] = __builtin_amdgcn_rsqf(rowss(ss, idx) * (1.0f / 1024.0f) + EPS);
                tk[m] = (lr >= 2 && gr < MT) ? (gr < MP ? gr % LP : -1 - (gr - MP)) : INV;
                plain = plain && (tk[m] == INV || (tk[m] >= 2 && tk[m] < LP - 2)); }
            const bool all_plain = __builtin_amdgcn_ballot_w64(!plain) == 0ull;
            if (all_plain) {
#pragma unroll
                for (int n = 0; n < 2; ++n) {
                    float keep[4]; unsigned pk[4][2];
#pragma unroll
                    for (int j = 0; j < 4; ++j) {
                        const float wg0 = cws[4 * n + j], wg1 = cws[128 + 4 * n + j], wg2 = cws[256 + 4 * n + j], bg = cws[384 + 4 * n + j];
                        const float wv0 = cws[512 + 4 * n + j], wv1 = cws[640 + 4 * n + j], wv2 = cws[768 + 4 * n + j], bv = cws[896 + 4 * n + j];
                        float ug[4], uv[4];
#pragma unroll
                        for (int m = 0; m < 4; ++m) { ug[m] = acc[ai][0][m][n][j] * rs[m]; uv[m] = acc[ai][1][m][n][j] * rs[m]; }
#pragma unroll
                        for (int m = 0; m < 4; ++m) {
                            const float cg_ = m == 0 ? conv3_dpp_first(ug[0], wg0, wg1, wg2, bg) : conv3_dpp(ug[m], ug[m > 0 ? m - 1 : 0], wg0, wg1, wg2, bg);
                            const float cv_ = m == 0 ? conv3_dpp_first(uv[0], wv0, wv1, wv2, bv) : conv3_dpp(uv[m], uv[m > 0 ? m - 1 : 0], wv0, wv1, wv2, bv);
                            const float r_ = gelu_tanh(cg_) * cv_;
                            if (j & 1) pk[m][j >> 1] = cvt_pk_bf16(keep[m], r_); else keep[m] = r_;
                        }
                    }
#pragma unroll
                    for (int m = 0; m < 4; ++m) { if (tk[m] >= 0) { u32x2 w; w.x = pk[m][0]; w.y = pk[m][1]; *(u32x2*)(a + (size_t)((gr0 + 16 * m + fr) & rmask) * DFF + ch0 + 4 * n) = w; } }
                }
            } else {
#pragma unroll
                for (int n = 0; n < 2; ++n) {
                    float keep[4]; unsigned pk[4][2];
#pragma unroll
                    for (int j = 0; j < 4; ++j) {
                        const int col = ch0 + 4 * n + j;
                        const float wg0 = cws[4 * n + j], wg1 = cws[128 + 4 * n + j], wg2 = cws[256 + 4 * n + j], bg = cws[384 + 4 * n + j];
                        const float wv0 = cws[512 + 4 * n + j], wv1 = cws[640 + 4 * n + j], wv2 = cws[768 + 4 * n + j], bv = cws[896 + 4 * n + j];
                        float pv1g = 0.f, pv2g = 0.f, pv1v = 0.f, pv2v = 0.f;
#pragma unroll
                        for (int m = 0; m < 4; ++m) {
                            const float ug = acc[ai][0][m][n][j] * rs[m], uv = acc[ai][1][m][n][j] * rs[m];
                            const float r1g = dpp_ror1(ug), r2g = dpp_ror2(ug), r1v = dpp_ror1(uv), r2v = dpp_ror2(uv);
                            float p1g = fr >= 1 ? r1g : pv1g, p2g = fr >= 2 ? r2g : pv2g, p1v = fr >= 1 ? r1v : pv1v, p2v = fr >= 2 ? r2v : pv2v;
                            pv1g = r1g; pv2g = r2g; pv1v = r1v; pv2v = r2v;
                            const int t = tk[m];
                            if (t >= 0) { if (t < 1) { p1g = 0.f; p1v = 0.f; } if (t < 2) { p2g = 0.f; p2v = 0.f; }
                                if (t >= LP - 2) { const int gr = gr0 + 16 * m + fr; float* o = pf + ((size_t)(gr / LP) * 2 + (t - (LP - 2))) * 6144 + col; o[0] = ug; o[3072] = uv; } }
                            else if (t != INV) { float* o = usamp + (size_t)(-1 - t) * 6144 + col; o[0] = ug; o[3072] = uv; }
                            const float cg_ = bg + wg0 * p2g + wg1 * p1g + wg2 * ug, cv_ = bv + wv0 * p2v + wv1 * p1v + wv2 * uv;
                            const float r_ = gelu_tanh(cg_) * cv_;
                            if (j & 1) pk[m][j >> 1] = cvt_pk_bf16(keep[m], r_); else keep[m] = r_;
                        }
                    }
#pragma unroll
                    for (int m = 0; m < 4; ++m) { if (tk[m] >= 0) { u32x2 w; w.x = pk[m][0]; w.y = pk[m][1]; *(u32x2*)(a + (size_t)((gr0 + 16 * m + fr) & rmask) * DFF + ch0 + 4 * n) = w; } }
                }
            }
        }
    }
};
}

#define XB_TMO      128
#define XB_XCNT(j)  (256  + 64 * (j))
#define XB_XSUB(j)  (1280 + 64 * (j))
#define XB_XGEN(j)  (2304 + 64 * (j))
#define XB_TOP      3328
#define XB_TOPGEN   3392
#define XCD_BAR_WORDS 3456
#define XB_SPIN_CAP (1u << 18)
__device__ __forceinline__ unsigned xb_ld(unsigned* p)              { return __hip_atomic_load(p, __ATOMIC_RELAXED, __HIP_MEMORY_SCOPE_AGENT); }
__device__ __forceinline__ unsigned xb_add(unsigned* p, unsigned v) { return __hip_atomic_fetch_add(p, v, __ATOMIC_RELAXED, __HIP_MEMORY_SCOPE_AGENT); }
__device__ __forceinline__ unsigned xb_xcc_id() { return (unsigned)__builtin_amdgcn_s_getreg((3 << 11) | 20) & 0xFu; }
#define XB_SPIN(cond, bar) do { unsigned _sp = 0; while (cond) { __builtin_amdgcn_s_sleep(1); \
    if ((++_sp & 255u) == 0u) { if (xb_ld(&(bar)[XB_TMO])) break; if (_sp > XB_SPIN_CAP) { atomicAdd(&(bar)[XB_TMO], 1u); break; } } } } while (0)
struct XcdBarrier { unsigned* bar; unsigned x; volatile LAS unsigned* st; };
__device__ __forceinline__ XcdBarrier xcd_barrier_post(unsigned* bar, volatile LAS unsigned* st, const int tid) {
    XcdBarrier b; b.bar = bar; b.x = xb_xcc_id(); b.st = st;
    if (tid == 0) (void)xb_add(&bar[XB_XCNT(b.x)], 1u);
    return b;
}
__device__ __forceinline__ void xcd_barrier_complete(unsigned* bar, unsigned x, unsigned& nloc, unsigned& nx) {
    const unsigned G = gridDim.x * gridDim.y * gridDim.z;
    unsigned sum, cnt, mine, sp = 0u;
    for (;;) {
        sum = 0u; cnt = 0u; mine = 0u;
#pragma unroll
        for (unsigned j = 0; j < 16; ++j) { const unsigned c = xb_ld(&bar[XB_XCNT(j)]); sum += c; cnt += (c > 0u) ? 1u : 0u; mine = (j == x) ? c : mine; }
        if (sum == G) break;
        __builtin_amdgcn_s_sleep(1);
        if ((++sp & 255u) == 0u) { if (xb_ld(&bar[XB_TMO])) break; if (sp > XB_SPIN_CAP) { atomicAdd(&bar[XB_TMO], 1u); break; } }
    }
    nloc = mine > 0u ? mine : 1u; nx = cnt > 0u ? cnt : 1u;
}
__device__ __forceinline__ void xcd_barrier(const XcdBarrier& b, const int tid) {
    asm volatile("s_waitcnt vmcnt(0)" ::: "memory");
    __syncthreads();
    if (tid == 0) {
        unsigned* bar = b.bar;
        __builtin_amdgcn_s_waitcnt(0);
        unsigned nloc = b.st[0], nx = b.st[1];
        if (nloc == 0u) { xcd_barrier_complete(bar, b.x, nloc, nx); b.st[0] = nloc; b.st[1] = nx; }
        const unsigned old = xb_add(&bar[XB_XSUB(b.x)], 1u);
        const unsigned gen = old / nloc;
        if (old + 1u == (gen + 1u) * nloc) {
            __builtin_amdgcn_fence(__ATOMIC_RELEASE, "agent");
            asm volatile("s_waitcnt vmcnt(0)" ::: "memory");
            const unsigned og = xb_add(&bar[XB_TOP], 1u);
            const unsigned tg = og / nx;
            if (og + 1u == (tg + 1u) * nx) xb_add(&bar[XB_TOPGEN], 1u);
            else XB_SPIN(xb_ld(&bar[XB_TOPGEN]) == tg, bar);
            __builtin_amdgcn_fence(__ATOMIC_ACQUIRE, "agent");
            xb_add(&bar[XB_XGEN(b.x)], 1u);
            asm volatile("s_waitcnt vmcnt(0)" ::: "memory");
        } else {
            XB_SPIN(xb_ld(&bar[XB_XGEN(b.x)]) == gen, bar);
            __builtin_amdgcn_fence(__ATOMIC_ACQUIRE, "agent");
            asm volatile("s_waitcnt vmcnt(0)" ::: "memory");
        }
    }
    __syncthreads();
}

__device__ __forceinline__ int my_lane_volatile() { int x; asm volatile("v_mbcnt_lo_u32_b32 %0, -1, 0\n\tv_mbcnt_hi_u32_b32 %0, -1, %0" : "=v"(x)); return x; }
struct Params { const float* in[31]; float* out; unsigned char* ws; };
enum { I_XP = 0, I_XS, I_SLC, I_SLH, I_SSC, I_SSS, I_SFC, I_META, I_NMIX, I_WIN, I_LCW, I_LCB, I_WA, I_BA, I_WX, I_BX, I_APAR, I_LON, I_SCW, I_SCB, I_DTB, I_ALOG, I_SSD_D, I_SON, I_WOUT, I_NFFN, I_WUP, I_FCW, I_FCB, I_WDOWN, I_NFIN };

constexpr int LDS_MISC = 131072, LDS_BYTES = 147456;


__device__ __forceinline__ void p0_transpose_item(const float* W, int ldw, int nvalid, const float* gain, bf16_t* WT, int ldt, int k0, int n0, int drow0, LAS float* scr, int lane) {
    const int nn = n0 + (lane & 31);
    float vv[32];
#pragma unroll
    for (int i = 0; i < 32; ++i) { const int kk = 2 * i + (lane >> 5); vv[i] = nn < nvalid ? W[(size_t)(k0 + kk) * ldw + nn] : 0.f; }
#pragma unroll
    for (int i = 0; i < 32; ++i) { const int kk = 2 * i + (lane >> 5); float v = vv[i]; if (gain) v *= gain[k0 + kk]; scr[kk * 33 + (lane & 31)] = v; }
    LDS_WAIT(); asm volatile("" ::: "memory");
    const int c = lane & 7;
#pragma unroll
    for (int j = 0; j < 4; ++j) { const int n = (lane >> 3) + 8 * j; const LAS float* s = scr + (8 * c) * 33 + n;
        u32x4 o; o.x = pk2(s[0 * 33], s[1 * 33]); o.y = pk2(s[2 * 33], s[3 * 33]); o.z = pk2(s[4 * 33], s[5 * 33]); o.w = pk2(s[6 * 33], s[7 * 33]);
        *(u32x4*)(WT + (size_t)(drow0 + n) * ldt + k0 + 8 * c) = o; }
    LDS_WAIT(); asm volatile("" ::: "memory");
}
__device__ __forceinline__ void p0_prologue(const Params& P, LAS unsigned char* lds, int wave, int lane, const int tid) {
    LAS float* scr = (LAS float*)(lds + wave * 16384);
    const int gw = blockIdx.x * 8 + wave, NGW = gridDim.x * 8;
    unsigned char* ws = P.ws;
    constexpr int I_IN = 16 * 88, I_OUT = 16 * 32, I_UP = 16 * 192, I_DN = 48 * 32, I_L = I_IN + I_OUT + I_UP + I_DN, I_LRU = DEPTH * 8 * 2 * 2;
    for (int it = gw; it < DEPTH * I_L + I_LRU; it += NGW) {
        if (it < DEPTH * I_L) {
            const int l = it / I_L; int r = it % I_L; unsigned char* wl = ws + WS_W + (size_t)l * W_LAYER;
            if (r < I_IN) { const int kb = r / 88, nb = r % 88; p0_transpose_item(P.in[I_WIN] + (size_t)l * D * PIN, PIN, PIN, P.in[I_NMIX] + l * D, (bf16_t*)(wl + W_IN), D, 64 * kb, 32 * nb, 32 * nb, scr, lane); continue; } r -= I_IN;
            if (r < I_OUT) { const int kb = r / 32, nb = r % 32; p0_transpose_item(P.in[I_WOUT] + (size_t)l * D * D, D, D, nullptr, (bf16_t*)(wl + W_OUT), D, 64 * kb, 32 * nb, 32 * nb, scr, lane); continue; } r -= I_OUT;
            if (r < I_UP) { const int kb = r / 192, nb = r % 192, n0 = 32 * nb; const int drow = n0 < DFF ? (n0 / 128) * 256 + (n0 % 128) : ((n0 - DFF) / 128) * 256 + 128 + ((n0 - DFF) % 128);
                p0_transpose_item(P.in[I_WUP] + (size_t)l * D * 2 * DFF, 2 * DFF, 2 * DFF, P.in[I_NFFN] + l * D, (bf16_t*)(wl + W_UP), D, 64 * kb, n0, drow, scr, lane); continue; } r -= I_UP;
            { const int kb = r / 32, nb = r % 32; p0_transpose_item(P.in[I_WDOWN] + (size_t)l * DFF * D, D, D, nullptr, (bf16_t*)(wl + W_DOWN), DFF, 64 * kb, 32 * nb, 32 * nb, scr, lane); }
        } else {
            const int r = it - DEPTH * I_L, lh = r >> 2, which = (r >> 1) & 1, nb = r & 1;
            p0_transpose_item(P.in[which ? I_WX : I_WA] + (size_t)lh * 4096, 64, 64, nullptr, (bf16_t*)(ws + WS_LRUW) + (size_t)which * DEPTH * 8 * 4096 + (size_t)lh * 4096, 64, 0, 32 * nb, 32 * nb, scr, lane);
        }
    }
    bf16_t* xb = (bf16_t*)(ws + WS_XB); float* ss = (float*)(ws + WS_SS);
    for (int m = gw; m < MPAD; m += NGW) {
        const float* src = nullptr;
        if (m < MP) { const int b = m / LP, t = m % LP; src = t < NMETA ? P.in[I_META] + (size_t)t * D : P.in[I_XP] + ((size_t)b * SEQ + (t - NMETA)) * D; }
        else if (m < MT) src = P.in[I_XS] + (size_t)(m - MP) * D;
        f32x4 v[4]; float s = 0.f;
#pragma unroll
        for (int j = 0; j < 4; ++j) { v[j] = src ? *((const f32x4*)src + lane + 64 * j) : (f32x4){0.f, 0.f, 0.f, 0.f}; s += (v[j][0] * v[j][0] + v[j][1] * v[j][1]) + (v[j][2] * v[j][2] + v[j][3] * v[j][3]); }
        s = wave_sum(s, lane);
#pragma unroll
        for (int j = 0; j < 4; ++j) {
            u32x2 w; w.x = pk2(v[j][0], v[j][1]); w.y = pk2(v[j][2], v[j][3]); *((u32x2*)(xb + (size_t)m * D) + lane + 64 * j) = w; }
        if (lane < 16) ss[(size_t)m * 16 + lane] = lane == 0 ? s : 0.f;
    }
    if (blockIdx.x == 0) for (int i = tid; i < 4 * D / 2; i += 512) ((unsigned*)(ws + WS_XB - 8192))[i] = 0u;
}

constexpr int M1_BG = 0, M1_CG = 17408, M1_BGT = 34816, M1_XT = 53248, M1_XST = 71680, M1_WIM = 90112, M1_SDT = 108544, M1_SCS = 109568;
constexpr int M3_XC = 0, XC_RS = 1040, M3_CG = 66560, M3_SSQS = 101376, M3_SSQL = 103424;

struct LayerPtrs {
    const float *lcw, *lcb, *ba, *bx, *apar, *lon, *scw, *scb, *dtb, *alog, *sdd, *son;
    const bf16_t *waT, *wxT;
};
__device__ __forceinline__ LayerPtrs layer_ptrs(const Params& P, int l) {
    LayerPtrs L;
    L.lcw = P.in[I_LCW] + (size_t)l * 4 * 512; L.lcb = P.in[I_LCB] + l * 512; L.ba = P.in[I_BA] + l * 512; L.bx = P.in[I_BX] + l * 512; L.apar = P.in[I_APAR] + l * 512; L.lon = P.in[I_LON] + l * 512;
    L.scw = P.in[I_SCW] + (size_t)l * 4 * 1024; L.scb = P.in[I_SCB] + l * 1024; L.dtb = P.in[I_DTB] + l * 8; L.alog = P.in[I_ALOG] + l * 8; L.sdd = P.in[I_SSD_D] + l * 8; L.son = P.in[I_SON] + l * 512;
    L.waT = (const bf16_t*)(P.ws + WS_LRUW) + (size_t)l * 8 * 4096; L.wxT = L.waT + (size_t)DEPTH * 8 * 4096;
    return L;
}

template <int CNT>
__device__ __forceinline__ void conv4_run(const bf16_t* src, size_t rowb, int tok0, float w0, float w1, float w2, float w3, float bias, bool do_silu, float (&out)[CNT]) {
    float x3 = tok0 - 3 >= 0 ? bf2f(src[(rowb + tok0 - 3) * PROJ_LD]) : 0.f, x2 = tok0 - 2 >= 0 ? bf2f(src[(rowb + tok0 - 2) * PROJ_LD]) : 0.f, x1 = tok0 - 1 >= 0 ? bf2f(src[(rowb + tok0 - 1) * PROJ_LD]) : 0.f;
#pragma unroll
    for (int i = 0; i < CNT; ++i) { const float x0 = bf2f(src[(rowb + tok0 + i) * PROJ_LD]); const float v = bias + w0 * x3 + w1 * x2 + w2 * x1 + w3 * x0; out[i] = do_silu ? siluf_(v) : v; x3 = x2; x2 = x1; x1 = x0; }
}

__device__ __forceinline__ void m1_ssd_unit(const Params& P, const LayerPtrs& L, int l, int b, int c, int g, LAS unsigned char* lds, int wave, int lane_in) {
    int lane = lane_in; asm volatile("" : "+v"(lane));
    const int tid = wave * 64 + lane, fr = lane & 15, fq = lane >> 4;
    unsigned char* ws = P.ws;
    const bf16_t* proj = (const bf16_t*)(ws + WS_PROJ); const float* dtraw = (const float*)(ws + WS_DTRAW);
    float* csbuf = (float*)(ws + WS_CS); float* cdec = (float*)(ws + WS_CDEC); bf16_t* ybuf = (bf16_t*)(ws + WS_YBUF); float* states = (float*)(ws + WS_STATES);
    const size_t rowb = (size_t)b * LP; const int t0 = 64 * c;
    LAS float* SDT = (LAS float*)(lds + M1_SDT); LAS float* SCS = (LAS float*)(lds + M1_SCS);
    if (wave < 4) {
        const int head = 4 * g + wave, tok = t0 + lane; const bool ok = tok < LP;
        const float raw = ok ? dtraw[(rowb + tok) * 8 + head] : 0.f; const float dt = ok ? softplusf_(raw + L.dtb[head]) : 0.f;
        const float Ah = -__expf(L.alog[head]); float cs = dt * Ah;
#pragma unroll
        for (int o = 1; o < 64; o <<= 1) { const float v = bperm(cs, lane - o); if (lane >= o) cs += v; }
        SDT[wave * 64 + lane] = dt; SCS[wave * 64 + lane] = cs;
        if (ok) csbuf[(rowb + tok) * 8 + head] = cs;
        if (lane == 63) cdec[((size_t)b * NCH + c) * 8 + head] = __expf(cs);
    }
    {
        const int cc = tid & 255, half = tid >> 8, isC = cc >> 7, n = cc & 127, chan = 512 + 256 * isC + 128 * g + n;
        float o[32]; conv4_run<32>(proj + O_XBC + chan, rowb, t0 + 32 * half, L.scw[chan], L.scw[1024 + chan], L.scw[2048 + chan], L.scw[3072 + chan], L.scb[chan], true, o);
        LAS unsigned char* img = lds + (isC ? M1_CG : M1_BG);
#pragma unroll
        for (int i = 0; i < 32; ++i) *(LAS bf16_t*)(img + (32 * half + i) * 272 + n * 2) = (bf16_t)f2bf(o[i]);
        if (!isC) {
#pragma unroll
            for (int i = 0; i < 4; ++i) { u32x4 w; w.x = pk2(o[8 * i], o[8 * i + 1]); w.y = pk2(o[8 * i + 2], o[8 * i + 3]); w.z = pk2(o[8 * i + 4], o[8 * i + 5]); w.w = pk2(o[8 * i + 6], o[8 * i + 7]);
                *(LAS u32x4*)(lds + M1_BGT + n * 144 + (32 * half + 8 * i) * 2) = w; }
        }
        if (c == NCH - 1 && half == 0) {
#pragma unroll
            for (int k = 0; k < 3; ++k) P.out[OFF_PSC + (((size_t)l * NB + b) * 3 + k) * 1024 + chan] = bf2f(proj[(rowb + LP - 3 + k) * PROJ_LD + O_XBC + chan]);
        }
    }
    __syncthreads();
    for (int pr = 0; pr < 2; ++pr) {
        {
            const int xi = tid & 127, q = tid >> 7, hl2 = xi >> 6, p = xi & 63, hl = 2 * pr + hl2, chan = 256 * g + 64 * hl + p;
            float o[16]; conv4_run<16>(proj + O_XBC + chan, rowb, t0 + 16 * q, L.scw[chan], L.scw[1024 + chan], L.scw[2048 + chan], L.scw[3072 + chan], L.scb[chan], true, o);
            const float cl = SCS[hl * 64 + 63];
            float os[16];
#pragma unroll
            for (int i = 0; i < 16; ++i) { const int s = 16 * q + i; os[i] = o[i] * SDT[hl * 64 + s] * __expf(cl - SCS[hl * 64 + s]); }
#pragma unroll
            for (int i = 0; i < 2; ++i) { u32x4 w; w.x = pk2(o[8 * i], o[8 * i + 1]); w.y = pk2(o[8 * i + 2], o[8 * i + 3]); w.z = pk2(o[8 * i + 4], o[8 * i + 5]); w.w = pk2(o[8 * i + 6], o[8 * i + 7]);
                *(LAS u32x4*)(lds + M1_XT + hl2 * 9216 + p * 144 + (16 * q + 8 * i) * 2) = w;
                u32x4 v; v.x = pk2(os[8 * i], os[8 * i + 1]); v.y = pk2(os[8 * i + 2], os[8 * i + 3]); v.z = pk2(os[8 * i + 4], os[8 * i + 5]); v.w = pk2(os[8 * i + 6], os[8 * i + 7]);
                *(LAS u32x4*)(lds + M1_XST + hl2 * 9216 + p * 144 + (16 * q + 8 * i) * 2) = v; }
            if (c == NCH - 1 && q == 0) {
#pragma unroll
                for (int k = 0; k < 3; ++k) P.out[OFF_PSC + (((size_t)l * NB + b) * 3 + k) * 1024 + chan] = bf2f(proj[(rowb + LP - 3 + k) * PROJ_LD + O_XBC + chan]);
            }
        }
        __syncthreads();
        {
            const int hl2 = wave >> 2, tt = wave & 3, hl = 2 * pr + hl2, head = 4 * g + hl;
            LAS unsigned char* Wm = lds + M1_WIM + wave * 2304;
            const LAS unsigned char* XT = lds + M1_XT + hl2 * 9216; const LAS unsigned char* XST = lds + M1_XST + hl2 * 9216;
            const int kb0 = 16 * fq;
            const int tl = 16 * tt + fr; const float cs_t = SCS[hl * 64 + tl];
#pragma unroll
            for (int st = 0; st < 4; ++st) {
                u32x2 wpk; wpk.x = 0u; wpk.y = 0u;
                if (st <= tt) {
                    f32x4 acc = (f32x4){0.f, 0.f, 0.f, 0.f};
#pragma unroll
                    for (int ks = 0; ks < 4; ++ks) acc = mfma16(ldsfrag(lds + M1_BG, 272, 16 * st + fr, 64 * ks + kb0), ldsfrag(lds + M1_CG, 272, tl, 64 * ks + kb0), acc);
                    const f32x4 css = *(const LAS f32x4*)(SCS + hl * 64 + 16 * st + 4 * fq), dts = *(const LAS f32x4*)(SDT + hl * 64 + 16 * st + 4 * fq);
                    float w[4];
#pragma unroll
                    for (int r = 0; r < 4; ++r) { const int s = 16 * st + 4 * fq + r; w[r] = (s <= tl) ? acc[r] * __expf(cs_t - css[r]) * dts[r] : 0.f; }
                    wpk.x = pk2(w[0], w[1]); wpk.y = pk2(w[2], w[3]);
                }
                *(LAS u32x2*)(Wm + fr * 144 + (16 * st + 4 * fq) * 2) = wpk;
            }
            LDS_WAIT();
            const int tok = t0 + tl; const float Dh = L.sdd[head];
#pragma unroll
            for (int pt = 0; pt < 4; ++pt) {
                f32x4 acc = (f32x4){0.f, 0.f, 0.f, 0.f};
#pragma unroll
                for (int ks = 0; ks < 2; ++ks) acc = mfma16(ldsfrag(XT, 144, 16 * pt + fr, 64 * ks + kb0), ldsfrag(Wm, 144, fr, 64 * ks + kb0), acc);
#pragma unroll
                for (int r = 0; r < 4; ++r) acc[r] += Dh * bf2f(*(const LAS bf16_t*)(XT + (16 * pt + 4 * fq + r) * 144 + tl * 2));
                if (tok < LP) { u32x2 w; w.x = pk2(acc[0], acc[1]); w.y = pk2(acc[2], acc[3]); *(u32x2*)(ybuf + (rowb + tok) * 512 + head * 64 + 16 * pt + 4 * fq) = w; }
            }
            float* sdst = states + (((size_t)b * NCH + c) * 8 + head) * 8192;
#pragma unroll
            for (int n2 = 0; n2 < 2; ++n2) { const int nt = 2 * tt + n2;
#pragma unroll
                for (int pt = 0; pt < 4; ++pt) {
                    f32x4 acc = (f32x4){0.f, 0.f, 0.f, 0.f};
#pragma unroll
                    for (int ks = 0; ks < 2; ++ks) acc = mfma16(ldsfrag(lds + M1_BGT, 144, 16 * nt + fr, 64 * ks + kb0), ldsfrag(XST, 144, 16 * pt + fr, 64 * ks + kb0), acc);
                    *(f32x4*)(sdst + (16 * pt + fr) * 128 + 16 * nt + 4 * fq) = acc;
                } }
        }
        __syncthreads();
    }
}

__device__ __forceinline__ void m1_sample_ssd_unit(const Params& P, const LayerPtrs& L, int l, int sq, LAS unsigned char* lds, int wave, int lane_in) {
    int lane = lane_in; asm volatile("" : "+v"(lane));
    unsigned char* ws = P.ws;
    const bf16_t* proj = (const bf16_t*)(ws + WS_PROJ); const float* dtraw = (const float*)(ws + WS_DTRAW); bf16_t* ybuf = (bf16_t*)(ws + WS_YBUF);
    const int head = wave, g = head >> 2; const size_t row0 = (size_t)MP + (size_t)sq * 4;
    LAS float* SX = (LAS float*)(lds + wave * 5120); LAS float* SB = SX + 256; LAS float* SC = SX + 768;
    const float* stc = P.in[I_SSC] + ((size_t)l * NS + sq) * 3 * 1024;
#pragma unroll 1
    for (int slot = 0; slot < 5; ++slot) {
        const int chan = slot == 0 ? head * 64 + lane : (slot < 3 ? 512 + g * 128 + lane + 64 * (slot - 1) : 768 + g * 128 + lane + 64 * (slot - 3));
        const float w0 = L.scw[chan], w1 = L.scw[1024 + chan], w2 = L.scw[2048 + chan], w3 = L.scw[3072 + chan], bs = L.scb[chan];
        const float s0 = stc[chan], s1 = stc[1024 + chan], s2 = stc[2048 + chan];
        float xr[4];
#pragma unroll
        for (int t = 0; t < 4; ++t) xr[t] = bf2f(proj[(row0 + t) * PROJ_LD + O_XBC + chan]);
        float y[4];
        y[0] = siluf_(bs + w0 * s0 + w1 * s1 + w2 * s2 + w3 * xr[0]); y[1] = siluf_(bs + w0 * s1 + w1 * s2 + w2 * xr[0] + w3 * xr[1]);
        y[2] = siluf_(bs + w0 * s2 + w1 * xr[0] + w2 * xr[1] + w3 * xr[2]); y[3] = siluf_(bs + w0 * xr[0] + w1 * xr[1] + w2 * xr[2] + w3 * xr[3]);
        LAS float* dst = slot == 0 ? SX + lane : (slot < 3 ? SB + lane + 64 * (slot - 1) : SC + lane + 64 * (slot - 3));
        const int rs = slot == 0 ? 64 : 128;
#pragma unroll
        for (int t = 0; t < 4; ++t) dst[t * rs] = y[t];
        if (slot == 0 || (head & 3) == 0) {
#pragma unroll
            for (int k = 0; k < 3; ++k) P.out[OFF_SSC + (((size_t)l * NS + sq) * 3 + k) * 1024 + chan] = xr[k + 1];
        }
    }
    const float dtb_h = L.dtb[head];
    const float Ah = -__expf(L.alog[head]), Dh = L.sdd[head];
    LDS_WAIT(); asm volatile("" ::: "memory");
    const int p8 = lane >> 3, nq = lane & 7;
    const float* sin_ = P.in[I_SSS] + (((size_t)l * NS + sq) * 8 + head) * 8192;
    float* sout = P.out + OFF_SSS + (((size_t)l * NS + sq) * 8 + head) * 8192;
#pragma unroll 1
    for (int hf = 0; hf < 2; ++hf) {
        f32x4 S[4][4];
#pragma unroll
        for (int pg = 0; pg < 4; ++pg)
#pragma unroll
            for (int k = 0; k < 4; ++k) S[pg][k] = *(const f32x4*)(sin_ + (8 * (4 * hf + pg) + p8) * 128 + 16 * nq + 4 * k);
#pragma unroll 1
        for (int t = 0; t < 4; ++t) {
            const float dtv_t = softplusf_(dtraw[(row0 + t) * 8 + head] + dtb_h);
            const float dec = __expf(dtv_t * Ah);
            f32x4 Bv[4], Cv[4];
#pragma unroll
            for (int k = 0; k < 4; ++k) { Bv[k] = *(const LAS f32x4*)(SB + t * 128 + 16 * nq + 4 * k); Cv[k] = *(const LAS f32x4*)(SC + t * 128 + 16 * nq + 4 * k); }
#pragma unroll
            for (int pg = 0; pg < 4; ++pg) {
                const int p = 8 * (4 * hf + pg) + p8; const float xv = SX[t * 64 + p]; const float xp = xv * dtv_t;
                float ys = 0.f;
#pragma unroll
                for (int k = 0; k < 4; ++k) { S[pg][k] = S[pg][k] * dec + Bv[k] * xp; const f32x4 pc = S[pg][k] * Cv[k]; ys += (pc[0] + pc[1]) + (pc[2] + pc[3]); }
                ys += bperm(ys, lane ^ 1); ys += bperm(ys, lane ^ 2); ys += bperm(ys, lane ^ 4);
                if (nq == 0) ybuf[(row0 + t) * 512 + head * 64 + p] = (bf16_t)f2bf(ys + Dh * xv);
            }
        }
#pragma unroll
        for (int pg = 0; pg < 4; ++pg)
#pragma unroll
            for (int k = 0; k < 4; ++k) *(f32x4*)(sout + (8 * (4 * hf + pg) + p8) * 128 + 16 * nq + 4 * k) = S[pg][k];
    }
    LDS_WAIT(); asm volatile("" ::: "memory");
}

template <bool SAMPLE, bool WRITE_STATE>
__device__ __forceinline__ void lru_build_xc(const Params& P, const LayerPtrs& L, int l, int b, int c, int u, LAS unsigned char* lds, const int ci) {
    const bf16_t* proj = (const bf16_t*)(P.ws + WS_PROJ);
    const float w0 = L.lcw[ci], w1 = L.lcw[512 + ci], w2 = L.lcw[1024 + ci], w3 = L.lcw[1536 + ci], bs = L.lcb[ci];
    if constexpr (!SAMPLE) {
        const size_t rowb = (size_t)b * LP; const int t0 = 64 * c;
#pragma unroll
        for (int h = 0; h < 2; ++h) { float o[32]; conv4_run<32>(proj + O_LX + ci, rowb, t0 + 32 * h, w0, w1, w2, w3, bs, false, o);
#pragma unroll
            for (int i = 0; i < 32; ++i) *(LAS bf16_t*)(lds + M3_XC + (32 * h + i) * XC_RS + ci * 2) = (bf16_t)f2bf(o[i]); }
        if (WRITE_STATE && c == NCH - 1) {
#pragma unroll
            for (int k = 0; k < 3; ++k) P.out[OFF_PLC + (((size_t)l * NB + b) * 3 + k) * 512 + ci] = bf2f(proj[(rowb + LP - 3 + k) * PROJ_LD + O_LX + ci]);
        }
    } else {
#pragma unroll 4
        for (int s = 0; s < 16; ++s) { const int sq = 16 * u + s; const size_t row0 = (size_t)MP + (size_t)sq * 4;
            const float* stc = P.in[I_SLC] + ((size_t)l * NS + sq) * 3 * 512; const float s0 = stc[ci], s1 = stc[512 + ci], s2 = stc[1024 + ci];
            float xr[4];
#pragma unroll
            for (int t = 0; t < 4; ++t) xr[t] = bf2f(proj[(row0 + t) * PROJ_LD + O_LX + ci]);
            float y[4];
            y[0] = bs + w0 * s0 + w1 * s1 + w2 * s2 + w3 * xr[0]; y[1] = bs + w0 * s1 + w1 * s2 + w2 * xr[0] + w3 * xr[1];
            y[2] = bs + w0 * s2 + w1 * xr[0] + w2 * xr[1] + w3 * xr[2]; y[3] = bs + w0 * xr[0] + w1 * xr[1] + w2 * xr[2] + w3 * xr[3];
#pragma unroll
            for (int t = 0; t < 4; ++t) *(LAS bf16_t*)(lds + M3_XC + (4 * s + t) * XC_RS + ci * 2) = (bf16_t)f2bf(y[t]);
            if (WRITE_STATE) {
#pragma unroll
                for (int k = 0; k < 3; ++k) P.out[OFF_SLC + (((size_t)l * NS + sq) * 3 + k) * 512 + ci] = xr[k + 1];
            } }
    }
}

template <bool PASSB, bool SAMPLE>
__device__ __forceinline__ void lru_wave(const Params& P, const LayerPtrs& L, int l, int b, int c, int u, int len, LAS unsigned char* lds, int wave, int lane, bf16_t* hdst) {
    const int fr = lane & 15, fq = lane >> 4, h = wave; unsigned char* ws = P.ws;
    const bf16_t* proj = (const bf16_t*)(ws + WS_PROJ);
    float* lruA = (float*)(ws + WS_LRUA); float* lruH = (float*)(ws + WS_LRUH); const float* lruHin = (const float*)(ws + WS_LRUHIN);
    const size_t rowbase = SAMPLE ? (size_t)MP + 64 * (size_t)u : (size_t)b * LP + 64 * (size_t)c;
    bf16x8 qan[2], qxn[2];
#pragma unroll
    for (int ks = 0; ks < 2; ++ks) { qan[ks] = *(const bf16x8*)(L.waT + ((size_t)(h * 64 + fr) * 64 + 32 * ks + 8 * fq)); qxn[ks] = *(const bf16x8*)(L.wxT + ((size_t)(h * 64 + fr) * 64 + 32 * ks + 8 * fq)); }
#pragma unroll 1
    for (int jt = 0; jt < 4; ++jt) {
        const int ch = 64 * h + 16 * jt + fr;
        bf16x8 qa[2], qx[2];
#pragma unroll
        for (int ks = 0; ks < 2; ++ks) { qa[ks] = qan[ks]; qx[ks] = qxn[ks]; }
        { const int jn = jt < 3 ? jt + 1 : 3;
#pragma unroll
          for (int ks = 0; ks < 2; ++ks) { qan[ks] = *(const bf16x8*)(L.waT + ((size_t)(h * 64 + 16 * jn + fr) * 64 + 32 * ks + 8 * fq)); qxn[ks] = *(const bf16x8*)(L.wxT + ((size_t)(h * 64 + 16 * jn + fr) * 64 + 32 * ks + 8 * fq)); } }
        f32x4 ar[4], ai[4];
#pragma unroll
        for (int tt = 0; tt < 4; ++tt) { ar[tt] = (f32x4){0.f, 0.f, 0.f, 0.f}; ai[tt] = (f32x4){0.f, 0.f, 0.f, 0.f};
#pragma unroll
            for (int ks = 0; ks < 2; ++ks) { const bf16x8 pf = ldsfrag(lds + M3_XC, XC_RS, 16 * tt + fr, (64 * h + 32 * ks + 8 * fq) * 2); ar[tt] = mfma16(pf, qa[ks], ar[tt]); ai[tt] = mfma16(pf, qx[ks], ai[tt]); } }
        const float bav = L.ba[ch], bxv = L.bx[ch], sp = softplusf_(-L.apar[ch]);
        float av[4][4], bv[4][4], A4[4], B4[4];
#pragma unroll
        for (int tt = 0; tt < 4; ++tt) {
#pragma unroll
            for (int r = 0; r < 4; ++r) { const int t = 16 * tt + 4 * fq + r;
                const float rg = sigmoidf_(ar[tt][r] + bav), ig = sigmoidf_(ai[tt][r] + bxv); const float la = -8.0f * rg * sp; float a_ = __expf(la);
                const float mult = __builtin_amdgcn_sqrtf(fmaxf(neg_expm1(2.0f * la), 0.f)); const float xc = bf2f(*(const LAS bf16_t*)(lds + M3_XC + t * XC_RS + ch * 2)); float bb = mult * ig * xc;
                if (t >= len) { a_ = 1.f; bb = 0.f; }
                av[tt][r] = a_; bv[tt][r] = bb; }
            float A = av[tt][0], B = bv[tt][0];
#pragma unroll
            for (int r = 1; r < 4; ++r) { B = av[tt][r] * B + bv[tt][r]; A *= av[tt][r]; }
            A4[tt] = A; B4[tt] = B; }
        float cin[4];
        if constexpr (!SAMPLE) {
            float stv = PASSB ? lruHin[((size_t)b * NCH + c) * 512 + ch] : 0.f, prd = 1.f;
#pragma unroll
            for (int tt = 0; tt < 4; ++tt)
#pragma unroll
                for (int q = 0; q < 4; ++q) { const float Aq = bperm(A4[tt], fr + 16 * q), Bq = bperm(B4[tt], fr + 16 * q); if (q == fq) cin[tt] = stv; stv = Aq * stv + Bq; prd *= Aq; }
            if (!PASSB && fq == 0) { lruA[((size_t)b * NCH + c) * 512 + ch] = prd; lruH[((size_t)b * NCH + c) * 512 + ch] = stv; }
        } else {
#pragma unroll
            for (int tt = 0; tt < 4; ++tt) cin[tt] = P.in[I_SLH][((size_t)l * NS + 16 * u + 4 * tt + fq) * 512 + ch];
        }
        if constexpr (PASSB) {
#pragma unroll
            for (int tt = 0; tt < 4; ++tt) { float s = cin[tt];
#pragma unroll
                for (int r = 0; r < 4; ++r) { const int t = 16 * tt + 4 * fq + r; s = av[tt][r] * s + bv[tt][r];
                    if (t < len) hdst[(size_t)t * D + ch] = (bf16_t)f2bf(s); }
                if (SAMPLE) P.out[OFF_SLH + ((size_t)l * NS + 16 * u + 4 * tt + fq) * 512 + ch] = s; }
        }
    }
}

__device__ __forceinline__ void m1_lru_unit(const Params& P, const LayerPtrs& L, int l, int b, int c, LAS unsigned char* lds, int wave, int lane_in) {
    int lane = lane_in; asm volatile("" : "+v"(lane));
    lru_build_xc<false, false>(P, L, l, b, c, 0, lds, wave * 64 + lane);
    __syncthreads();
    const int len = (LP - 64 * c) < 64 ? (LP - 64 * c) : 64;
    lru_wave<false, false>(P, L, l, b, c, 0, len, lds, wave, lane, nullptr);
    __syncthreads();
}

template <bool FROM_LDS, bool GELU>
__device__ __forceinline__ void m3_finish(const LAS unsigned char* gl, const bf16_t* gate_rows  , const float* gain, bf16_t* mixed_rows, int len, int wave, int lane) {
    VM_WAIT(); LDS_WAIT();
    __syncthreads();
    const int c8 = lane * 8;
    const f32x4 g0 = *(const f32x4*)(gain + c8), g1 = *(const f32x4*)(gain + c8 + 4);
    u32x4 sv[8], gv[8];
#pragma unroll
    for (int i = 0; i < 8; ++i) { const int row = wave * 8 + i;
        if (FROM_LDS) sv[i] = *(const LAS u32x4*)(gl + row * 1024 + ((lane ^ (row & 15)) << 4)); else sv[i] = *(const u32x4*)(mixed_rows + (size_t)row * D + c8);
        gv[i] = *(const u32x4*)(gate_rows + (size_t)row * PROJ_LD + c8); }
#pragma unroll
    for (int i = 0; i < 8; ++i) { const int row = wave * 8 + i;
        float v[8]; const unsigned sw[4] = {sv[i].x, sv[i].y, sv[i].z, sv[i].w}, gw[4] = {gv[i].x, gv[i].y, gv[i].z, gv[i].w};
        float sq = 0.f;
#pragma unroll
        for (int k = 0; k < 4; ++k) { const float s0 = bf2f(sw[k] & 0xffffu), s1 = bf2f(sw[k] >> 16), z0 = bf2f(gw[k] & 0xffffu), z1 = bf2f(gw[k] >> 16);
            v[2 * k] = s0 * (GELU ? gelu_tanh(z0) : siluf_(z0)); v[2 * k + 1] = s1 * (GELU ? gelu_tanh(z1) : siluf_(z1)); sq += v[2 * k] * v[2 * k] + v[2 * k + 1] * v[2 * k + 1]; }
        const float rs = __builtin_amdgcn_rsqf(wave_sum(sq, lane) * (1.0f / 512.0f) + EPS);
        if (row < len) { u32x4 w; w.x = pk2(v[0] * rs * g0[0], v[1] * rs * g0[1]); w.y = pk2(v[2] * rs * g0[2], v[3] * rs * g0[3]); w.z = pk2(v[4] * rs * g1[0], v[5] * rs * g1[1]); w.w = pk2(v[6] * rs * g1[2], v[7] * rs * g1[3]);
            *(u32x4*)(mixed_rows + (size_t)row * D + c8) = w; }
    }
    __syncthreads();
}
template <bool SAMPLE>
__device__ __forceinline__ void m3_lru_unit(const Params& P, const LayerPtrs& L, int l, int b, int c, int u, LAS unsigned char* lds, int wave, int lane_in) {
    int lane = lane_in; asm volatile("" : "+v"(lane));
    const int tid = wave * 64 + lane; unsigned char* ws = P.ws;
    bf16_t* mixed = (bf16_t*)(ws + WS_MIXED); const bf16_t* proj = (const bf16_t*)(ws + WS_PROJ);
    const size_t rowbase = SAMPLE ? (size_t)MP + 64 * (size_t)u : (size_t)b * LP + 64 * (size_t)c;
    const int len = SAMPLE ? 64 : ((LP - 64 * c) < 64 ? (LP - 64 * c) : 64);
    lru_build_xc<SAMPLE, true>(P, L, l, b, c, u, lds, tid);
    __syncthreads();
    lru_wave<true, SAMPLE>(P, L, l, b, c, u, len, lds, wave, lane, mixed + rowbase * D);
    m3_finish<false, true>(nullptr, proj + rowbase * PROJ_LD + O_LG, L.lon, mixed + rowbase * D, len, wave, lane);
}
template <bool SAMPLE>
__device__ __forceinline__ void m3_ssd_unit(const Params& P, const LayerPtrs& L, int l, int b, int c, int u, LAS unsigned char* lds, int wave, int lane_in) {
    int lane = lane_in; asm volatile("" : "+v"(lane));
    const int tid = wave * 64 + lane, fr = lane & 15, fq = lane >> 4, h = wave; unsigned char* ws = P.ws;
    const bf16_t* proj = (const bf16_t*)(ws + WS_PROJ); const float* csbuf = (const float*)(ws + WS_CS); const bf16_t* ybuf = (const bf16_t*)(ws + WS_YBUF);
    bf16_t* mixed = (bf16_t*)(ws + WS_MIXED);
    const size_t rowbase = SAMPLE ? (size_t)MP + 64 * (size_t)u : (size_t)b * LP + 64 * (size_t)c;
    const int len = SAMPLE ? 64 : ((LP - 64 * c) < 64 ? (LP - 64 * c) : 64);
    u32x2 yy[4][4]; float ev[4];
#pragma unroll
    for (int tt = 0; tt < 4; ++tt) { const size_t row = rowbase + 16 * tt + fr; ev[tt] = SAMPLE ? 0.f : csbuf[row * 8 + h];
#pragma unroll
        for (int pt = 0; pt < 4; ++pt) yy[tt][pt] = *(const u32x2*)(ybuf + row * 512 + h * 64 + 16 * pt + 4 * fq); }
    bf16x8 pfr[4][4];
    if constexpr (!SAMPLE) {
        const bf16_t* hp = (const bf16_t*)(ws + WS_SINB) + (((size_t)b * NCH + c) * 8 + h) * 8192;
#pragma unroll
        for (int pt = 0; pt < 4; ++pt)
#pragma unroll
            for (int ks = 0; ks < 4; ++ks) pfr[pt][ks] = *(const bf16x8*)(hp + (16 * pt + fr) * 128 + 32 * ks + 8 * fq);
    }
    if constexpr (!SAMPLE) {
        const int cc = tid & 255, half = tid >> 8, chan = 768 + cc; const size_t rowb = (size_t)b * LP;
        float o[32]; conv4_run<32>(proj + O_XBC + chan, rowb, 64 * c + 32 * half, L.scw[chan], L.scw[1024 + chan], L.scw[2048 + chan], L.scw[3072 + chan], L.scb[chan], true, o);
#pragma unroll
        for (int i = 0; i < 32; ++i) *(LAS bf16_t*)(lds + M3_CG + (cc >> 7) * 17408 + (32 * half + i) * 272 + (cc & 127) * 2) = (bf16_t)f2bf(o[i]);
        __syncthreads();
    }
    LAS unsigned char* GL = lds + M3_XC;
    {
        const LAS unsigned char* CG = lds + M3_CG + (h >> 2) * 17408;
#pragma unroll
        for (int tt = 0; tt < 4; ++tt) {
            f32x4 acc[4];
#pragma unroll
            for (int pt = 0; pt < 4; ++pt) acc[pt] = (f32x4){0.f, 0.f, 0.f, 0.f};
            if constexpr (!SAMPLE) {
#pragma unroll
                for (int ks = 0; ks < 4; ++ks) { const bf16x8 cf = ldsfrag(CG, 272, 16 * tt + fr, 64 * ks + 16 * fq);
#pragma unroll
                    for (int pt = 0; pt < 4; ++pt) acc[pt] = mfma16(pfr[pt][ks], cf, acc[pt]); }
            }
            const int t = 16 * tt + fr; const float e = SAMPLE ? 0.f : __expf(ev[tt]);
#pragma unroll
            for (int pt = 0; pt < 4; ++pt) {
                const f32x4 y = (f32x4){bf2f(yy[tt][pt].x & 0xffffu), bf2f(yy[tt][pt].x >> 16), bf2f(yy[tt][pt].y & 0xffffu), bf2f(yy[tt][pt].y >> 16)} + acc[pt] * e;
                u32x2 w; w.x = pk2(y[0], y[1]); w.y = pk2(y[2], y[3]); const int c16 = (h * 8 + 2 * pt + (fq >> 1)) ^ (t & 15); *(LAS u32x2*)(GL + t * 1024 + c16 * 16 + (fq & 1) * 8) = w;
            }
        }
    }
    m3_finish<true, false>(GL, proj + rowbase * PROJ_LD + O_Z, L.son, mixed + rowbase * D + 512, len, wave, lane);
}

__device__ __forceinline__ void m2_phase(const Params& P, int l, const int tid, const int dry) {
    unsigned char* ws = P.ws; float* states = (float*)(ws + WS_STATES); const float* cdec = (const float*)(ws + WS_CDEC);
    for (int e4 = blockIdx.x * 512 + tid; e4 < NB * 8 * 2048; e4 += gridDim.x * 512) {
        const int bh = e4 >> 11, off = (e4 & 2047) * 4, b = bh >> 3, h = bh & 7;
        f32x4 run = (f32x4){0.f, 0.f, 0.f, 0.f};
#pragma unroll 3
        for (int c = 0; c < NCH; ++c) { const size_t eo = (((size_t)b * NCH + c) * 8 + h) * 8192 + off; const f32x4 sc = *(const f32x4*)(states + eo); { u32x2 w; w.x = pk2(run[0], run[1]); w.y = pk2(run[2], run[3]); *(u32x2*)((bf16_t*)(ws + WS_SINB) + eo) = w; } const float d = cdec[((size_t)b * NCH + c) * 8 + h]; run = run * d + sc; }
        if (!dry || run[0] == 12345.678f) *(f32x4*)(P.out + OFF_PSS + (((size_t)l * NB + b) * 8 + h) * 8192 + off) = run;
    }
    if (dry) return;
    const float* lruA = (const float*)(ws + WS_LRUA); const float* lruH = (const float*)(ws + WS_LRUH); float* lruHin = (float*)(ws + WS_LRUHIN);
    for (int i = blockIdx.x * 512 + tid; i < NB * 512; i += gridDim.x * 512) {
        const int b = i >> 9, ch = i & 511; float hv = 0.f;
        for (int c = 0; c < NCH; ++c) { const size_t o = ((size_t)b * NCH + c) * 512 + ch; lruHin[o] = hv; hv = lruA[o] * hv + lruH[o]; }
        P.out[OFF_PLH + ((size_t)l * NB + b) * 512 + ch] = hv;
    }
}


__device__ __forceinline__ void ffn_sample_phase(const Params& P, int l, const int tid) {
    unsigned char* ws = P.ws; const float* us = (const float*)(ws + WS_USAMP); bf16_t* abuf = (bf16_t*)(ws + WS_ABUF);
    const float* cw = P.in[I_FCW] + (size_t)l * 3 * 6144; const float* cb = P.in[I_FCB] + (size_t)l * 6144; const float* st = P.in[I_SFC] + (size_t)l * NS * 2 * 6144;
    float* sf = P.out + OFF_SFC + (size_t)l * NS * 2 * 6144;
    for (int i = blockIdx.x * 512 + tid; i < NS * 768; i += gridDim.x * 512) {
        const int sq = i / 768, c = (i % 768) * 4;
        f32x4 res[4];
#pragma unroll
        for (int half = 0; half < 2; ++half) {
            const int col = c + 3072 * half;
            const f32x4 w0 = *(const f32x4*)(cw + col), w1 = *(const f32x4*)(cw + 6144 + col), w2 = *(const f32x4*)(cw + 2 * 6144 + col), bb = *(const f32x4*)(cb + col);
            f32x4 p2 = *(const f32x4*)(st + ((size_t)sq * 2) * 6144 + col), p1 = *(const f32x4*)(st + ((size_t)sq * 2 + 1) * 6144 + col);
#pragma unroll
            for (int t = 0; t < 4; ++t) {
                const f32x4 uu = *(const f32x4*)(us + ((size_t)sq * 4 + t) * 6144 + col);
                f32x4 cv = bb + w0 * p2 + w1 * p1 + w2 * uu;
                if (half == 0) { cv[0] = gelu_tanh(cv[0]); cv[1] = gelu_tanh(cv[1]); cv[2] = gelu_tanh(cv[2]); cv[3] = gelu_tanh(cv[3]); res[t] = cv; } else res[t] = res[t] * cv;
                if (t >= 2) *(f32x4*)(sf + ((size_t)sq * 2 + (t - 2)) * 6144 + col) = uu;
                p2 = p1; p1 = uu;
            }
        }
#pragma unroll
        for (int t = 0; t < 4; ++t) { u32x2 w; w.x = pk2(res[t][0], res[t][1]); w.y = pk2(res[t][2], res[t][3]); *(u32x2*)(abuf + ((size_t)MP + (size_t)sq * 4 + t) * DFF + c) = w; }
    }
}

__device__ __forceinline__ void final_phase(const Params& P, int wave, int lane) {
    const bf16_t* xb = (const bf16_t*)(P.ws + WS_XB); const float* gn = P.in[I_NFIN];
    const int gw = blockIdx.x * 8 + wave, NGW = gridDim.x * 8;
    for (int m = gw; m < MT; m += NGW) {
        float* dst;
        if (m < MP) { const int b = m / LP, t = m % LP; if (t < NMETA) continue; dst = P.out + OFF_YP + ((size_t)b * SEQ + (t - NMETA)) * D; }
        else dst = P.out + OFF_YS + (size_t)(m - MP) * D;
        f32x4 v[4]; float s = 0.f;
#pragma unroll
        for (int j = 0; j < 4; ++j) { const u32x2 w = *((const u32x2*)(xb + (size_t)m * D) + lane + 64 * j); v[j][0] = bf2f(w.x & 0xffffu); v[j][1] = bf2f(w.x >> 16); v[j][2] = bf2f(w.y & 0xffffu); v[j][3] = bf2f(w.y >> 16);
            s += (v[j][0] * v[j][0] + v[j][1] * v[j][1]) + (v[j][2] * v[j][2] + v[j][3] * v[j][3]); }
        const float rs = __builtin_amdgcn_rsqf(wave_sum(s, lane) * (1.0f / 1024.0f) + EPS);
#pragma unroll
        for (int j = 0; j < 4; ++j) { const f32x4 g4 = *((const f32x4*)gn + lane + 64 * j); *((f32x4*)dst + lane + 64 * j) = v[j] * rs * g4; }
    }
}

__global__ void __launch_bounds__(512, 2) hymba_fwd(Params P) {
    extern __shared__ __attribute__((aligned(16))) unsigned char lds_raw[];
    LAS unsigned char* lds = (LAS unsigned char*)lds_raw;
    int wave0 = __builtin_amdgcn_readfirstlane((int)threadIdx.x >> 6);
    asm volatile("" : "+s"(wave0));
#define MYTID() (wave0 * 64 + my_lane_volatile())
    { const int tid = MYTID(); for (int i = tid; i < (LDS_BYTES - LDS_MISC) / 4; i += 512) ((LAS unsigned*)(lds + LDS_MISC))[i] = 0u; }
    __syncthreads();
    { unsigned char* w_ = P.ws; asm volatile("" : "+s"(w_)); w_ = glob(w_); (void)xcd_barrier_post((unsigned*)(w_ + WS_CTL) + 4096, (volatile LAS unsigned*)(lds + LDS_MISC) + 8, MYTID()); }
#define GRID_BAR() do { unsigned char* w_ = P.ws; asm volatile("" : "+s"(w_)); w_ = glob(w_); XcdBarrier b_; b_.bar = (unsigned*)(w_ + WS_CTL) + 4096; b_.x = xb_xcc_id(); b_.st = (volatile LAS unsigned*)(lds + LDS_MISC) + 8; \
        int t_ = MYTID(); asm volatile("" : "+v"(t_)); xcd_barrier(b_, t_); } while (0)
#define PHASE_ENV() Params Q = P; asm volatile("" : "+s"(Q.ws), "+s"(Q.out)); Q.ws = glob(Q.ws); Q.out = glob(Q.out); _Pragma("unroll") for (int i_ = 0; i_ < 31; ++i_) Q.in[i_] = glob(Q.in[i_]); unsigned char* ws = Q.ws; (void)ws; int ptid = MYTID(); asm volatile("" : "+v"(ptid)); const int lane = ptid & 63, wave = __builtin_amdgcn_readfirstlane(ptid >> 6); (void)lane; (void)wave; int G = (int)gridDim.x, bid = (int)blockIdx.x; asm volatile("" : "+s"(G), "+s"(bid)); (void)G; (void)bid

    if (PH_MASK & 1) { PHASE_ENV(); if (REP_MASK & 256) p0_prologue(Q, lds, wave, lane, ptid); p0_prologue(Q, lds, wave, lane, ptid); }
    { cg::grid_group grid = cg::this_grid(); grid.sync(); }
    GRID_BAR();

#pragma unroll 1
    for (int l = 0; l < DEPTH; ++l) {
        if (PH_MASK & 2) {
            PHASE_ENV();
            pg8::Gemm g{(const bf16_t*)(ws + WS_XB), (const bf16_t*)(ws + WS_W + (size_t)l * W_LAYER + W_IN), D, 67, 11, (long)256 * D * 2, (long)128 * D * 2, 0};
            pg8::ConsOrder S; S.init(67, 11, G, bid, (REP_MASK & 1) ? 2 : 1); S.cnt = (unsigned*)(ws + WS_CTL) + 16384 + ((l > 0 ? l - 1 : 0) * 2 + 1) * 67 * 64; S.need = l > 0 ? 4u : 0u; S.tmo = (unsigned*)(ws + WS_CTL) + 8; S.ovl = 0; S.wid = wave; S.nP = 67;
            pg8::EpiIn E{(bf16_t*)(ws + WS_PROJ), (float*)(ws + WS_DTRAW), (const float*)(ws + WS_SS) + (size_t)(2 * l) * MPAD * 16};
            pg8::gemm_phase<pg8::EpiIn, pg8::ConsOrder, true, true>(lds, g, S, E, ptid);
        }
        GRID_BAR();
        {
            PHASE_ENV();
            const LayerPtrs L = layer_ptrs(Q, l);
            constexpr int N_SSD = NB * NCH * 2, N_LRU = NB * NCH, N_SMP = NS;
            constexpr int M1_REP = (REP_MASK & 2) ? (N_SSD + N_LRU + N_SMP) : (REP_MASK & 32768) ? N_SSD : (REP_MASK & 65536) ? N_LRU : (REP_MASK & 131072) ? N_SMP : 0;
            constexpr int M1_REP0 = (REP_MASK & 65536) ? N_SSD : (REP_MASK & 131072) ? N_SSD + N_LRU : 0;
            for (int it_ = bid; it_ < (N_SSD + N_LRU + N_SMP) + M1_REP; it_ += G) {
                const int it = it_ < (N_SSD + N_LRU + N_SMP) ? it_ : M1_REP0 + (it_ - (N_SSD + N_LRU + N_SMP));
                if (it < N_SSD) { if (PH_MASK & 4) { const int b = it / (NCH * 2), r = it % (NCH * 2); m1_ssd_unit(Q, L, l, b, r >> 1, r & 1, lds, wave, lane); } }
                else if (it < N_SSD + N_LRU) { const int r = it - N_SSD; if (PH_MASK & 8) m1_lru_unit(Q, L, l, r / NCH, r % NCH, lds, wave, lane); }
                else { if (PH_MASK & 16) m1_sample_ssd_unit(Q, L, l, it - N_SSD - N_LRU, lds, wave, lane); __syncthreads(); }
            }
        }
        GRID_BAR();
        if (REP_MASK & 128) { for (int eb_ = 0; eb_ < 10; ++eb_) GRID_BAR(); }
        if (PH_MASK & 32) { PHASE_ENV(); m2_phase(Q, l, ptid, 0); }
        GRID_BAR();
        {
            PHASE_ENV();
            const LayerPtrs L = layer_ptrs(Q, l);
            constexpr int N_PR = NB * NCH, N_SM = MS / 64, N_U = N_PR + N_SM;
            for (int it_ = bid; it_ < 2 * N_U * ((REP_MASK & 4) ? 2 : 1); it_ += G) {
                const int it = it_ % (2 * N_U), kind = it / N_U, un = it % N_U;
                if (kind == 0) { if (un < N_PR) { if (PH_MASK & 64) m3_ssd_unit<false>(Q, L, l, un / NCH, un % NCH, 0, lds, wave, lane); } else if (PH_MASK & 128) m3_ssd_unit<true>(Q, L, l, 0, 0, un - N_PR, lds, wave, lane); }
                else { if (un < N_PR) { if (PH_MASK & 64) m3_lru_unit<false>(Q, L, l, un / NCH, un % NCH, 0, lds, wave, lane); } else if (PH_MASK & 128) m3_lru_unit<true>(Q, L, l, 0, 0, un - N_PR, lds, wave, lane); }
            }
        }
        GRID_BAR();
        if (PH_MASK & 256) {
            PHASE_ENV();
            pg8::Gemm g{(const bf16_t*)(ws + WS_MIXED), (const bf16_t*)(ws + WS_W + (size_t)l * W_LAYER + W_OUT), D, 67, 4, (long)256 * D * 2, (long)128 * D * 2, 0};
            pg8::ProdOrder S; S.init(67, 4, G, (bid + G - (69 * 24) % G) % G); S.cnt = (unsigned*)(ws + WS_CTL) + 16384 + (l * 2 + 0) * 67 * 64; S.tid = ptid;
            pg8::EpiRes E{(bf16_t*)(ws + WS_XB), (float*)(ws + WS_SS) + (size_t)(2 * l + 1) * MPAD * 16};
            pg8::gemm_phase<pg8::EpiRes, pg8::ProdOrder, true, true>(lds, g, S, E, ptid);
        }
        if (PH_MASK & 512) {
            PHASE_ENV();
            pg8::Gemm g{(const bf16_t*)(ws + WS_XB) - 2 * D, (const bf16_t*)(ws + WS_W + (size_t)l * W_LAYER + W_UP), D, 69, 24, (long)248 * D * 2, (long)124 * D * 2, 1};
            pg8::ConsOrder S; S.init(69, 24, G, bid, (REP_MASK & (8 | 512 | 8192 | 16384)) ? 2 : 1); S.cnt = (unsigned*)(ws + WS_CTL) + 16384 + (l * 2 + 0) * 67 * 64; S.need = 4u; S.tmo = (unsigned*)(ws + WS_CTL) + 8; S.ovl = 1; S.wid = wave; S.nP = 67;
            pg8::EpiUp E{(bf16_t*)(ws + WS_ABUF), (const float*)(ws + WS_SS) + (size_t)(2 * l + 1) * MPAD * 16, Q.in[I_FCW] + (size_t)l * 3 * 6144, Q.in[I_FCB] + (size_t)l * 6144,
                         Q.out + OFF_PFC + (size_t)l * NB * 2 * 6144, (float*)(ws + WS_USAMP), (void*)(ws + WS_X)};
            pg8::gemm_phase<pg8::EpiUp, pg8::ConsOrder, true, true>(lds, g, S, E, ptid);
        }
        GRID_BAR();
        if (PH_MASK & 512) { PHASE_ENV(); ffn_sample_phase(Q, l, ptid); }
        GRID_BAR();
        if (PH_MASK & 1024) {
            PHASE_ENV();
            pg8::Gemm g{(const bf16_t*)(ws + WS_ABUF), (const bf16_t*)(ws + WS_W + (size_t)l * W_LAYER + W_DOWN), DFF, 67, 4, (long)256 * DFF * 2, (long)128 * DFF * 2, 0};
            pg8::ProdOrder S; S.init(67, 4, G, (bid + G - (67 * 11) % G) % G); S.cnt = (unsigned*)(ws + WS_CTL) + 16384 + (l * 2 + 1) * 67 * 64; S.tid = ptid;
            pg8::EpiRes E{(bf16_t*)(ws + WS_XB), (float*)(ws + WS_SS) + (size_t)(2 * l + 2) * MPAD * 16};
            pg8::gemm_phase<pg8::EpiRes, pg8::ProdOrder, true, true>(lds, g, S, E, ptid);
        }
        if (l == DEPTH - 1) GRID_BAR();
    }
    if (PH_MASK & 2048) { PHASE_ENV(); final_phase(Q, wave, lane); }
}

extern "C" void kernel_launch(void* const* d_in, const int* in_sizes, int n_in, void* d_out, int out_size, void* d_ws, size_t ws_size, hipStream_t stream) {
    static int grid = 0;
    if (grid == 0) {
        if (n_in != 31 || (size_t)out_size != OUT_TOTAL || ws_size < WS_END) { fprintf(stderr, "kernel_launch: unexpected problem (n_in %d, out %d, ws %zu)\n", n_in, out_size, ws_size); grid = -1; return; }
        int dev = 0, cus = 0, per_cu = 0;
        if (hipGetDevice(&dev) != hipSuccess || hipDeviceGetAttribute(&cus, hipDeviceAttributeMultiprocessorCount, dev) != hipSuccess) { grid = -1; return; }
        if (hipFuncSetAttribute((const void*)hymba_fwd, hipFuncAttributeMaxDynamicSharedMemorySize, LDS_BYTES) != hipSuccess) { fprintf(stderr, "kernel_launch: hipFuncSetAttribute failed\n"); grid = -1; return; }
        if (hipOccupancyMaxActiveBlocksPerMultiprocessor(&per_cu, (const void*)hymba_fwd, 512, LDS_BYTES) != hipSuccess || per_cu < 1) { fprintf(stderr, "kernel_launch: occupancy query says %d\n", per_cu); per_cu = 1; }
        (void)hipGetLastError();
        grid = cus * (per_cu > 1 ? 1 : per_cu);
    }
    if (grid < 0) return;
    (void)hipMemsetAsync((char*)d_ws + WS_CTL, 0, CTL_BYTES, stream);
    Params p{};
    for (int i = 0; i < 31; ++i) p.in[i] = (const float*)d_in[i];
    p.out = (float*)d_out; p.ws = (unsigned char*)d_ws;
    void* args[] = {&p};
    hipError_t e = hipLaunchCooperativeKernel((const void*)hymba_fwd, dim3(grid), dim3(512), args, LDS_BYTES, stream);
    if (e != hipSuccess) fprintf(stderr, "kernel_launch: cooperative launch failed: %s (grid %d)\n", hipGetErrorString(e), grid);
}
```

```cpp
#include <hip/hip_runtime.h>
#include <hip/hip_cooperative_groups.h>
#include <cstdio>
#include <cstdint>
namespace cg = cooperative_groups;
#ifndef PH_MASK
#define PH_MASK 0xFFF
#endif
#ifndef TIME_PHASE
#define TIME_WG 0
#define TIME_PHASE -1
#endif
#ifndef REP_MASK
#define REP_MASK 0
#endif

#define LAS __attribute__((address_space(3)))
#define GAS __attribute__((address_space(1)))
template <class T> __device__ __forceinline__ T* glob(T* p) { return (T*)(GAS T*)p; }
template <class T> __device__ __forceinline__ T* glob_launder(T* p) { GAS T* g = (GAS T*)p; asm volatile("" : "+s"(g)); return (T*)g; }
typedef unsigned short bf16_t;
typedef short bf16x8 __attribute__((ext_vector_type(8)));
typedef float f32x4 __attribute__((ext_vector_type(4)));
typedef float f32x2 __attribute__((ext_vector_type(2)));
typedef unsigned u32x4 __attribute__((ext_vector_type(4)));
typedef unsigned u32x2 __attribute__((ext_vector_type(2)));

constexpr int D = 1024, DEPTH = 4, NB = 8, SEQ = 2048, NMETA = 16, LP = SEQ + NMETA, NS = 128, LS = 4;
constexpr int MP = NB * LP, MS = NS * LS, MT = MP + MS, MPAD = 17152;
constexpr int NH = 8, HD = 64, SST = 128, DFF = 3072, PIN = 2568, PINPAD = 2816;
constexpr int O_LX = 0, O_LG = 512, O_Z = 1024, O_XBC = 1536, PROJ_LD = 2560;
constexpr int NCH = 33;
constexpr float EPS = 1e-6f;

constexpr size_t OFF_YP = 0, OFF_YS = OFF_YP + (size_t)NB * SEQ * D, OFF_PLC = OFF_YS + (size_t)MS * D, OFF_PLH = OFF_PLC + (size_t)DEPTH * NB * 3 * 512,
                 OFF_PSC = OFF_PLH + (size_t)DEPTH * NB * 512, OFF_PSS = OFF_PSC + (size_t)DEPTH * NB * 3 * 1024, OFF_PFC = OFF_PSS + (size_t)DEPTH * NB * 8 * 8192,
                 OFF_SLC = OFF_PFC + (size_t)DEPTH * NB * 2 * 6144, OFF_SLH = OFF_SLC + (size_t)DEPTH * NS * 3 * 512, OFF_SSC = OFF_SLH + (size_t)DEPTH * NS * 512,
                 OFF_SSS = OFF_SSC + (size_t)DEPTH * NS * 3 * 1024, OFF_SFC = OFF_SSS + (size_t)DEPTH * NS * 8 * 8192, OUT_TOTAL = OFF_SFC + (size_t)DEPTH * NS * 2 * 6144;

constexpr size_t MiB = 1u << 20;
constexpr size_t WS_CTL = 0, CTL_BYTES = 1 * MiB;
constexpr size_t WS_SS = 495 * MiB;
constexpr size_t WS_LRUW = 2 * MiB;
constexpr size_t WS_DTRAW = 3 * MiB, WS_CS = 4 * MiB, WS_CDEC = 5 * MiB, WS_LRUA = 6 * MiB, WS_LRUH = 7 * MiB, WS_LRUHIN = 8 * MiB;
constexpr size_t WS_W = 9 * MiB;
constexpr size_t W_LAYER = 25 * MiB + MiB / 2, W_IN = 0, W_OUT = 5 * MiB + MiB / 2, W_UP = 7 * MiB + MiB / 2, W_DOWN = 19 * MiB + MiB / 2;
constexpr size_t WS_X = 111 * MiB;
constexpr size_t WS_SINB = WS_X;
constexpr size_t WS_XB = 178 * MiB + 8192;
constexpr size_t WS_PROJ = 212 * MiB;
constexpr size_t WS_YBUF = 296 * MiB;
constexpr size_t WS_STATES = 330 * MiB;
constexpr size_t WS_MIXED = 397 * MiB;
constexpr size_t WS_ABUF = 296 * MiB;
constexpr size_t WS_GSCR = 431 * MiB;
constexpr size_t WS_USAMP = WS_GSCR;
constexpr size_t WS_HLAC = 448 * MiB;
constexpr size_t WS_END = 505 * MiB;
static_assert(WS_W + DEPTH * W_LAYER <= WS_X && WS_X + (size_t)MPAD * D * 4 <= 178 * MiB && WS_XB + (size_t)MPAD * D * 2 <= WS_PROJ, "ws map 1");
static_assert(WS_PROJ + (size_t)MPAD * PROJ_LD * 2 <= WS_YBUF && WS_YBUF + (size_t)MT * 512 * 4 <= WS_STATES && WS_STATES + (size_t)NB * NCH * 8 * 8192 * 4 <= WS_MIXED, "ws map 2");
static_assert(WS_SS + (size_t)9 * MPAD * 16 * 4 <= WS_END && WS_GSCR + 64 * MiB <= WS_SS && WS_USAMP + (size_t)MS * 6144 * 4 <= WS_SS && WS_MIXED + (size_t)MPAD * D * 2 <= WS_GSCR && WS_ABUF + (size_t)MPAD * DFF * 2 <= WS_MIXED, "ws map 3");

__device__ __forceinline__ float bf2f(unsigned b) { return __uint_as_float(b << 16); }
typedef __bf16 bf16x2n_t __attribute__((ext_vector_type(2)));
typedef float f32x2n_t __attribute__((ext_vector_type(2)));
__device__ __forceinline__ unsigned pk2(float lo, float hi) { const f32x2n_t f = {lo, hi}; return __builtin_bit_cast(unsigned, __builtin_convertvector(f, bf16x2n_t)); }
__device__ __forceinline__ unsigned f2bf(float f) { return (unsigned)__builtin_bit_cast(unsigned short, (__bf16)f); }
__device__ __forceinline__ float sigmoidf_(float x) { return __builtin_amdgcn_rcpf(1.0f + __builtin_amdgcn_exp2f(-1.4426950408889634f * x)); }
__device__ __forceinline__ float siluf_(float x) { return x * sigmoidf_(x); }
__device__ __forceinline__ float softplusf_(float x) { const float e = __builtin_amdgcn_exp2f(-1.4426950408889634f * __builtin_fabsf(x)); const float p = e * (1.0f - e * (0.5f - e * (0.33333334f - e * (0.25f - e * 0.2f)))); const float q = 0.6931471805599453f * __builtin_amdgcn_logf(1.0f + e); return fmaxf(x, 0.f) + (e < 0.0625f ? p : q); }
__device__ __forceinline__ float gelu_tanh(float x) { const float e = __builtin_amdgcn_exp2f(x * __builtin_fmaf(-0.10294324f, x * x, -2.3022082f)); return x * __builtin_amdgcn_rcpf(1.0f + e); }
__device__ __forceinline__ float neg_expm1(float y) { const float p = -y * (1.0f + y * (0.5f + y * (0.16666667f + y * (0.041666668f + y * (0.0083333338f + y * 0.0013888889f))))); const float q = 1.0f - __builtin_amdgcn_exp2f(1.4426950408889634f * y); return y > -0.25f ? p : q; }
__device__ __forceinline__ float dpp_ror1(float v) { return __int_as_float(__builtin_amdgcn_mov_dpp(__float_as_int(v), 0x121, 0xF, 0xF, false)); }
__device__ __forceinline__ float dpp_ror2(float v) { return __int_as_float(__builtin_amdgcn_mov_dpp(__float_as_int(v), 0x122, 0xF, 0xF, false)); }
__device__ __forceinline__ float bperm(float v, int srclane) { return __int_as_float(__builtin_amdgcn_ds_bpermute(srclane << 2, __float_as_int(v))); }
__device__ __forceinline__ float rowss(const float* ss, int row) { const f32x4 a = *(const f32x4*)(ss + (size_t)row * 4); return (a[0] + a[1]) + (a[2] + a[3]); }
__device__ __forceinline__ float conv3_dpp(float um, float upm, float w0, float w1, float w2, float b) {
    float o = __builtin_fmaf(w2, um, b);
    asm("s_nop 1\n\t"
        "v_fmac_f32_dpp %0, %1, %3 row_shr:1 row_mask:0xf bank_mask:0xf\n\t"
        "v_fmac_f32_dpp %0, %2, %3 row_shl:15 row_mask:0xf bank_mask:0xf\n\t"
        "v_fmac_f32_dpp %0, %1, %4 row_shr:2 row_mask:0xf bank_mask:0xf\n\t"
        "v_fmac_f32_dpp %0, %2, %4 row_shl:14 row_mask:0xf bank_mask:0xf"
        : "+v"(o) : "v"(um), "v"(upm), "v"(w1), "v"(w0));
    return o;
}
__device__ __forceinline__ float conv3_dpp_first(float um, float w0, float w1, float w2, float b) {
    float o = __builtin_fmaf(w2, um, b);
    asm("s_nop 1\n\t"
        "v_fmac_f32_dpp %0, %1, %2 row_shr:1 row_mask:0xf bank_mask:0xf\n\t"
        "v_fmac_f32_dpp %0, %1, %3 row_shr:2 row_mask:0xf bank_mask:0xf"
        : "+v"(o) : "v"(um), "v"(w1), "v"(w0));
    return o;
}
__device__ __forceinline__ float wave_sum(float v, int lane) {
#pragma unroll
    for (int o = 1; o < 64; o <<= 1) v += bperm(v, lane ^ o);
    return v;
}
#define LDS_WAIT() asm volatile("s_waitcnt lgkmcnt(0)" ::: "memory")
#define VM_WAIT() asm volatile("s_waitcnt vmcnt(0)" ::: "memory")
__device__ __forceinline__ f32x4 mfma16(bf16x8 p, bf16x8 q, f32x4 c) { return __builtin_amdgcn_mfma_f32_16x16x32_bf16(p, q, c, 0, 0, 0); }
__device__ __forceinline__ bf16x8 ldsfrag(const LAS unsigned char* img, int rs, int row, int kbyte) { return *(const LAS bf16x8*)(img + row * rs + kbyte); }

namespace pg8 {
#define PG8_LAS __attribute__((address_space(3)))
constexpr int BM = 256, BK = 64, HALF = 128, HTB = HALF * BK * 2, STAGE_BYTES = 8 * HTB, NXCD = 8, WGM = 8;
__host__ __device__ __forceinline__ int lds_byte(int r, int c) { const int st = (r >> 4) * 2 + (c >> 5), rr = r & 15, cc = c & 31, ob = rr * 64 + cc * 2; return st * 1024 + (ob ^ (((ob >> 9) & 1) << 5)); }
__host__ __device__ __forceinline__ void stage_rc(int b, int& R, int& C) { const int st = b / 1024, sb = b % 1024, swz = sb ^ (((sb >> 9) & 1) << 5); R = (st >> 1) * 16 + swz / 64; C = (st & 1) * 32 + (swz % 64) / 2; }
__host__ __device__ __forceinline__ int perm32(int rho) { const int n = rho >> 4, i = rho & 15; return 8 * (i >> 2) + 4 * n + (i & 3); }
struct Unit { int pm, pn, dry; };
struct Gemm { const bf16_t* A; const bf16_t* Bt; int K, nM, nN; long a_tstep, a_hstep; int ovl; };
struct StaticOrder {
    int nM, nN, nwg, G, c, rep;
    __device__ __forceinline__ void init(int nM_, int nN_, int G_, int c_, int rep_ = 1) { nM = nM_; nN = nN_; nwg = nM * nN; G = G_; c = c_; rep = rep_; }
    __device__ __forceinline__ bool next(int i, Unit& u) const { return from_l((long)i * G + c, u); }
    __device__ __forceinline__ bool from_l(const long L, Unit& u) const {
        if (L >= (long)nwg * rep) return false;
        int wgid = (int)(L % nwg); u.dry = (L >= nwg) ? 1 : 0; { const int q = nwg / NXCD, r = nwg % NXCD, xcd = wgid % NXCD, off = wgid / NXCD; wgid = (xcd < r ? xcd * (q + 1) : r * (q + 1) + (xcd - r) * q) + off; }
        const int nig = WGM * nN, gid = wgid / nig, fm = gid * WGM, gsz = (nM - fm) < WGM ? (nM - fm) : WGM;
        u.pm = fm + ((wgid % nig) % gsz); u.pn = (wgid % nig) / gsz; return true;
    }
    __device__ __forceinline__ void a_ready(const Unit&) const {}
    __device__ __forceinline__ void done(const Unit&) const {}
};
struct ProdOrder : StaticOrder {
    unsigned* cnt; int tid;
    __device__ __forceinline__ bool next(int i, Unit& u) const {
        const long L = (long)i * G + c; if (L >= nwg) return false;
        u.dry = 0;
        const int n0 = 64 * nN;
        if (L < n0) { int wgid = (int)L; { const int q = n0 / NXCD, xcd = wgid % NXCD, off = wgid / NXCD; wgid = xcd * q + off; }
            const int nig = WGM * nN; u.pm = (wgid / nig) * WGM + ((wgid % nig) % WGM); u.pn = (wgid % nig) / WGM; }
        else { const int t = (int)L - n0; u.pm = 64 + t / nN; u.pn = t % nN; }
        return true;
    }
    __device__ __forceinline__ void done(const Unit& u) const {
        asm volatile("s_waitcnt vmcnt(0)" ::: "memory");
        __builtin_amdgcn_s_barrier();
        if (tid == 0) { __builtin_amdgcn_fence(__ATOMIC_RELEASE, "agent"); asm volatile("s_waitcnt vmcnt(0)" ::: "memory");
            __hip_atomic_fetch_add(cnt + 64 * u.pm, 1u, __ATOMIC_RELAXED, __HIP_MEMORY_SCOPE_AGENT); }
    }
};
struct ConsOrder : StaticOrder {
    int nMg = 0;
    int rb = 0;
    __device__ __forceinline__ bool next(int i, Unit& u) const {
        if (nMg == 0) {
            long L = (long)i * G + c;
            if (rb && G == 256) {
                int Lr = -2;
                if (c >= 225 && c <= 236) Lr = i == 0 ? (c == 231 ? 487 : c) : -1;
                else if (c == 223) Lr = i < 2 ? i * 256 + 223 : -1;
                else if (i == 2) { if (c == 237) Lr = 231; else if (c == 240) Lr = 488; else if ((c >= 241 && c <= 246) || (c >= 249 && c <= 252)) Lr = 240 + c; else if (c == 253) Lr = 735; }
                if (Lr == -1) return false;
                if (Lr >= 0) L = Lr;
            }
            return StaticOrder::from_l(L, u);
        }
        const long L = (long)i * G + c; if (L >= (long)nwg * rep) return false;
        const int t = (int)(L % nwg); u.dry = (L >= nwg) ? 1 : 0;
        const int n0 = nMg * nN;
        if (t < n0) { int wgid = t; { const int q = n0 / NXCD, r = n0 % NXCD, xcd = wgid % NXCD, off = wgid / NXCD; wgid = (xcd < r ? xcd * (q + 1) : r * (q + 1) + (xcd - r) * q) + off; }
            const int nig = WGM * nN, gid = wgid / nig, fm = gid * WGM, gsz = (nMg - fm) < WGM ? (nMg - fm) : WGM;
            u.pm = fm + ((wgid % nig) % gsz); u.pn = (wgid % nig) / gsz; }
        else { const int tt = t - n0; u.pm = nMg + tt / nN; u.pn = tt % nN; }
        return true;
    }
    unsigned* cnt; unsigned need; unsigned* tmo; int ovl, wid, nP;
    __device__ __forceinline__ void a_ready(const Unit& u) const {
        if (need == 0u) return;
        if (wid == 0) {
            int p0 = u.pm, p1 = u.pm;
            if (ovl) { int r0 = 248 * u.pm - 2; r0 = r0 < 0 ? 0 : r0; p0 = r0 >> 8; p1 = (248 * u.pm + 253) >> 8; p1 = p1 > nP - 1 ? nP - 1 : p1; }
            unsigned spins = 0;
            for (int p = p0; p <= p1; ++p) {
                while ((unsigned)__builtin_amdgcn_readfirstlane((int)__hip_atomic_load(cnt + 64 * p, __ATOMIC_RELAXED, __HIP_MEMORY_SCOPE_AGENT)) < need) {
                    if (++spins > (1u << 15)) { __hip_atomic_store(tmo, 1u, __ATOMIC_RELAXED, __HIP_MEMORY_SCOPE_AGENT); break; }
                    if ((spins & 255u) == 0u && __builtin_amdgcn_readfirstlane((int)__hip_atomic_load(tmo, __ATOMIC_RELAXED, __HIP_MEMORY_SCOPE_AGENT)) != 0) break;
                    __builtin_amdgcn_s_sleep(4); }
            }
            __builtin_amdgcn_fence(__ATOMIC_ACQUIRE, "agent");
            asm volatile("s_waitcnt vmcnt(0)" ::: "memory");
        }
        asm volatile("" ::: "memory"); __builtin_amdgcn_s_barrier(); asm volatile("" ::: "memory");
    }
};
__device__ __forceinline__ unsigned cvt_pk_bf16(float lo, float hi) { unsigned r; asm volatile("v_cvt_pk_bf16_f32 %0, %1, %2" : "=v"(r) : "v"(lo), "v"(hi)); return r; }

template <class Epi, class Sched, bool ALIGN_EPI, bool SP2>
__device__ __forceinline__ void gemm_phase(PG8_LAS unsigned char* lds, const Gemm g, const Sched& S, const Epi& E, const int tid) {
    const int wid = __builtin_amdgcn_readfirstlane(tid >> 6), lane = tid & 63, wr = wid >> 2, wc = wid & 3, fr = lane & 15, fq = lane >> 4;
    const int K = g.K, nt = K / BK;
    unsigned voffA[2], voffB[2];
#pragma unroll
    for (int i = 0; i < 2; ++i) { int R, C; stage_rc(tid * 16 + i * 8192, R, C); const int Rb = Epi::PERM ? ((R & ~31) + perm32(R & 31)) : R; const int Ra = g.ovl ? (R - 2 * (R >> 6)) : R;
        voffA[i] = (unsigned)(Ra * K + C) * 2u; voffB[i] = (unsigned)(Rb * K + C) * 2u; }
    const size_t kstep = (size_t)(BK * 2);
    const size_t hstepB = (size_t)HALF * K * 2, tstepB = 2 * hstepB;
    const size_t hstepA = (size_t)g.a_hstep, tstepA = (size_t)g.a_tstep;
    const unsigned ldsw = (unsigned)wid * 1024u;
    const int aoff = lds_byte(wr * 64 + fr, fq * 8), boff = lds_byte(wc * 32 + fr, fq * 8);
#define PG8_SA(b, h) (((b) * 2 + (h)) * HTB)
#define PG8_SB(b, h) ((4 + (b) * 2 + (h)) * HTB)
#define PG8_STAGE(bufoff, gbase, voff) do { _Pragma("unroll") for (int _i = 0; _i < 2; ++_i) \
        __builtin_amdgcn_global_load_lds((const unsigned*)((const char*)(gbase) + (voff)[_i]), (PG8_LAS unsigned*)(lds + (bufoff) + ldsw + _i * 8192), 16, 0, 0); } while (0)
#define PG8_LDA(dst, b, h) do { _Pragma("unroll") for (int m = 0; m < 4; ++m) _Pragma("unroll") for (int k = 0; k < 2; ++k) dst[m][k] = *(const PG8_LAS bf16x8*)(lds + PG8_SA(b, h) + aoff + m * 2048 + k * 1024); } while (0)
#define PG8_LDB(dst, b, h) do { _Pragma("unroll") for (int n = 0; n < 2; ++n) _Pragma("unroll") for (int k = 0; k < 2; ++k) dst[n][k] = *(const PG8_LAS bf16x8*)(lds + PG8_SB(b, h) + boff + n * 2048 + k * 1024); } while (0)
#define PG8_MMA(ai, bj, At, Bt) do { __builtin_amdgcn_s_setprio(1); _Pragma("unroll") for (int m = 0; m < 4; ++m) _Pragma("unroll") for (int n = 0; n < 2; ++n) _Pragma("unroll") for (int k = 0; k < 2; ++k) \
        acc[ai][bj][m][n] = __builtin_amdgcn_mfma_f32_16x16x32_bf16(Bt[n][k], At[m][k], acc[ai][bj][m][n], 0, 0, 0); __builtin_amdgcn_s_setprio(0); } while (0)
#define PG8_WAIT_V(n) asm volatile("s_waitcnt vmcnt(" #n ")" ::: "memory")
#define PG8_WAIT_L(n) asm volatile("s_waitcnt lgkmcnt(" #n ")" ::: "memory")
#define PG8_BAR __builtin_amdgcn_s_barrier()
#define PG8_SCHED __builtin_amdgcn_sched_barrier(0)
    Unit cur, nxt; int ui = 0;
    if (!S.next(0, cur)) return;
    f32x4 acc[2][2][4][2];
#pragma unroll
    for (int a = 0; a < 2; ++a)
#pragma unroll
        for (int b = 0; b < 2; ++b)
#pragma unroll
            for (int m = 0; m < 4; ++m)
#pragma unroll
                for (int n = 0; n < 2; ++n) acc[a][b][m][n] = (f32x4){0.f, 0.f, 0.f, 0.f};
    bf16x8 At[4][2], B0[2][2], B1[2][2];
    const char* cA = (const char*)g.A + (size_t)cur.pm * tstepA; const char* cB = (const char*)g.Bt + (size_t)cur.pn * tstepB;
    S.a_ready(cur);
    E.prefetch(lds, cur, 0, wid, lane);
    if constexpr (SP2) {
        PG8_STAGE(PG8_SB(0, 0), cB, voffB); PG8_STAGE(PG8_SB(0, 1), cB + hstepB, voffB); PG8_STAGE(PG8_SA(0, 0), cA, voffA); PG8_STAGE(PG8_SA(0, 1), cA + hstepA, voffA);
        if (wr == 1) PG8_BAR;
        PG8_WAIT_V(2); PG8_BAR;
        PG8_STAGE(PG8_SB(1, 0), cB + kstep, voffB); PG8_STAGE(PG8_SA(1, 0), cA + kstep, voffA); PG8_STAGE(PG8_SB(1, 1), cB + hstepB + kstep, voffB);
        PG8_WAIT_V(6); PG8_BAR;
    } else {
        PG8_STAGE(PG8_SB(0, 0), cB, voffB); PG8_STAGE(PG8_SA(0, 0), cA, voffA); PG8_STAGE(PG8_SB(0, 1), cB + hstepB, voffB); PG8_STAGE(PG8_SA(0, 1), cA + hstepA, voffA);
        if (wr == 1) PG8_BAR;
        PG8_WAIT_V(4); PG8_BAR;
        PG8_STAGE(PG8_SB(1, 0), cB + kstep, voffB); PG8_STAGE(PG8_SA(1, 0), cA + kstep, voffA); PG8_STAGE(PG8_SB(1, 1), cB + hstepB + kstep, voffB);
        PG8_WAIT_V(6); PG8_BAR;
    }
    for (;;) {
        const bool has_next = S.next(ui + 1, nxt);
        const char* nA = has_next ? (const char*)g.A + (size_t)nxt.pm * tstepA : cA; const char* nB = has_next ? (const char*)g.Bt + (size_t)nxt.pn * tstepB : cB;
        for (int t = 0; t < nt; t += 2) {
            const bool last = (t == nt - 2);
            const char* a1 = cA + (size_t)(t + 1) * kstep;
            const char* a2 = last ? nA : cA + (size_t)(t + 2) * kstep; const char* b2 = last ? nB : cB + (size_t)(t + 2) * kstep;
            const char* a3 = a2 + kstep; const char* b3 = b2 + kstep;
            if (last && has_next) { S.a_ready(nxt); E.prefetch(lds, nxt, (ui + 1) & 1, wid, lane); }
            if constexpr (SP2) {
            PG8_LDB(B0, 0, 0); PG8_LDB(B1, 0, 1); PG8_SCHED; PG8_LDA(At, 0, 0); PG8_STAGE(PG8_SA(1, 1), a1 + hstepA, voffA);
            PG8_WAIT_V(8); PG8_WAIT_L(0); PG8_BAR; PG8_MMA(0, 0, At, B0); PG8_MMA(0, 1, At, B1); PG8_BAR; PG8_SCHED;
            PG8_LDA(At, 0, 1); PG8_STAGE(PG8_SB(0, 0), b2, voffB); PG8_STAGE(PG8_SB(0, 1), b2 + hstepB, voffB); PG8_STAGE(PG8_SA(0, 0), a2, voffA);
            PG8_WAIT_V(8); PG8_WAIT_L(0); PG8_BAR; PG8_MMA(1, 0, At, B0); PG8_MMA(1, 1, At, B1); PG8_BAR; PG8_SCHED;
            PG8_LDB(B0, 1, 0); PG8_LDB(B1, 1, 1); PG8_SCHED; PG8_LDA(At, 1, 0); PG8_STAGE(PG8_SA(0, 1), a2 + hstepA, voffA);
            PG8_WAIT_V(8); PG8_WAIT_L(0); PG8_BAR; PG8_MMA(0, 0, At, B0); PG8_MMA(0, 1, At, B1); PG8_BAR; PG8_SCHED;
            PG8_LDA(At, 1, 1); PG8_STAGE(PG8_SB(1, 0), b3, voffB); PG8_STAGE(PG8_SB(1, 1), b3 + hstepB, voffB); PG8_STAGE(PG8_SA(1, 0), a3, voffA);
            PG8_WAIT_V(8); PG8_WAIT_L(0); PG8_BAR; PG8_MMA(1, 0, At, B0); PG8_MMA(1, 1, At, B1); PG8_BAR; PG8_SCHED;
            } else {
            PG8_LDB(B0, 0, 0); PG8_SCHED; PG8_LDA(At, 0, 0); PG8_STAGE(PG8_SA(1, 1), a1 + hstepA, voffA);
            PG8_WAIT_L(8); PG8_BAR; PG8_WAIT_L(0); PG8_MMA(0, 0, At, B0); PG8_BAR; PG8_SCHED;
            PG8_LDB(B1, 0, 1); PG8_STAGE(PG8_SB(0, 0), b2, voffB);
            PG8_BAR; PG8_WAIT_L(0); PG8_MMA(0, 1, At, B1); PG8_BAR;
            PG8_LDA(At, 0, 1); PG8_STAGE(PG8_SA(0, 0), a2, voffA);
            PG8_BAR; PG8_WAIT_L(0); PG8_MMA(1, 0, At, B0); PG8_BAR; PG8_SCHED;
            PG8_STAGE(PG8_SB(0, 1), b2 + hstepB, voffB);
            PG8_WAIT_V(6); PG8_BAR; PG8_MMA(1, 1, At, B1); PG8_BAR;
            PG8_LDB(B0, 1, 0); PG8_SCHED; PG8_LDA(At, 1, 0); PG8_STAGE(PG8_SA(0, 1), a2 + hstepA, voffA);
            PG8_WAIT_L(8); PG8_BAR; PG8_WAIT_L(0); PG8_MMA(0, 0, At, B0); PG8_BAR; PG8_SCHED;
            PG8_LDB(B1, 1, 1); PG8_STAGE(PG8_SB(1, 0), b3, voffB);
            PG8_BAR; PG8_WAIT_L(0); PG8_MMA(0, 1, At, B1); PG8_BAR;
            PG8_LDA(At, 1, 1); PG8_STAGE(PG8_SA(1, 0), a3, voffA);
            PG8_BAR; PG8_WAIT_L(0); PG8_MMA(1, 0, At, B0); PG8_BAR; PG8_SCHED;
            PG8_STAGE(PG8_SB(1, 1), b3 + hstepB, voffB);
            PG8_WAIT_V(6); PG8_BAR; PG8_MMA(1, 1, At, B1); PG8_BAR;
            }
        }
        if constexpr (ALIGN_EPI) { if (wr == 0) PG8_BAR; }
        if constexpr (Epi::TWICE) { int nrep_ = 2; asm volatile("" : "+s"(nrep_));
_Pragma("unroll 1") for (int rep_ = 0; rep_ < nrep_; ++rep_) { asm volatile("" ::: "memory"); E(acc, cur, wr, wc, fr, fq, lds, ui & 1); } }
        else E(acc, cur, wr, wc, fr, fq, lds, ui & 1);
        S.done(cur);
        if (!has_next) break;
#pragma unroll
        for (int a = 0; a < 2; ++a)
#pragma unroll
            for (int b = 0; b < 2; ++b)
#pragma unroll
                for (int m = 0; m < 4; ++m)
#pragma unroll
                    for (int n = 0; n < 2; ++n) acc[a][b][m][n] = (f32x4){0.f, 0.f, 0.f, 0.f};
        cur = nxt; cA = nA; cB = nB; ++ui;
        if constexpr (ALIGN_EPI) { if (wr == 1) PG8_BAR; }
    }
    PG8_WAIT_V(0);
    if constexpr (!ALIGN_EPI) { if (wr == 0) PG8_BAR; }
    PG8_BAR;
#undef PG8_SA
#undef PG8_SB
#undef PG8_STAGE
#undef PG8_LDA
#undef PG8_LDB
#undef PG8_MMA
#undef PG8_WAIT_V
#undef PG8_WAIT_L
#undef PG8_BAR
#undef PG8_SCHED
}


struct EpiIn {
    static constexpr bool PERM = true, TWICE = false;
    bf16_t* proj; float* dtraw; const float* ss;
    __device__ __forceinline__ void prefetch(PG8_LAS unsigned char*, const Unit&, int, int, int) const {}
    __device__ __forceinline__ void operator()(const f32x4 (&acc)[2][2][4][2], const Unit& u, int wr, int wc, int fr, int fq, PG8_LAS unsigned char*, int) const {
        const int row0 = u.pm * BM + wr * 64 + fr;
        if (u.pn < 10) {
            const int col0 = u.pn * BM + wc * 32 + 8 * fq;
#pragma unroll
            for (int ai = 0; ai < 2; ++ai)
#pragma unroll
                for (int m = 0; m < 4; ++m) { const int row = row0 + ai * HALF + m * 16; const float rs = __builtin_amdgcn_rsqf(rowss(ss, row) * (1.0f / 1024.0f) + EPS);
                    bf16_t* rowp = proj + (size_t)row * PROJ_LD + col0;
#pragma unroll
                    for (int bj = 0; bj < 2; ++bj) { const f32x4 v0 = acc[ai][bj][m][0] * rs, v1 = acc[ai][bj][m][1] * rs;
                        u32x4 w; w.x = pk2(v0[0], v0[1]); w.y = pk2(v0[2], v0[3]); w.z = pk2(v1[0], v1[1]); w.w = pk2(v1[2], v1[3]);
                        *(u32x4*)(rowp + bj * HALF) = w; } }
        } else if (wc == 0 && fq == 0) {
#pragma unroll
            for (int ai = 0; ai < 2; ++ai)
#pragma unroll
                for (int m = 0; m < 4; ++m) { const int row = row0 + ai * HALF + m * 16; const float rs = __builtin_amdgcn_rsqf(rowss(ss, row) * (1.0f / 1024.0f) + EPS);
                    float* p = dtraw + (size_t)row * 8; *(f32x4*)p = acc[ai][0][m][0] * rs; *(f32x4*)(p + 4) = acc[ai][0][m][1] * rs; }
        }
    }
};
struct EpiRes {
    static constexpr bool PERM = true, TWICE = false;
    bf16_t* xb; float* ssn;
    __device__ __forceinline__ void prefetch(PG8_LAS unsigned char*, const Unit&, int, int, int) const {}
    static constexpr int SSRED_OFF = 131072 + 512 + 8192;
    __device__ __forceinline__ void operator()(const f32x4 (&acc)[2][2][4][2], const Unit& u, int wr, int wc, int fr, int fq, PG8_LAS unsigned char* lds, int) const {
        const int row0 = u.pm * BM + wr * 64 + fr, col0 = u.pn * BM + wc * 32 + 8 * fq;
        PG8_LAS float* red = (PG8_LAS float*)(lds + SSRED_OFF);
#pragma unroll
        for (int ai = 0; ai < 2; ++ai)
#pragma unroll
            for (int m = 0; m < 4; ++m) { const int row = row0 + ai * HALF + m * 16; float part = 0.f;
#pragma unroll
                for (int bj = 0; bj < 2; ++bj) { bf16_t* xp = xb + (size_t)row * D + col0 + bj * HALF; const u32x4 old = *(const u32x4*)xp;
                    f32x4 o0, o1;
                    o0[0] = bf2f(old.x & 0xffffu) + acc[ai][bj][m][0][0]; o0[1] = bf2f(old.x >> 16) + acc[ai][bj][m][0][1]; o0[2] = bf2f(old.y & 0xffffu) + acc[ai][bj][m][0][2]; o0[3] = bf2f(old.y >> 16) + acc[ai][bj][m][0][3];
                    o1[0] = bf2f(old.z & 0xffffu) + acc[ai][bj][m][1][0]; o1[1] = bf2f(old.z >> 16) + acc[ai][bj][m][1][1]; o1[2] = bf2f(old.w & 0xffffu) + acc[ai][bj][m][1][2]; o1[3] = bf2f(old.w >> 16) + acc[ai][bj][m][1][3];
                    part += (o0[0] * o0[0] + o0[1] * o0[1]) + (o0[2] * o0[2] + o0[3] * o0[3]) + (o1[0] * o1[0] + o1[1] * o1[1]) + (o1[2] * o1[2] + o1[3] * o1[3]);
                    u32x4 w; w.x = pk2(o0[0], o0[1]); w.y = pk2(o0[2], o0[3]); w.z = pk2(o1[0], o1[1]); w.w = pk2(o1[2], o1[3]);
                    *(u32x4*)xp = w; }
                { const int ln = fr + 16 * fq; part += bperm(part, ln ^ 16); part += bperm(part, ln ^ 32); }
                if (fq == 0) red[wc * 256 + ai * HALF + wr * 64 + m * 16 + fr] = part; }
        asm volatile("s_waitcnt lgkmcnt(0)" ::: "memory"); __builtin_amdgcn_s_barrier(); asm volatile("" ::: "memory");
        const int r = (wr * 4 + wc) * 64 + fq * 16 + fr;
        if (r < 256) ssn[(size_t)(u.pm * BM + r) * 4 + u.pn] = (red[r] + red[256 + r]) + (red[512 + r] + red[768 + r]);
    }
};
struct EpiUp {
    static constexpr bool PERM = true, TWICE = (REP_MASK & 1024) != 0;
    bf16_t* a; const float* ss; const float* cw; const float* cb; float* pf; float* usamp; void* dummy;
    static constexpr int CWS_OFF = 131072 + 512;
    __device__ __forceinline__ void prefetch(PG8_LAS unsigned char* lds, const Unit& u, int slot, int wid, int lane) const {
        if (wid < 4) { const int seg = 2 * wid + (lane >> 5), k = seg & 3, el = (lane & 31) * 4;
            const float* src = (k < 3 ? cw + k * 6144 : cb) + (seg >> 2) * 3072 + u.pn * 128 + el;
            __builtin_amdgcn_global_load_lds((const unsigned*)src, (PG8_LAS unsigned*)(lds + CWS_OFF + slot * 4096 + wid * 1024), 16, 0, 0); }
    }
    __device__ __forceinline__ void operator()(const f32x4 (&acc)[2][2][4][2], const Unit& u, int wr, int wc, int fr, int fq, PG8_LAS unsigned char* lds, int slot) const {
        const int ch0 = u.pn * 128 + wc * 32 + 8 * fq;
        const PG8_LAS float* cws = (const PG8_LAS float*)(lds + CWS_OFF + slot * 4096) + wc * 32 + 8 * fq;
        if ((REP_MASK & 512) && u.dry) return;
        bf16_t* a = this->a;
        int rmask = 0x7fffffff;
        if ((REP_MASK & (8192 | 16384)) && u.dry) { a = (bf16_t*)dummy; rmask = 8191; }
        if ((REP_MASK & 16384) && u.dry) {
#pragma unroll
            for (int ai = 0; ai < 2; ++ai) { const int gr0 = u.pm * 248 + 62 * (2 * ai + wr) - 2;
#pragma unroll
                for (int m = 0; m < 4; ++m) { const int gr = gr0 + 16 * m + fr; const int idx = gr < 0 ? 0 : gr; const float rs = __builtin_amdgcn_rsqf(rowss(ss, idx) * (1.0f / 1024.0f) + EPS);
#pragma unroll
                    for (int n = 0; n < 2; ++n) { const f32x4 g4 = acc[ai][0][m][n] * rs, v4 = acc[ai][1][m][n] * rs; u32x2 w; w.x = cvt_pk_bf16(g4[0] * v4[0], g4[1] * v4[1]); w.y = cvt_pk_bf16(g4[2] * v4[2], g4[3] * v4[3]);
                        if (gr >= 0 && gr < MP) *(u32x2*)(a + (size_t)(gr & rmask) * DFF + ch0 + 4 * n) = w; } } }
            return;
        }
        constexpr int INV = (int)0x80000000;
#pragma unroll
        for (int ai = 0; ai < 2; ++ai) {
            const int gr0 = u.pm * 248 + 62 * (2 * ai + wr) - 2;
            float rs[4]; int tk[4];
            bool plain = true;
#pragma unroll
            for (int m = 0; m < 4; ++m) { const int lr = 16 * m + fr, gr = gr0 + lr; const int idx = gr < 0 ? 0 : gr; rs[m] = __builtin_amdgcn_rsqf(rowss(ss, idx) * (1.0f / 1024.0f) + EPS);
                tk[m] = (lr >= 2 && gr < MT) ? (gr < MP ? gr % LP : -1 - (gr - MP)) : INV;
                plain = plain && (tk[m] == INV || (tk[m] >= 2 && tk[m] < LP - 2)); }
            const bool all_plain = __builtin_amdgcn_ballot_w64(!plain) == 0ull;
            bool smp = true;
#pragma unroll
            for (int m = 0; m < 4; ++m) smp = smp && (tk[m] < 0);
            if (__builtin_amdgcn_ballot_w64(!smp) == 0ull) {
#pragma unroll
                for (int m = 0; m < 4; ++m) if (tk[m] != INV) { float* o = usamp + (size_t)(-1 - tk[m]) * 6144 + ch0;
#pragma unroll
                    for (int n = 0; n < 2; ++n) { *(f32x4*)(o + 4 * n) = acc[ai][0][m][n] * rs[m]; *(f32x4*)(o + 3072 + 4 * n) = acc[ai][1][m][n] * rs[m]; } }
            } else
            if (all_plain) {
                unsigned pk[4][4];
#pragma unroll
                for (int n = 0; n < 2; ++n) {
                    float keep[4];
#pragma unroll
                    for (int j = 0; j < 4; ++j) {
                        const float wg0 = cws[4 * n + j], wg1 = cws[128 + 4 * n + j], wg2 = cws[256 + 4 * n + j], bg = cws[384 + 4 * n + j];
                        const float wv0 = cws[512 + 4 * n + j], wv1 = cws[640 + 4 * n + j], wv2 = cws[768 + 4 * n + j], bv = cws[896 + 4 * n + j];
                        float ug[4], uv[4];
#pragma unroll
                        for (int m = 0; m < 4; ++m) { ug[m] = acc[ai][0][m][n][j] * rs[m]; uv[m] = acc[ai][1][m][n][j] * rs[m]; }
#pragma unroll
                        for (int m = 0; m < 4; ++m) {
                            const float cg_ = m == 0 ? conv3_dpp_first(ug[0], wg0, wg1, wg2, bg) : conv3_dpp(ug[m], ug[m > 0 ? m - 1 : 0], wg0, wg1, wg2, bg);
                            const float cv_ = m == 0 ? conv3_dpp_first(uv[0], wv0, wv1, wv2, bv) : conv3_dpp(uv[m], uv[m > 0 ? m - 1 : 0], wv0, wv1, wv2, bv);
                            const float r_ = gelu_tanh(cg_) * cv_;
                            if (j & 1) pk[m][2 * n + (j >> 1)] = cvt_pk_bf16(keep[m], r_); else keep[m] = r_;
                        }
                    }
                }
#pragma unroll
                for (int m = 0; m < 4; ++m) { if (tk[m] >= 0) { u32x4 w; w.x = pk[m][0]; w.y = pk[m][1]; w.z = pk[m][2]; w.w = pk[m][3]; *(u32x4*)(a + (size_t)((gr0 + 16 * m + fr) & rmask) * DFF + ch0) = w; } }
            } else {
#pragma unroll
                for (int n = 0; n < 2; ++n) {
                    float keep[4]; unsigned pk[4][2];
#pragma unroll
                    for (int j = 0; j < 4; ++j) {
                        const int col = ch0 + 4 * n + j;
                        const float wg0 = cws[4 * n + j], wg1 = cws[128 + 4 * n + j], wg2 = cws[256 + 4 * n + j], bg = cws[384 + 4 * n + j];
                        const float wv0 = cws[512 + 4 * n + j], wv1 = cws[640 + 4 * n + j], wv2 = cws[768 + 4 * n + j], bv = cws[896 + 4 * n + j];
                        float pv1g = 0.f, pv2g = 0.f, pv1v = 0.f, pv2v = 0.f;
#pragma unroll
                        for (int m = 0; m < 4; ++m) {
                            const float ug = acc[ai][0][m][n][j] * rs[m], uv = acc[ai][1][m][n][j] * rs[m];
                            const float r1g = dpp_ror1(ug), r2g = dpp_ror2(ug), r1v = dpp_ror1(uv), r2v = dpp_ror2(uv);
                            float p1g = fr >= 1 ? r1g : pv1g, p2g = fr >= 2 ? r2g : pv2g, p1v = fr >= 1 ? r1v : pv1v, p2v = fr >= 2 ? r2v : pv2v;
                            pv1g = r1g; pv2g = r2g; pv1v = r1v; pv2v = r2v;
                            const int t = tk[m];
                            if (t >= 0) { if (t < 1) { p1g = 0.f; p1v = 0.f; } if (t < 2) { p2g = 0.f; p2v = 0.f; }
                                if (t >= LP - 2) { const int gr = gr0 + 16 * m + fr; float* o = pf + ((size_t)(gr / LP) * 2 + (t - (LP - 2))) * 6144 + col; o[0] = ug; o[3072] = uv; } }
                            else if (t != INV) { float* o = usamp + (size_t)(-1 - t) * 6144 + col; o[0] = ug; o[3072] = uv; }
                            const float cg_ = bg + wg0 * p2g + wg1 * p1g + wg2 * ug, cv_ = bv + wv0 * p2v + wv1 * p1v + wv2 * uv;
                            const float r_ = gelu_tanh(cg_) * cv_;
                            if (j & 1) pk[m][j >> 1] = cvt_pk_bf16(keep[m], r_); else keep[m] = r_;
                        }
                    }
#pragma unroll
                    for (int m = 0; m < 4; ++m) { if (tk[m] >= 0) { u32x2 w; w.x = pk[m][0]; w.y = pk[m][1]; *(u32x2*)(a + (size_t)((gr0 + 16 * m + fr) & rmask) * DFF + ch0 + 4 * n) = w; } }
                }
            }
        }
    }
};
}

#define XB_TMO      128
#define XB_XCNT(j)  (256  + 64 * (j))
#define XB_XSUB(j)  (1280 + 64 * (j))
#define XB_XGEN(j)  (2304 + 64 * (j))
#define XB_TOP      3328
#define XB_TOPGEN   3392
#define XCD_BAR_WORDS 3456
#define XB_SPIN_CAP (1u << 18)
__device__ __forceinline__ unsigned xb_ld(unsigned* p)              { return __hip_atomic_load(p, __ATOMIC_RELAXED, __HIP_MEMORY_SCOPE_AGENT); }
__device__ __forceinline__ unsigned xb_add(unsigned* p, unsigned v) { return __hip_atomic_fetch_add(p, v, __ATOMIC_RELAXED, __HIP_MEMORY_SCOPE_AGENT); }
__device__ __forceinline__ unsigned xb_xcc_id() { return (unsigned)__builtin_amdgcn_s_getreg((3 << 11) | 20) & 0xFu; }
#define XB_SPIN(cond, bar) do { unsigned _sp = 0; while (cond) { __builtin_amdgcn_s_sleep(1); \
    if ((++_sp & 255u) == 0u) { if (xb_ld(&(bar)[XB_TMO])) break; if (_sp > XB_SPIN_CAP) { atomicAdd(&(bar)[XB_TMO], 1u); break; } } } } while (0)
struct XcdBarrier { unsigned* bar; unsigned x; volatile LAS unsigned* st; };
__device__ __forceinline__ XcdBarrier xcd_barrier_post(unsigned* bar, volatile LAS unsigned* st, const int tid) {
    XcdBarrier b; b.bar = bar; b.x = xb_xcc_id(); b.st = st;
    if (tid == 0) (void)xb_add(&bar[XB_XCNT(b.x)], 1u);
    return b;
}
__device__ __forceinline__ void xcd_barrier_complete(unsigned* bar, unsigned x, unsigned& nloc, unsigned& nx) {
    const unsigned G = gridDim.x * gridDim.y * gridDim.z;
    unsigned sum, cnt, mine, sp = 0u;
    for (;;) {
        sum = 0u; cnt = 0u; mine = 0u;
#pragma unroll
        for (unsigned j = 0; j < 16; ++j) { const unsigned c = xb_ld(&bar[XB_XCNT(j)]); sum += c; cnt += (c > 0u) ? 1u : 0u; mine = (j == x) ? c : mine; }
        if (sum == G) break;
        __builtin_amdgcn_s_sleep(1);
        if ((++sp & 255u) == 0u) { if (xb_ld(&bar[XB_TMO])) break; if (sp > XB_SPIN_CAP) { atomicAdd(&bar[XB_TMO], 1u); break; } }
    }
    nloc = mine > 0u ? mine : 1u; nx = cnt > 0u ? cnt : 1u;
}
__device__ __forceinline__ void xcd_barrier(const XcdBarrier& b, const int tid) {
    asm volatile("s_waitcnt vmcnt(0)" ::: "memory");
    __syncthreads();
    if (tid == 0) {
        unsigned* bar = b.bar;
        __builtin_amdgcn_s_waitcnt(0);
        unsigned nloc = b.st[0], nx = b.st[1];
        if (nloc == 0u) { xcd_barrier_complete(bar, b.x, nloc, nx); b.st[0] = nloc; b.st[1] = nx; }
        const unsigned old = xb_add(&bar[XB_XSUB(b.x)], 1u);
        const unsigned gen = old / nloc;
        if (old + 1u == (gen + 1u) * nloc) {
            __builtin_amdgcn_fence(__ATOMIC_RELEASE, "agent");
            asm volatile("s_waitcnt vmcnt(0)" ::: "memory");
            const unsigned og = xb_add(&bar[XB_TOP], 1u);
            const unsigned tg = og / nx;
            if (og + 1u == (tg + 1u) * nx) xb_add(&bar[XB_TOPGEN], 1u);
            else XB_SPIN(xb_ld(&bar[XB_TOPGEN]) == tg, bar);
            __builtin_amdgcn_fence(__ATOMIC_ACQUIRE, "agent");
            xb_add(&bar[XB_XGEN(b.x)], 1u);
            asm volatile("s_waitcnt vmcnt(0)" ::: "memory");
        } else {
            XB_SPIN(xb_ld(&bar[XB_XGEN(b.x)]) == gen, bar);
            __builtin_amdgcn_fence(__ATOMIC_ACQUIRE, "agent");
            asm volatile("s_waitcnt vmcnt(0)" ::: "memory");
        }
    }
    __syncthreads();
}

__device__ __forceinline__ int my_lane_volatile() { int x; asm volatile("v_mbcnt_lo_u32_b32 %0, -1, 0\n\tv_mbcnt_hi_u32_b32 %0, -1, %0" : "=v"(x)); return x; }
struct Params { const float* in[31]; float* out; unsigned char* ws; };
enum { I_XP = 0, I_XS, I_SLC, I_SLH, I_SSC, I_SSS, I_SFC, I_META, I_NMIX, I_WIN, I_LCW, I_LCB, I_WA, I_BA, I_WX, I_BX, I_APAR, I_LON, I_SCW, I_SCB, I_DTB, I_ALOG, I_SSD_D, I_SON, I_WOUT, I_NFFN, I_WUP, I_FCW, I_FCB, I_WDOWN, I_NFIN };

constexpr int LDS_MISC = 131072, LDS_BYTES = 147456;


__device__ __forceinline__ void p0_transpose_item(const float* W, int ldw, int nvalid, const float* gain, bf16_t* WT, int ldt, int k0, int n0, int drow0, LAS float* scr, int lane) {
    const int nn = n0 + (lane & 31);
    float vv[32];
#pragma unroll
    for (int i = 0; i < 32; ++i) { const int kk = 2 * i + (lane >> 5); vv[i] = nn < nvalid ? W[(size_t)(k0 + kk) * ldw + nn] : 0.f; }
#pragma unroll
    for (int i = 0; i < 32; ++i) { const int kk = 2 * i + (lane >> 5); float v = vv[i]; if (gain) v *= gain[k0 + kk]; scr[kk * 33 + (lane & 31)] = v; }
    LDS_WAIT(); asm volatile("" ::: "memory");
    const int c = lane & 7;
#pragma unroll
    for (int j = 0; j < 4; ++j) { const int n = (lane >> 3) + 8 * j; const LAS float* s = scr + (8 * c) * 33 + n;
        u32x4 o; o.x = pk2(s[0 * 33], s[1 * 33]); o.y = pk2(s[2 * 33], s[3 * 33]); o.z = pk2(s[4 * 33], s[5 * 33]); o.w = pk2(s[6 * 33], s[7 * 33]);
        *(u32x4*)(WT + (size_t)(drow0 + n) * ldt + k0 + 8 * c) = o; }
    LDS_WAIT(); asm volatile("" ::: "memory");
}
__device__ __forceinline__ void p0_prologue(const Params& P, LAS unsigned char* lds, int wave, int lane, const int tid) {
    LAS float* scr = (LAS float*)(lds + wave * 16384);
    const int gw = blockIdx.x * 8 + wave, NGW = gridDim.x * 8;
    unsigned char* ws = P.ws;
    constexpr int I_IN = 16 * 88, I_OUT = 16 * 32, I_UP = 16 * 192, I_DN = 48 * 32, I_L = I_IN + I_OUT + I_UP + I_DN, I_LRU = DEPTH * 8 * 2 * 2;
    for (int it = gw; it < DEPTH * I_L + I_LRU; it += NGW) {
        if (it < DEPTH * I_L) {
            const int l = it / I_L; int r = it % I_L; unsigned char* wl = ws + WS_W + (size_t)l * W_LAYER;
            if (r < I_IN) { const int kb = r / 88, nb = r % 88; p0_transpose_item(P.in[I_WIN] + (size_t)l * D * PIN, PIN, PIN, P.in[I_NMIX] + l * D, (bf16_t*)(wl + W_IN), D, 64 * kb, 32 * nb, 32 * nb, scr, lane); continue; } r -= I_IN;
            if (r < I_OUT) { const int kb = r / 32, nb = r % 32; p0_transpose_item(P.in[I_WOUT] + (size_t)l * D * D, D, D, nullptr, (bf16_t*)(wl + W_OUT), D, 64 * kb, 32 * nb, 32 * nb, scr, lane); continue; } r -= I_OUT;
            if (r < I_UP) { const int kb = r / 192, nb = r % 192, n0 = 32 * nb; const int drow = n0 < DFF ? (n0 / 128) * 256 + (n0 % 128) : ((n0 - DFF) / 128) * 256 + 128 + ((n0 - DFF) % 128);
                p0_transpose_item(P.in[I_WUP] + (size_t)l * D * 2 * DFF, 2 * DFF, 2 * DFF, P.in[I_NFFN] + l * D, (bf16_t*)(wl + W_UP), D, 64 * kb, n0, drow, scr, lane); continue; } r -= I_UP;
            { const int kb = r / 32, nb = r % 32; p0_transpose_item(P.in[I_WDOWN] + (size_t)l * DFF * D, D, D, nullptr, (bf16_t*)(wl + W_DOWN), DFF, 64 * kb, 32 * nb, 32 * nb, scr, lane); }
        } else {
            const int r = it - DEPTH * I_L, lh = r >> 2, which = (r >> 1) & 1, nb = r & 1;
            p0_transpose_item(P.in[which ? I_WX : I_WA] + (size_t)lh * 4096, 64, 64, nullptr, (bf16_t*)(ws + WS_LRUW) + (size_t)which * DEPTH * 8 * 4096 + (size_t)lh * 4096, 64, 0, 32 * nb, 32 * nb, scr, lane);
        }
    }
    bf16_t* xb = (bf16_t*)(ws + WS_XB); float* ss = (float*)(ws + WS_SS);
    for (int m = gw; m < MPAD; m += NGW) {
        const float* src = nullptr;
        if (m < MP) { const int b = m / LP, t = m % LP; src = t < NMETA ? P.in[I_META] + (size_t)t * D : P.in[I_XP] + ((size_t)b * SEQ + (t - NMETA)) * D; }
        else if (m < MT) src = P.in[I_XS] + (size_t)(m - MP) * D;
        f32x4 v[4]; float s = 0.f;
#pragma unroll
        for (int j = 0; j < 4; ++j) { v[j] = src ? *((const f32x4*)src + lane + 64 * j) : (f32x4){0.f, 0.f, 0.f, 0.f}; s += (v[j][0] * v[j][0] + v[j][1] * v[j][1]) + (v[j][2] * v[j][2] + v[j][3] * v[j][3]); }
        s = wave_sum(s, lane);
#pragma unroll
        for (int j = 0; j < 4; ++j) {
            u32x2 w; w.x = pk2(v[j][0], v[j][1]); w.y = pk2(v[j][2], v[j][3]); *((u32x2*)(xb + (size_t)m * D) + lane + 64 * j) = w; }
        if (lane < 4) ss[(size_t)m * 4 + lane] = lane == 0 ? s : 0.f;
    }
    if (blockIdx.x == 0) for (int i = tid; i < 4 * D / 2; i += 512) ((unsigned*)(ws + WS_XB - 8192))[i] = 0u;
}

constexpr int M1_BG = 0, M1_CG = 17408, M1_BGT = 34816, M1_XT = 53248, M1_XST = 71680, M1_WIM = 90112, M1_SDT = 108544, M1_SCS = 109568;
constexpr int M3_XC = 0, XC_RS = 1040, M3_CG = 66560, M3_SSQS = 101376, M3_SSQL = 103424;

struct LayerPtrs {
    const float *lcw, *lcb, *ba, *bx, *apar, *lon, *scw, *scb, *dtb, *alog, *sdd, *son;
    const bf16_t *waT, *wxT;
};
__device__ __forceinline__ LayerPtrs layer_ptrs(const Params& P, int l) {
    LayerPtrs L;
    L.lcw = P.in[I_LCW] + (size_t)l * 4 * 512; L.lcb = P.in[I_LCB] + l * 512; L.ba = P.in[I_BA] + l * 512; L.bx = P.in[I_BX] + l * 512; L.apar = P.in[I_APAR] + l * 512; L.lon = P.in[I_LON] + l * 512;
    L.scw = P.in[I_SCW] + (size_t)l * 4 * 1024; L.scb = P.in[I_SCB] + l * 1024; L.dtb = P.in[I_DTB] + l * 8; L.alog = P.in[I_ALOG] + l * 8; L.sdd = P.in[I_SSD_D] + l * 8; L.son = P.in[I_SON] + l * 512;
    L.waT = (const bf16_t*)(P.ws + WS_LRUW) + (size_t)l * 8 * 4096; L.wxT = L.waT + (size_t)DEPTH * 8 * 4096;
    return L;
}

template <int CNT>
__device__ __forceinline__ void conv4_run(const bf16_t* src, size_t rowb, int tok0, float w0, float w1, float w2, float w3, float bias, bool do_silu, float (&out)[CNT]) {
    float x3 = tok0 - 3 >= 0 ? bf2f(src[(rowb + tok0 - 3) * PROJ_LD]) : 0.f, x2 = tok0 - 2 >= 0 ? bf2f(src[(rowb + tok0 - 2) * PROJ_LD]) : 0.f, x1 = tok0 - 1 >= 0 ? bf2f(src[(rowb + tok0 - 1) * PROJ_LD]) : 0.f;
#pragma unroll
    for (int i = 0; i < CNT; ++i) { const float x0 = bf2f(src[(rowb + tok0 + i) * PROJ_LD]); const float v = bias + w0 * x3 + w1 * x2 + w2 * x1 + w3 * x0; out[i] = do_silu ? siluf_(v) : v; x3 = x2; x2 = x1; x1 = x0; }
}

template <int CNT>
__device__ __forceinline__ void conv4_load(const bf16_t* src, size_t rowb, int tok0, float (&raw)[CNT + 3]) {
#pragma unroll
    for (int i = 0; i < 3; ++i) raw[i] = (tok0 - 3 + i >= 0) ? bf2f(src[(rowb + tok0 - 3 + i) * PROJ_LD]) : 0.f;
#pragma unroll
    for (int i = 3; i < CNT + 3; ++i) raw[i] = bf2f(src[(rowb + tok0 - 3 + i) * PROJ_LD]);
}
template <int CNT>
__device__ __forceinline__ void conv4_silu(const float (&raw)[CNT + 3], float w0, float w1, float w2, float w3, float bias, float (&out)[CNT]) {
#pragma unroll
    for (int i = 0; i < CNT; ++i) out[i] = siluf_(bias + w0 * raw[i] + w1 * raw[i + 1] + w2 * raw[i + 2] + w3 * raw[i + 3]);
}
__device__ __forceinline__ void m1_ssd_unit(const Params& P, const LayerPtrs& L, int l, int b, int c, int g, LAS unsigned char* lds, int wave, int lane_in) {
    int lane = lane_in; asm volatile("" : "+v"(lane));
    const int tid = wave * 64 + lane, fr = lane & 15, fq = lane >> 4;
    unsigned char* ws = P.ws;
    const bf16_t* proj = (const bf16_t*)(ws + WS_PROJ); const float* dtraw = (const float*)(ws + WS_DTRAW);
    float* csbuf = (float*)(ws + WS_CS); float* cdec = (float*)(ws + WS_CDEC); bf16_t* ybuf = (bf16_t*)(ws + WS_YBUF); bf16_t* states = (bf16_t*)(ws + WS_STATES);
    const size_t rowb = (size_t)b * LP; const int t0 = 64 * c;
    LAS float* SDT = (LAS float*)(lds + M1_SDT); LAS float* SCS = (LAS float*)(lds + M1_SCS);
    const int xi2 = tid & 127, q2 = tid >> 7;
    float raw2[2][19];
#pragma unroll
    for (int pr = 0; pr < 2; ++pr) conv4_load<16>(proj + O_XBC + 256 * g + 64 * (2 * pr + (xi2 >> 6)) + (xi2 & 63), rowb, t0 + 16 * q2, raw2[pr]);
    if (wave < 4) {
        const int head = 4 * g + wave, tok = t0 + lane; const bool ok = tok < LP;
        const float raw = ok ? dtraw[(rowb + tok) * 8 + head] : 0.f; const float dt = ok ? softplusf_(raw + L.dtb[head]) : 0.f;
        const float Ah = -__expf(L.alog[head]); float cs = dt * Ah;
#pragma unroll
        for (int o = 1; o < 64; o <<= 1) { const float v = bperm(cs, lane - o); if (lane >= o) cs += v; }
        SDT[wave * 64 + lane] = dt; SCS[wave * 64 + lane] = cs;
        if (ok) csbuf[(rowb + tok) * 8 + head] = cs;
        if (lane == 63) cdec[((size_t)b * NCH + c) * 8 + head] = __expf(cs);
    }
    {
        const int cc = tid & 255, half = tid >> 8, isC = cc >> 7, n = cc & 127, chan = 512 + 256 * isC + 128 * g + n;
        float o[32]; conv4_run<32>(proj + O_XBC + chan, rowb, t0 + 32 * half, L.scw[chan], L.scw[1024 + chan], L.scw[2048 + chan], L.scw[3072 + chan], L.scb[chan], true, o);
        LAS unsigned char* img = lds + (isC ? M1_CG : M1_BG);
#pragma unroll
        for (int i = 0; i < 32; ++i) *(LAS bf16_t*)(img + (32 * half + i) * 272 + n * 2) = (bf16_t)f2bf(o[i]);
        if (!isC) {
#pragma unroll
            for (int i = 0; i < 4; ++i) { u32x4 w; w.x = pk2(o[8 * i], o[8 * i + 1]); w.y = pk2(o[8 * i + 2], o[8 * i + 3]); w.z = pk2(o[8 * i + 4], o[8 * i + 5]); w.w = pk2(o[8 * i + 6], o[8 * i + 7]);
                *(LAS u32x4*)(lds + M1_BGT + n * 144 + (32 * half + 8 * i) * 2) = w; }
        }
        if (c == NCH - 1 && half == 0) {
#pragma unroll
            for (int k = 0; k < 3; ++k) P.out[OFF_PSC + (((size_t)l * NB + b) * 3 + k) * 1024 + chan] = bf2f(proj[(rowb + LP - 3 + k) * PROJ_LD + O_XBC + chan]);
        }
    }
    __syncthreads();
#pragma unroll
    for (int pr = 0; pr < 2; ++pr) {
        {
            const int xi = tid & 127, q = tid >> 7, hl2 = xi >> 6, p = xi & 63, hl = 2 * pr + hl2, chan = 256 * g + 64 * hl + p;
            float o[16]; if (pr == 0) conv4_silu<16>(raw2[0], L.scw[chan], L.scw[1024 + chan], L.scw[2048 + chan], L.scw[3072 + chan], L.scb[chan], o); else conv4_silu<16>(raw2[1], L.scw[chan], L.scw[1024 + chan], L.scw[2048 + chan], L.scw[3072 + chan], L.scb[chan], o);
            const float cl = SCS[hl * 64 + 63];
            float os[16];
#pragma unroll
            for (int i = 0; i < 16; ++i) { const int s = 16 * q + i; os[i] = o[i] * SDT[hl * 64 + s] * __expf(cl - SCS[hl * 64 + s]); }
#pragma unroll
            for (int i = 0; i < 2; ++i) { u32x4 w; w.x = pk2(o[8 * i], o[8 * i + 1]); w.y = pk2(o[8 * i + 2], o[8 * i + 3]); w.z = pk2(o[8 * i + 4], o[8 * i + 5]); w.w = pk2(o[8 * i + 6], o[8 * i + 7]);
                *(LAS u32x4*)(lds + M1_XT + hl2 * 9216 + p * 144 + (16 * q + 8 * i) * 2) = w;
                u32x4 v; v.x = pk2(os[8 * i], os[8 * i + 1]); v.y = pk2(os[8 * i + 2], os[8 * i + 3]); v.z = pk2(os[8 * i + 4], os[8 * i + 5]); v.w = pk2(os[8 * i + 6], os[8 * i + 7]);
                *(LAS u32x4*)(lds + M1_XST + hl2 * 9216 + p * 144 + (16 * q + 8 * i) * 2) = v; }
            if (c == NCH - 1 && q == 0) {
#pragma unroll
                for (int k = 0; k < 3; ++k) P.out[OFF_PSC + (((size_t)l * NB + b) * 3 + k) * 1024 + chan] = bf2f(proj[(rowb + LP - 3 + k) * PROJ_LD + O_XBC + chan]);
            }
        }
        __syncthreads();
        {
            const int hl2 = wave >> 2, tt = wave & 3, hl = 2 * pr + hl2, head = 4 * g + hl;
            LAS unsigned char* Wm = lds + M1_WIM + wave * 2304;
            const LAS unsigned char* XT = lds + M1_XT + hl2 * 9216; const LAS unsigned char* XST = lds + M1_XST + hl2 * 9216;
            const int kb0 = 16 * fq;
            const int tl = 16 * tt + fr; const float cs_t = SCS[hl * 64 + tl];
#pragma unroll
            for (int st = 0; st < 4; ++st) {
                u32x2 wpk; wpk.x = 0u; wpk.y = 0u;
                if (st <= tt) {
                    f32x4 acc = (f32x4){0.f, 0.f, 0.f, 0.f};
#pragma unroll
                    for (int ks = 0; ks < 4; ++ks) acc = mfma16(ldsfrag(lds + M1_BG, 272, 16 * st + fr, 64 * ks + kb0), ldsfrag(lds + M1_CG, 272, tl, 64 * ks + kb0), acc);
                    const f32x4 css = *(const LAS f32x4*)(SCS + hl * 64 + 16 * st + 4 * fq), dts = *(const LAS f32x4*)(SDT + hl * 64 + 16 * st + 4 * fq);
                    float w[4];
#pragma unroll
                    for (int r = 0; r < 4; ++r) { const int s = 16 * st + 4 * fq + r; w[r] = (s <= tl) ? acc[r] * __expf(cs_t - css[r]) * dts[r] : 0.f; }
                    wpk.x = pk2(w[0], w[1]); wpk.y = pk2(w[2], w[3]);
                }
                *(LAS u32x2*)(Wm + fr * 144 + (16 * st + 4 * fq) * 2) = wpk;
            }
            LDS_WAIT();
            const int tok = t0 + tl; const float Dh = L.sdd[head];
#pragma unroll
            for (int pt = 0; pt < 4; ++pt) {
                f32x4 acc = (f32x4){0.f, 0.f, 0.f, 0.f};
#pragma unroll
                for (int ks = 0; ks < 2; ++ks) acc = mfma16(ldsfrag(XT, 144, 16 * pt + fr, 64 * ks + kb0), ldsfrag(Wm, 144, fr, 64 * ks + kb0), acc);
#pragma unroll
                for (int r = 0; r < 4; ++r) acc[r] += Dh * bf2f(*(const LAS bf16_t*)(XT + (16 * pt + 4 * fq + r) * 144 + tl * 2));
                if (tok < LP) { u32x2 w; w.x = pk2(acc[0], acc[1]); w.y = pk2(acc[2], acc[3]); *(u32x2*)(ybuf + (rowb + tok) * 512 + head * 64 + 16 * pt + 4 * fq) = w; }
            }
            bf16_t* sdst = states + (((size_t)b * NCH + c) * 8 + head) * 8192;
#pragma unroll
            for (int n2 = 0; n2 < 2; ++n2) { const int nt = 2 * tt + n2;
#pragma unroll
                for (int pt = 0; pt < 4; ++pt) {
                    f32x4 acc = (f32x4){0.f, 0.f, 0.f, 0.f};
#pragma unroll
                    for (int ks = 0; ks < 2; ++ks) acc = mfma16(ldsfrag(lds + M1_BGT, 144, 16 * nt + fr, 64 * ks + kb0), ldsfrag(XST, 144, 16 * pt + fr, 64 * ks + kb0), acc);
                    { u32x2 w; w.x = pk2(acc[0], acc[1]); w.y = pk2(acc[2], acc[3]); *(u32x2*)(sdst + (16 * pt + fr) * 128 + 16 * nt + 4 * fq) = w; }
                } }
        }
        __syncthreads();
    }
}

__device__ __forceinline__ void m1_sample_ssd_unit(const Params& P, const LayerPtrs& L, int l, int sq, LAS unsigned char* lds, int wave, int lane_in) {
    int lane = lane_in; asm volatile("" : "+v"(lane));
    unsigned char* ws = P.ws;
    const bf16_t* proj = (const bf16_t*)(ws + WS_PROJ); const float* dtraw = (const float*)(ws + WS_DTRAW); bf16_t* ybuf = (bf16_t*)(ws + WS_YBUF);
    const int head = wave, g = head >> 2; const size_t row0 = (size_t)MP + (size_t)sq * 4;
    LAS float* SX = (LAS float*)(lds + wave * 5120); LAS float* SB = SX + 256; LAS float* SC = SX + 768;
    const float* stc = P.in[I_SSC] + ((size_t)l * NS + sq) * 3 * 1024;
#pragma unroll 1
    for (int slot = 0; slot < 5; ++slot) {
        const int chan = slot == 0 ? head * 64 + lane : (slot < 3 ? 512 + g * 128 + lane + 64 * (slot - 1) : 768 + g * 128 + lane + 64 * (slot - 3));
        const float w0 = L.scw[chan], w1 = L.scw[1024 + chan], w2 = L.scw[2048 + chan], w3 = L.scw[3072 + chan], bs = L.scb[chan];
        const float s0 = stc[chan], s1 = stc[1024 + chan], s2 = stc[2048 + chan];
        float xr[4];
#pragma unroll
        for (int t = 0; t < 4; ++t) xr[t] = bf2f(proj[(row0 + t) * PROJ_LD + O_XBC + chan]);
        float y[4];
        y[0] = siluf_(bs + w0 * s0 + w1 * s1 + w2 * s2 + w3 * xr[0]); y[1] = siluf_(bs + w0 * s1 + w1 * s2 + w2 * xr[0] + w3 * xr[1]);
        y[2] = siluf_(bs + w0 * s2 + w1 * xr[0] + w2 * xr[1] + w3 * xr[2]); y[3] = siluf_(bs + w0 * xr[0] + w1 * xr[1] + w2 * xr[2] + w3 * xr[3]);
        LAS float* dst = slot == 0 ? SX + lane : (slot < 3 ? SB + lane + 64 * (slot - 1) : SC + lane + 64 * (slot - 3));
        const int rs = slot == 0 ? 64 : 128;
#pragma unroll
        for (int t = 0; t < 4; ++t) dst[t * rs] = y[t];
        if (slot == 0 || (head & 3) == 0) {
#pragma unroll
            for (int k = 0; k < 3; ++k) P.out[OFF_SSC + (((size_t)l * NS + sq) * 3 + k) * 1024 + chan] = xr[k + 1];
        }
    }
    const float dtb_h = L.dtb[head];
    const float Ah = -__expf(L.alog[head]), Dh = L.sdd[head];
    LDS_WAIT(); asm volatile("" ::: "memory");
    const int p8 = lane >> 3, nq = lane & 7;
    const float* sin_ = P.in[I_SSS] + (((size_t)l * NS + sq) * 8 + head) * 8192;
    float* sout = P.out + OFF_SSS + (((size_t)l * NS + sq) * 8 + head) * 8192;
#pragma unroll 1
    for (int hf = 0; hf < 2; ++hf) {
        f32x4 S[4][4];
#pragma unroll
        for (int pg = 0; pg < 4; ++pg)
#pragma unroll
            for (int k = 0; k < 4; ++k) S[pg][k] = *(const f32x4*)(sin_ + (8 * (4 * hf + pg) + p8) * 128 + 16 * nq + 4 * k);
#pragma unroll 1
        for (int t = 0; t < 4; ++t) {
            const float dtv_t = softplusf_(dtraw[(row0 + t) * 8 + head] + dtb_h);
            const float dec = __expf(dtv_t * Ah);
            f32x4 Bv[4], Cv[4];
#pragma unroll
            for (int k = 0; k < 4; ++k) { Bv[k] = *(const LAS f32x4*)(SB + t * 128 + 16 * nq + 4 * k); Cv[k] = *(const LAS f32x4*)(SC + t * 128 + 16 * nq + 4 * k); }
#pragma unroll
            for (int pg = 0; pg < 4; ++pg) {
                const int p = 8 * (4 * hf + pg) + p8; const float xv = SX[t * 64 + p]; const float xp = xv * dtv_t;
                float ys = 0.f;
#pragma unroll
                for (int k = 0; k < 4; ++k) { S[pg][k] = S[pg][k] * dec + Bv[k] * xp; const f32x4 pc = S[pg][k] * Cv[k]; ys += (pc[0] + pc[1]) + (pc[2] + pc[3]); }
                ys += bperm(ys, lane ^ 1); ys += bperm(ys, lane ^ 2); ys += bperm(ys, lane ^ 4);
                if (nq == 0) ybuf[(row0 + t) * 512 + head * 64 + p] = (bf16_t)f2bf(ys + Dh * xv);
            }
        }
#pragma unroll
        for (int pg = 0; pg < 4; ++pg)
#pragma unroll
            for (int k = 0; k < 4; ++k) *(f32x4*)(sout + (8 * (4 * hf + pg) + p8) * 128 + 16 * nq + 4 * k) = S[pg][k];
    }
    LDS_WAIT(); asm volatile("" ::: "memory");
}

template <bool SAMPLE, bool WRITE_STATE>
__device__ __forceinline__ void lru_build_xc(const Params& P, const LayerPtrs& L, int l, int b, int c, int u, LAS unsigned char* lds, const int ci) {
    const bf16_t* proj = (const bf16_t*)(P.ws + WS_PROJ);
    const float w0 = L.lcw[ci], w1 = L.lcw[512 + ci], w2 = L.lcw[1024 + ci], w3 = L.lcw[1536 + ci], bs = L.lcb[ci];
    if constexpr (!SAMPLE) {
        const size_t rowb = (size_t)b * LP; const int t0 = 64 * c;
#pragma unroll
        for (int h = 0; h < 2; ++h) { float o[32]; conv4_run<32>(proj + O_LX + ci, rowb, t0 + 32 * h, w0, w1, w2, w3, bs, false, o);
#pragma unroll
            for (int i = 0; i < 32; ++i) *(LAS bf16_t*)(lds + M3_XC + (32 * h + i) * XC_RS + ci * 2) = (bf16_t)f2bf(o[i]); }
        if (WRITE_STATE && c == NCH - 1) {
#pragma unroll
            for (int k = 0; k < 3; ++k) P.out[OFF_PLC + (((size_t)l * NB + b) * 3 + k) * 512 + ci] = bf2f(proj[(rowb + LP - 3 + k) * PROJ_LD + O_LX + ci]);
        }
    } else {
#pragma unroll 4
        for (int s = 0; s < 16; ++s) { const int sq = 16 * u + s; const size_t row0 = (size_t)MP + (size_t)sq * 4;
            const float* stc = P.in[I_SLC] + ((size_t)l * NS + sq) * 3 * 512; const float s0 = stc[ci], s1 = stc[512 + ci], s2 = stc[1024 + ci];
            float xr[4];
#pragma unroll
            for (int t = 0; t < 4; ++t) xr[t] = bf2f(proj[(row0 + t) * PROJ_LD + O_LX + ci]);
            float y[4];
            y[0] = bs + w0 * s0 + w1 * s1 + w2 * s2 + w3 * xr[0]; y[1] = bs + w0 * s1 + w1 * s2 + w2 * xr[0] + w3 * xr[1];
            y[2] = bs + w0 * s2 + w1 * xr[0] + w2 * xr[1] + w3 * xr[2]; y[3] = bs + w0 * xr[0] + w1 * xr[1] + w2 * xr[2] + w3 * xr[3];
#pragma unroll
            for (int t = 0; t < 4; ++t) *(LAS bf16_t*)(lds + M3_XC + (4 * s + t) * XC_RS + ci * 2) = (bf16_t)f2bf(y[t]);
            if (WRITE_STATE) {
#pragma unroll
                for (int k = 0; k < 3; ++k) P.out[OFF_SLC + (((size_t)l * NS + sq) * 3 + k) * 512 + ci] = xr[k + 1];
            } }
    }
}

__device__ __forceinline__ void lru_build_xc_wave(const Params& P, const LayerPtrs& L, int l, int b, int c, LAS unsigned char* lds, int wave, int lane) {
    const bf16_t* proj = (const bf16_t*)(P.ws + WS_PROJ);
    const int c8 = lane & 7, g = lane >> 3, ch0 = 64 * wave + 8 * c8;
    const size_t rowb = (size_t)b * LP; const int t0 = 64 * c + 8 * g;
    u32x4 raw[11];
#pragma unroll
    for (int i = 0; i < 11; ++i) { const int tok = t0 - 3 + i; raw[i] = *(const u32x4*)(proj + (rowb + (tok < 0 ? 0 : tok)) * PROJ_LD + O_LX + ch0); }
    f32x4 w[4][2], bs[2];
#pragma unroll
    for (int k = 0; k < 4; ++k) { w[k][0] = *(const f32x4*)(L.lcw + k * 512 + ch0); w[k][1] = *(const f32x4*)(L.lcw + k * 512 + ch0 + 4); }
    bs[0] = *(const f32x4*)(L.lcb + ch0); bs[1] = *(const f32x4*)(L.lcb + ch0 + 4);
    if (t0 < 3) {
#pragma unroll
        for (int i = 0; i < 3; ++i) if (t0 - 3 + i < 0) raw[i] = (u32x4){0u, 0u, 0u, 0u};
    }
#pragma unroll
    for (int r = 0; r < 8; ++r) {
        f32x4 o0 = bs[0], o1 = bs[1];
#pragma unroll
        for (int k = 0; k < 4; ++k) { const u32x4 x = raw[r + k];
            o0 += w[k][0] * (f32x4){bf2f(x[0] & 0xffffu), bf2f(x[0] >> 16), bf2f(x[1] & 0xffffu), bf2f(x[1] >> 16)};
            o1 += w[k][1] * (f32x4){bf2f(x[2] & 0xffffu), bf2f(x[2] >> 16), bf2f(x[3] & 0xffffu), bf2f(x[3] >> 16)}; }
        u32x4 q; q.x = pg8::cvt_pk_bf16(o0[0], o0[1]); q.y = pg8::cvt_pk_bf16(o0[2], o0[3]); q.z = pg8::cvt_pk_bf16(o1[0], o1[1]); q.w = pg8::cvt_pk_bf16(o1[2], o1[3]);
        *(LAS u32x4*)(lds + M3_XC + (8 * g + r) * XC_RS + ch0 * 2) = q;
    }
    if (c == NCH - 1 && g == 1) {
#pragma unroll
        for (int k = 0; k < 3; ++k) { const u32x4 x = raw[8 + k]; float* dst = P.out + OFF_PLC + (((size_t)l * NB + b) * 3 + k) * 512 + ch0;
            *(f32x4*)dst = (f32x4){bf2f(x[0] & 0xffffu), bf2f(x[0] >> 16), bf2f(x[1] & 0xffffu), bf2f(x[1] >> 16)}; *(f32x4*)(dst + 4) = (f32x4){bf2f(x[2] & 0xffffu), bf2f(x[2] >> 16), bf2f(x[3] & 0xffffu), bf2f(x[3] >> 16)}; }
    }
    LDS_WAIT();
}

template <bool SAMPLE>
__device__ __forceinline__ void lru_wave(const Params& P, const LayerPtrs& L, int l, int b, int c, int u, int len, LAS unsigned char* lds, int wave, int lane, bf16_t* hdst) {
    const int fr = lane & 15, fq = lane >> 4, h = wave; unsigned char* ws = P.ws;
    const bf16_t* proj = (const bf16_t*)(ws + WS_PROJ);
    float* lruA = (float*)(ws + WS_LRUA); float* lruH = (float*)(ws + WS_LRUH);
    const size_t rowbase = SAMPLE ? (size_t)MP + 64 * (size_t)u : (size_t)b * LP + 64 * (size_t)c;
    bf16x8 qan[2], qxn[2];
#pragma unroll
    for (int ks = 0; ks < 2; ++ks) { qan[ks] = *(const bf16x8*)(L.waT + ((size_t)(h * 64 + fr) * 64 + 32 * ks + 8 * fq)); qxn[ks] = *(const bf16x8*)(L.wxT + ((size_t)(h * 64 + fr) * 64 + 32 * ks + 8 * fq)); }
    float ban = L.ba[64 * h + fr], bxn = L.bx[64 * h + fr], apn = L.apar[64 * h + fr];
#pragma unroll 1
    for (int jt = 0; jt < 4; ++jt) {
        const int ch = 64 * h + 16 * jt + fr;
        bf16x8 qa[2], qx[2];
#pragma unroll
        for (int ks = 0; ks < 2; ++ks) { qa[ks] = qan[ks]; qx[ks] = qxn[ks]; }
        const float ba_c = ban, bx_c = bxn, ap_c = apn;
        { const int jn = jt < 3 ? jt + 1 : 3; ban = L.ba[64 * h + 16 * jn + fr]; bxn = L.bx[64 * h + 16 * jn + fr]; apn = L.apar[64 * h + 16 * jn + fr];
#pragma unroll
          for (int ks = 0; ks < 2; ++ks) { qan[ks] = *(const bf16x8*)(L.waT + ((size_t)(h * 64 + 16 * jn + fr) * 64 + 32 * ks + 8 * fq)); qxn[ks] = *(const bf16x8*)(L.wxT + ((size_t)(h * 64 + 16 * jn + fr) * 64 + 32 * ks + 8 * fq)); } }
        f32x4 ar[4], ai[4];
#pragma unroll
        for (int tt = 0; tt < 4; ++tt) { ar[tt] = (f32x4){0.f, 0.f, 0.f, 0.f}; ai[tt] = (f32x4){0.f, 0.f, 0.f, 0.f};
#pragma unroll
            for (int ks = 0; ks < 2; ++ks) { const bf16x8 pf = ldsfrag(lds + M3_XC, XC_RS, 16 * tt + fr, (64 * h + 32 * ks + 8 * fq) * 2); ar[tt] = mfma16(pf, qa[ks], ar[tt]); ai[tt] = mfma16(pf, qx[ks], ai[tt]); } }
        constexpr float L2E = 1.4426950408889634f;
        const float bav2 = -L2E * ba_c, bxv2 = -L2E * bx_c, sp = softplusf_(-ap_c), spa = -8.0f * L2E * sp, spy = -16.0f * sp;
        float av[4][4], bv[4][4], A4[4], B4[4];
#pragma unroll
        for (int tt = 0; tt < 4; ++tt) {
#pragma unroll
            for (int r = 0; r < 4; ++r) { const int t = 16 * tt + 4 * fq + r;
                const float rg = __builtin_amdgcn_rcpf(1.0f + __builtin_amdgcn_exp2f(__builtin_fmaf(ar[tt][r], -L2E, bav2))), ig = __builtin_amdgcn_rcpf(1.0f + __builtin_amdgcn_exp2f(__builtin_fmaf(ai[tt][r], -L2E, bxv2)));
                const float a_ = __builtin_amdgcn_exp2f(rg * spa), y = rg * spy;
                const float p = -y * (1.0f + y * (0.5f + y * (0.16666667f + y * (0.041666668f + y * 0.0083333338f)))), q = __builtin_fmaf(-a_, a_, 1.0f);
                const float mult = __builtin_amdgcn_sqrtf(y > -0.125f ? p : q); const float xc = bf2f(*(const LAS bf16_t*)(lds + M3_XC + t * XC_RS + ch * 2));
                av[tt][r] = t >= len ? 1.f : a_; bv[tt][r] = t >= len ? 0.f : mult * ig * xc; }
            float A = av[tt][0], B = bv[tt][0];
#pragma unroll
            for (int r = 1; r < 4; ++r) { B = av[tt][r] * B + bv[tt][r]; A *= av[tt][r]; }
            A4[tt] = A; B4[tt] = B; }
        if constexpr (!SAMPLE) {
            float cin[4], pin[4];
            float stv = 0.f, prd = 1.f;
#pragma unroll
            for (int tt = 0; tt < 4; ++tt)
#pragma unroll
                for (int q = 0; q < 4; ++q) { const float Aq = bperm(A4[tt], fr + 16 * q), Bq = bperm(B4[tt], fr + 16 * q); if (q == fq) { cin[tt] = stv; pin[tt] = prd; } stv = Aq * stv + Bq; prd *= Aq; }
            if (fq == 0) { lruA[((size_t)b * NCH + c) * 512 + ch] = prd; lruH[((size_t)b * NCH + c) * 512 + ch] = stv; }
            LAS unsigned char* stg = lds + M3_CG + wave * 4096;
#pragma unroll
            for (int tt = 0; tt < 4; ++tt) { float s = cin[tt], pa = pin[tt];
#pragma unroll
                for (int r = 0; r < 4; ++r) { s = av[tt][r] * s + bv[tt][r]; pa *= av[tt][r]; *(LAS unsigned*)(stg + (((4 * tt + r) * 4 + fq) << 6) + fr * 4) = pg8::cvt_pk_bf16(s, pa); } }
            LDS_WAIT();
            unsigned* pdst = (unsigned*)(ws + WS_HLAC) + rowbase * 512 + 64 * h + 16 * jt + 4 * (lane & 3);
#pragma unroll
            for (int j = 0; j < 4; ++j) { const int slot = 16 * j + (lane >> 2), t = 16 * (slot >> 4) + 4 * (slot & 3) + ((slot >> 2) & 3);
                const u32x4 w = *(const LAS u32x4*)(stg + (slot << 6) + (lane & 3) * 16);
                if (t < len) *(u32x4*)(pdst + (size_t)t * 512) = w; }
            LDS_WAIT();
        } else {
#pragma unroll
            for (int tt = 0; tt < 4; ++tt) { float s = P.in[I_SLH][((size_t)l * NS + 16 * u + 4 * tt + fq) * 512 + ch];
#pragma unroll
                for (int r = 0; r < 4; ++r) { const int t = 16 * tt + 4 * fq + r; s = av[tt][r] * s + bv[tt][r]; hdst[(size_t)t * D + ch] = (bf16_t)f2bf(s); }
                P.out[OFF_SLH + ((size_t)l * NS + 16 * u + 4 * tt + fq) * 512 + ch] = s; }
        }
    }
}

__device__ __forceinline__ void m1_lru_unit(const Params& P, const LayerPtrs& L, int l, int b, int c, LAS unsigned char* lds, int wave, int lane_in) {
    int lane = lane_in; asm volatile("" : "+v"(lane));
    lru_build_xc_wave(P, L, l, b, c, lds, wave, lane);
    const int len = (LP - 64 * c) < 64 ? (LP - 64 * c) : 64;
    lru_wave<false>(P, L, l, b, c, 0, len, lds, wave, lane, nullptr);
    __syncthreads();
}

template <bool FROM_LDS, bool GELU, bool CARRY>
__device__ __forceinline__ void m3_finish(const LAS unsigned char* gl, const bf16_t* gate_rows  , const float* gain, bf16_t* mixed_rows, int len, int wave, int lane,
                                          const u32x4* gpre = nullptr  , const unsigned* pair_rows = nullptr  , const float* hin = nullptr) {
    if constexpr (!CARRY) { VM_WAIT(); LDS_WAIT(); __syncthreads(); }
    const int c8 = lane * 8;
    const f32x4 g0 = *(const f32x4*)(gain + c8), g1 = *(const f32x4*)(gain + c8 + 4);
    f32x4 h0 = (f32x4){0.f, 0.f, 0.f, 0.f}, h1 = h0;
    if constexpr (CARRY) { h0 = *(const f32x4*)(hin + c8); h1 = *(const f32x4*)(hin + c8 + 4); }
    u32x4 sv[8], gv[8], cv[8];
#pragma unroll
    for (int i = 0; i < 8; ++i) { const int row = wave * 8 + i;
        if constexpr (CARRY) { sv[i] = *(const u32x4*)(pair_rows + (size_t)row * 512 + c8); cv[i] = *(const u32x4*)(pair_rows + (size_t)row * 512 + c8 + 4); }
        else if (FROM_LDS) sv[i] = *(const LAS u32x4*)(gl + row * 1024 + ((lane ^ (row & 15)) << 4)); else sv[i] = *(const u32x4*)(mixed_rows + (size_t)row * D + c8);
        gv[i] = gpre ? gpre[i] : *(const u32x4*)(gate_rows + (size_t)row * PROJ_LD + c8); }
#pragma unroll
    for (int i = 0; i < 8; ++i) { const int row = wave * 8 + i;
        float v[8];
        if constexpr (CARRY) {
#pragma unroll
            for (int j = 0; j < 4; ++j) { v[j] = bf2f(sv[i][j] & 0xffffu) + bf2f(sv[i][j] >> 16) * h0[j]; v[4 + j] = bf2f(cv[i][j] & 0xffffu) + bf2f(cv[i][j] >> 16) * h1[j]; }
        } else {
#pragma unroll
            for (int k = 0; k < 4; ++k) { v[2 * k] = bf2f(sv[i][k] & 0xffffu); v[2 * k + 1] = bf2f(sv[i][k] >> 16); }
        }
        float sq = 0.f;
#pragma unroll
        for (int k = 0; k < 4; ++k) { const float z0 = bf2f(gv[i][k] & 0xffffu), z1 = bf2f(gv[i][k] >> 16);
            v[2 * k] *= (GELU ? gelu_tanh(z0) : siluf_(z0)); v[2 * k + 1] *= (GELU ? gelu_tanh(z1) : siluf_(z1)); sq += v[2 * k] * v[2 * k] + v[2 * k + 1] * v[2 * k + 1]; }
        const float rs = __builtin_amdgcn_rsqf(wave_sum(sq, lane) * (1.0f / 512.0f) + EPS);
        if (row < len) { u32x4 w; w.x = pk2(v[0] * rs * g0[0], v[1] * rs * g0[1]); w.y = pk2(v[2] * rs * g0[2], v[3] * rs * g0[3]); w.z = pk2(v[4] * rs * g1[0], v[5] * rs * g1[1]); w.w = pk2(v[6] * rs * g1[2], v[7] * rs * g1[3]);
            *(u32x4*)(mixed_rows + (size_t)row * D + c8) = w; }
    }
    if constexpr (!CARRY) __syncthreads();
}
__device__ __forceinline__ void lru_sample_unit(const Params& P, const LayerPtrs& L, int l, int u, LAS unsigned char* lds, int wave, int lane_in) {
    int lane = lane_in; asm volatile("" : "+v"(lane));
    const int tid = wave * 64 + lane; unsigned char* ws = P.ws;
    bf16_t* mixed = (bf16_t*)(ws + WS_MIXED); const bf16_t* proj = (const bf16_t*)(ws + WS_PROJ);
    const size_t rowbase = (size_t)MP + 64 * (size_t)u;
    lru_build_xc<true, true>(P, L, l, 0, 0, u, lds, tid);
    __syncthreads();
    lru_wave<true>(P, L, l, 0, 0, u, 64, lds, wave, lane, mixed + rowbase * D);
    m3_finish<false, true, false>(nullptr, proj + rowbase * PROJ_LD + O_LG, L.lon, mixed + rowbase * D, 64, wave, lane);
}
__device__ __forceinline__ void m3_lru_light(const Params& P, const LayerPtrs& L, int b, int c, int wave, int lane_in) {
    int lane = lane_in; asm volatile("" : "+v"(lane));
    unsigned char* ws = P.ws;
    const size_t rowbase = (size_t)b * LP + 64 * (size_t)c;
    const int len = (LP - 64 * c) < 64 ? (LP - 64 * c) : 64;
    m3_finish<false, true, true>(nullptr, (const bf16_t*)(ws + WS_PROJ) + rowbase * PROJ_LD + O_LG, L.lon, (bf16_t*)(ws + WS_MIXED) + rowbase * D, len, wave, lane, nullptr,
                                 (const unsigned*)(ws + WS_HLAC) + rowbase * 512, (const float*)(ws + WS_LRUHIN) + ((size_t)b * NCH + c) * 512);
}
template <bool SAMPLE>
__device__ __forceinline__ void m3_ssd_unit(const Params& P, const LayerPtrs& L, int l, int b, int c, int u, LAS unsigned char* lds, int wave, int lane_in) {
    int lane = lane_in; asm volatile("" : "+v"(lane));
    const int tid = wave * 64 + lane, fr = lane & 15, fq = lane >> 4, h = wave; unsigned char* ws = P.ws;
    const bf16_t* proj = (const bf16_t*)(ws + WS_PROJ); const float* csbuf = (const float*)(ws + WS_CS); const bf16_t* ybuf = (const bf16_t*)(ws + WS_YBUF);
    bf16_t* mixed = (bf16_t*)(ws + WS_MIXED);
    const size_t rowbase = SAMPLE ? (size_t)MP + 64 * (size_t)u : (size_t)b * LP + 64 * (size_t)c;
    const int len = SAMPLE ? 64 : ((LP - 64 * c) < 64 ? (LP - 64 * c) : 64);
    u32x2 yy[4][4]; float ev[4];
#pragma unroll
    for (int tt = 0; tt < 4; ++tt) { const size_t row = rowbase + 16 * tt + fr; ev[tt] = SAMPLE ? 0.f : csbuf[row * 8 + h];
#pragma unroll
        for (int pt = 0; pt < 4; ++pt) yy[tt][pt] = *(const u32x2*)(ybuf + row * 512 + h * 64 + 16 * pt + 4 * fq); }
    bf16x8 pfr[4][4];
    if constexpr (!SAMPLE) {
        const bf16_t* hp = (const bf16_t*)(ws + WS_SINB) + (((size_t)b * NCH + c) * 8 + h) * 8192;
#pragma unroll
        for (int pt = 0; pt < 4; ++pt)
#pragma unroll
            for (int ks = 0; ks < 4; ++ks) pfr[pt][ks] = *(const bf16x8*)(hp + (16 * pt + fr) * 128 + 32 * ks + 8 * fq);
    }
    u32x4 zpre[8];
#pragma unroll
    for (int i = 0; i < 8; ++i) zpre[i] = *(const u32x4*)(proj + (rowbase + wave * 8 + i) * PROJ_LD + O_Z + lane * 8);
    if constexpr (!SAMPLE) {
        const int cg = tid & 31, rg = tid >> 5, chan0 = 768 + 8 * cg; const size_t rowb = (size_t)b * LP; const int t0 = 64 * c + 4 * rg;
        u32x4 raw[7];
#pragma unroll
        for (int i = 0; i < 7; ++i) { const int tok = t0 - 3 + i; raw[i] = *(const u32x4*)(proj + (rowb + (tok < 0 ? 0 : tok)) * PROJ_LD + O_XBC + chan0); }
        f32x4 w[4][2], bs[2];
#pragma unroll
        for (int k = 0; k < 4; ++k) { w[k][0] = *(const f32x4*)(L.scw + k * 1024 + chan0); w[k][1] = *(const f32x4*)(L.scw + k * 1024 + chan0 + 4); }
        bs[0] = *(const f32x4*)(L.scb + chan0); bs[1] = *(const f32x4*)(L.scb + chan0 + 4);
        if (t0 < 3) {
#pragma unroll
            for (int i = 0; i < 3; ++i) if (t0 - 3 + i < 0) raw[i] = (u32x4){0u, 0u, 0u, 0u};
        }
#pragma unroll
        for (int r = 0; r < 4; ++r) {
            f32x4 o0 = bs[0], o1 = bs[1];
#pragma unroll
            for (int k = 0; k < 4; ++k) { const u32x4 x = raw[r + k];
                o0 += w[k][0] * (f32x4){bf2f(x[0] & 0xffffu), bf2f(x[0] >> 16), bf2f(x[1] & 0xffffu), bf2f(x[1] >> 16)};
                o1 += w[k][1] * (f32x4){bf2f(x[2] & 0xffffu), bf2f(x[2] >> 16), bf2f(x[3] & 0xffffu), bf2f(x[3] >> 16)}; }
            u32x4 q; q.x = pg8::cvt_pk_bf16(siluf_(o0[0]), siluf_(o0[1])); q.y = pg8::cvt_pk_bf16(siluf_(o0[2]), siluf_(o0[3])); q.z = pg8::cvt_pk_bf16(siluf_(o1[0]), siluf_(o1[1])); q.w = pg8::cvt_pk_bf16(siluf_(o1[2]), siluf_(o1[3]));
            *(LAS u32x4*)(lds + M3_CG + (cg >> 4) * 17408 + (4 * rg + r) * 272 + (cg & 15) * 16) = q;
        }
        __syncthreads();
    }
    LAS unsigned char* GL = lds + M3_XC;
    {
        const LAS unsigned char* CG = lds + M3_CG + (h >> 2) * 17408;
#pragma unroll
        for (int tt = 0; tt < 4; ++tt) {
            f32x4 acc[4];
#pragma unroll
            for (int pt = 0; pt < 4; ++pt) acc[pt] = (f32x4){0.f, 0.f, 0.f, 0.f};
            if constexpr (!SAMPLE) {
#pragma unroll
                for (int ks = 0; ks < 4; ++ks) { const bf16x8 cf = ldsfrag(CG, 272, 16 * tt + fr, 64 * ks + 16 * fq);
#pragma unroll
                    for (int pt = 0; pt < 4; ++pt) acc[pt] = mfma16(pfr[pt][ks], cf, acc[pt]); }
            }
            const int t = 16 * tt + fr; const float e = SAMPLE ? 0.f : __expf(ev[tt]);
#pragma unroll
            for (int pt = 0; pt < 4; ++pt) {
                const f32x4 y = (f32x4){bf2f(yy[tt][pt].x & 0xffffu), bf2f(yy[tt][pt].x >> 16), bf2f(yy[tt][pt].y & 0xffffu), bf2f(yy[tt][pt].y >> 16)} + acc[pt] * e;
                u32x2 w; w.x = pk2(y[0], y[1]); w.y = pk2(y[2], y[3]); const int c16 = (h * 8 + 2 * pt + (fq >> 1)) ^ (t & 15); *(LAS u32x2*)(GL + t * 1024 + c16 * 16 + (fq & 1) * 8) = w;
            }
        }
    }
    m3_finish<true, false, false>(GL, proj + rowbase * PROJ_LD + O_Z, L.son, mixed + rowbase * D + 512, len, wave, lane, zpre);
}

__device__ __forceinline__ void m2_phase(const Params& P, int l, const int tid, const int dry) {
    unsigned char* ws = P.ws; const bf16_t* states = (const bf16_t*)(ws + WS_STATES); const float* cdec = (const float*)(ws + WS_CDEC);
    for (int e4 = blockIdx.x * 512 + tid; e4 < NB * 8 * 2048; e4 += gridDim.x * 512) {
        const int bh = e4 >> 11, off = (e4 & 2047) * 4, b = bh >> 3, h = bh & 7;
        f32x4 run = (f32x4){0.f, 0.f, 0.f, 0.f};
        const size_t e0 = (((size_t)b * NCH) * 8 + h) * 8192 + off; constexpr size_t CST = (size_t)8 * 8192;
        u32x2 sc[NCH]; float dc[NCH];
        {
            constexpr int c0 = 0;
#pragma unroll
            for (int k = 0; k < NCH; ++k) { sc[k] = *(const u32x2*)(states + e0 + (size_t)(c0 + k) * CST); dc[k] = cdec[((size_t)b * NCH + c0 + k) * 8 + h]; }
#pragma unroll
            for (int k = 0; k < NCH; ++k) { u32x2 w; w.x = pk2(run[0], run[1]); w.y = pk2(run[2], run[3]); *(u32x2*)((bf16_t*)(ws + WS_SINB) + e0 + (size_t)(c0 + k) * CST) = w; run = run * dc[k] + (f32x4){bf2f(sc[k].x & 0xffffu), bf2f(sc[k].x >> 16), bf2f(sc[k].y & 0xffffu), bf2f(sc[k].y >> 16)}; }
        }
        if (!dry || run[0] == 12345.678f) *(f32x4*)(P.out + OFF_PSS + (((size_t)l * NB + b) * 8 + h) * 8192 + off) = run;
    }
    if (dry) return;
    const float* lruA = (const float*)(ws + WS_LRUA); const float* lruH = (const float*)(ws + WS_LRUH); float* lruHin = (float*)(ws + WS_LRUHIN);
    if (tid < 16) for (int i = blockIdx.x * 16 + tid; i < NB * 512; i += gridDim.x * 16) {
        const int b = i >> 9, ch = i & 511; float av[NCH], bv[NCH];
#pragma unroll
        for (int c = 0; c < NCH; ++c) { const size_t o = ((size_t)b * NCH + c) * 512 + ch; av[c] = lruA[o]; bv[c] = lruH[o]; }
        float hv = 0.f;
#pragma unroll
        for (int c = 0; c < NCH; ++c) { lruHin[((size_t)b * NCH + c) * 512 + ch] = hv; hv = av[c] * hv + bv[c]; }
        P.out[OFF_PLH + ((size_t)l * NB + b) * 512 + ch] = hv;
    }
}


__device__ __forceinline__ void ffn_sample_phase(const Params& P, int l, const int tid) {
    unsigned char* ws = P.ws; const float* us = (const float*)(ws + WS_USAMP); bf16_t* abuf = (bf16_t*)(ws + WS_ABUF);
    const float* cw = P.in[I_FCW] + (size_t)l * 3 * 6144; const float* cb = P.in[I_FCB] + (size_t)l * 6144; const float* st = P.in[I_SFC] + (size_t)l * NS * 2 * 6144;
    float* sf = P.out + OFF_SFC + (size_t)l * NS * 2 * 6144;
    for (int i = blockIdx.x * 512 + tid; i < NS * 768; i += gridDim.x * 512) {
        const int sq = i / 768, c = (i % 768) * 4;
        f32x4 res[4];
#pragma unroll
        for (int half = 0; half < 2; ++half) {
            const int col = c + 3072 * half;
            const f32x4 w0 = *(const f32x4*)(cw + col), w1 = *(const f32x4*)(cw + 6144 + col), w2 = *(const f32x4*)(cw + 2 * 6144 + col), bb = *(const f32x4*)(cb + col);
            f32x4 p2 = *(const f32x4*)(st + ((size_t)sq * 2) * 6144 + col), p1 = *(const f32x4*)(st + ((size_t)sq * 2 + 1) * 6144 + col);
#pragma unroll
            for (int t = 0; t < 4; ++t) {
                const f32x4 uu = *(const f32x4*)(us + ((size_t)sq * 4 + t) * 6144 + col);
                f32x4 cv = bb + w0 * p2 + w1 * p1 + w2 * uu;
                if (half == 0) { cv[0] = gelu_tanh(cv[0]); cv[1] = gelu_tanh(cv[1]); cv[2] = gelu_tanh(cv[2]); cv[3] = gelu_tanh(cv[3]); res[t] = cv; } else res[t] = res[t] * cv;
                if (t >= 2) *(f32x4*)(sf + ((size_t)sq * 2 + (t - 2)) * 6144 + col) = uu;
                p2 = p1; p1 = uu;
            }
        }
#pragma unroll
        for (int t = 0; t < 4; ++t) { u32x2 w; w.x = pk2(res[t][0], res[t][1]); w.y = pk2(res[t][2], res[t][3]); *(u32x2*)(abuf + ((size_t)MP + (size_t)sq * 4 + t) * DFF + c) = w; }
    }
}

__device__ __forceinline__ void final_phase(const Params& P, int wave, int lane) {
    const bf16_t* xb = (const bf16_t*)(P.ws + WS_XB); const float* gn = P.in[I_NFIN];
    const int gw = blockIdx.x * 8 + wave, NGW = gridDim.x * 8;
    for (int m = gw; m < MT; m += NGW) {
        float* dst;
        if (m < MP) { const int b = m / LP, t = m % LP; if (t < NMETA) continue; dst = P.out + OFF_YP + ((size_t)b * SEQ + (t - NMETA)) * D; }
        else dst = P.out + OFF_YS + (size_t)(m - MP) * D;
        f32x4 v[4]; float s = 0.f;
#pragma unroll
        for (int j = 0; j < 4; ++j) { const u32x2 w = *((const u32x2*)(xb + (size_t)m * D) + lane + 64 * j); v[j][0] = bf2f(w.x & 0xffffu); v[j][1] = bf2f(w.x >> 16); v[j][2] = bf2f(w.y & 0xffffu); v[j][3] = bf2f(w.y >> 16);
            s += (v[j][0] * v[j][0] + v[j][1] * v[j][1]) + (v[j][2] * v[j][2] + v[j][3] * v[j][3]); }
        const float rs = __builtin_amdgcn_rsqf(wave_sum(s, lane) * (1.0f / 1024.0f) + EPS);
#pragma unroll
        for (int j = 0; j < 4; ++j) { const f32x4 g4 = *((const f32x4*)gn + lane + 64 * j); *((f32x4*)dst + lane + 64 * j) = v[j] * rs * g4; }
    }
}

__global__ void __launch_bounds__(512, 2) hymba_fwd(Params P) {
    extern __shared__ __attribute__((aligned(16))) unsigned char lds_raw[];
    LAS unsigned char* lds = (LAS unsigned char*)lds_raw;
    int wave0 = __builtin_amdgcn_readfirstlane((int)threadIdx.x >> 6);
    asm volatile("" : "+s"(wave0));
#define MYTID() (wave0 * 64 + my_lane_volatile())
    unsigned long long tacc_ = 0ull, tst_ = 0ull; (void)tacc_; (void)tst_;
#define TSTART(k) do { if (TIME_PHASE == (k)) tst_ = __builtin_amdgcn_s_memrealtime(); } while (0)
#define TEND(k) do { if (TIME_PHASE == (k)) tacc_ += __builtin_amdgcn_s_memrealtime() - tst_; } while (0)
    { const int tid = MYTID(); for (int i = tid; i < (LDS_BYTES - LDS_MISC) / 4; i += 512) ((LAS unsigned*)(lds + LDS_MISC))[i] = 0u; }
    __syncthreads();
    { unsigned char* w_ = glob_launder(P.ws); (void)xcd_barrier_post((unsigned*)(w_ + WS_CTL) + 4096, (volatile LAS unsigned*)(lds + LDS_MISC) + 8, MYTID()); }
#define GRID_BAR() do { unsigned char* w_ = glob_launder(P.ws); XcdBarrier b_; b_.bar = (unsigned*)(w_ + WS_CTL) + 4096; b_.x = xb_xcc_id(); b_.st = (volatile LAS unsigned*)(lds + LDS_MISC) + 8; \
        int t_ = MYTID(); asm volatile("" : "+v"(t_)); xcd_barrier(b_, t_); } while (0)
#define PHASE_ENV() Params Q = P; Q.ws = glob_launder(Q.ws); Q.out = glob_launder(Q.out); _Pragma("unroll") for (int i_ = 0; i_ < 31; ++i_) Q.in[i_] = glob(Q.in[i_]); unsigned char* ws = Q.ws; (void)ws; int ptid = MYTID(); asm volatile("" : "+v"(ptid)); const int lane = ptid & 63, wave = __builtin_amdgcn_readfirstlane(ptid >> 6); (void)lane; (void)wave; int G = (int)gridDim.x, bid = (int)blockIdx.x; asm volatile("" : "+s"(G), "+s"(bid)); (void)G; (void)bid

    TSTART(0);
    if (PH_MASK & 1) { PHASE_ENV(); if (REP_MASK & 256) p0_prologue(Q, lds, wave, lane, ptid); p0_prologue(Q, lds, wave, lane, ptid); }
    { cg::grid_group grid = cg::this_grid(); grid.sync(); }
    GRID_BAR();
    TEND(0);

#pragma unroll 1
    for (int l = 0; l < DEPTH; ++l) {
        TSTART(1);
        if (PH_MASK & 2) {
            PHASE_ENV();
            pg8::Gemm g{(const bf16_t*)(ws + WS_XB), (const bf16_t*)(ws + WS_W + (size_t)l * W_LAYER + W_IN), D, 67, 11, (long)256 * D * 2, (long)128 * D * 2, 0};
            pg8::ConsOrder S; S.init(67, 11, G, bid, (REP_MASK & 1) ? 2 : 1); S.cnt = (unsigned*)(ws + WS_CTL) + 16384 + ((l > 0 ? l - 1 : 0) * 2 + 1) * 67 * 64; S.need = l > 0 ? 4u : 0u; S.tmo = (unsigned*)(ws + WS_CTL) + 8; S.ovl = 0; S.wid = wave; S.nP = 67; S.rb = l > 0 ? 1 : 0;
            pg8::EpiIn E{(bf16_t*)(ws + WS_PROJ), (float*)(ws + WS_DTRAW), (const float*)(ws + WS_SS) + (size_t)(2 * l) * MPAD * 16};
            pg8::gemm_phase<pg8::EpiIn, pg8::ConsOrder, true, true>(lds, g, S, E, ptid);
        }
        if (l > 0) TEND(81);
        GRID_BAR();
        TEND(1);
        TSTART(2);
        {
            PHASE_ENV();
            const LayerPtrs L = layer_ptrs(Q, l);
            constexpr int N_SSD = NB * NCH * 2, N_LRU = NB * NCH, N_SMP = NS, N_SLRU = MS / 64, N_ALL = N_SSD + N_LRU + N_SMP + N_SLRU;
            TSTART(24);
            static_assert(N_SSD == 528 && N_LRU == 264 && N_SMP == 128 && N_SLRU == 8, "M1 deal");
#pragma unroll 1
            for (int k = 0; ; ++k) {
                int it;
                if (G == 256) {
                    if (k >= 4) break;
                    if (k == 0) it = N_SSD + bid;
                    else if (bid >= 240) it = k > 1 ? -1 : (bid < 248 ? N_SSD + 256 + (bid - 240) : N_SSD + N_LRU + N_SMP + (bid - 248));
                    else if (k == 1) it = bid;
                    else if (k == 2) it = 240 + bid;
                    else it = bid < 48 ? 480 + bid : (bid < 176 ? N_SSD + N_LRU + (bid - 48) : -1);
                    if (it < 0) continue;
                } else { it = bid + k * G; if (it >= N_ALL) break; }
                if (it < N_SSD) { if (PH_MASK & 4) { const int b = it / (NCH * 2), r = it % (NCH * 2); m1_ssd_unit(Q, L, l, b, r >> 1, r & 1, lds, wave, lane); } }
                else if (it < N_SSD + N_LRU) { const int r = it - N_SSD; int nr_ = (REP_MASK & 524288) ? 2 : 1; asm volatile("" : "+s"(nr_));
#pragma unroll 1
                    for (int q_ = 0; q_ < nr_; ++q_) if (PH_MASK & 8) m1_lru_unit(Q, L, l, r / NCH, r % NCH, lds, wave, lane); }
                else if (it < N_SSD + N_LRU + N_SMP) { if (PH_MASK & 16) m1_sample_ssd_unit(Q, L, l, it - N_SSD - N_LRU, lds, wave, lane); __syncthreads(); }
                else { if (PH_MASK & 16) lru_sample_unit(Q, L, l, it - N_SSD - N_LRU - N_SMP, lds, wave, lane); }
            }
            TEND(24);
        }
        GRID_BAR();
        TEND(2);
        if (REP_MASK & 128) { for (int eb_ = 0; eb_ < 10; ++eb_) GRID_BAR(); }
        TSTART(3);
        if (PH_MASK & 32) { PHASE_ENV(); m2_phase(Q, l, ptid, 0); }
        GRID_BAR();
        TEND(3);
        TSTART(4);
        {
            PHASE_ENV();
            const LayerPtrs L = layer_ptrs(Q, l);
            constexpr int N_PR = NB * NCH, N_SM = MS / 64, N_U = N_PR + N_SM;
            TSTART(44);
            int nrr_ = (REP_MASK & 262144) ? 2 : 1; asm volatile("" : "+s"(nrr_));
#pragma unroll 1
            for (int rr_ = 0; rr_ < nrr_; ++rr_) {
                for (int un = bid; un < N_U; un += G) {
                    if (un < N_PR) { if (PH_MASK & 64) m3_ssd_unit<false>(Q, L, l, un / NCH, un % NCH, 0, lds, wave, lane); } else if (PH_MASK & 128) m3_ssd_unit<true>(Q, L, l, 0, 0, un - N_PR, lds, wave, lane); }
                { const int nx = N_U > G ? N_U - G : 0, nl = G - nx;
                  if (bid >= nx) for (int un = bid - nx; un < N_PR; un += nl) { if (PH_MASK & 64) m3_lru_light(Q, L, un / NCH, un % NCH, wave, lane); } }
            }
            TEND(44);
        }
        GRID_BAR();
        TEND(4);
        TSTART(5);
        if (PH_MASK & 256) {
            PHASE_ENV();
            pg8::Gemm g{(const bf16_t*)(ws + WS_MIXED), (const bf16_t*)(ws + WS_W + (size_t)l * W_LAYER + W_OUT), D, 67, 4, (long)256 * D * 2, (long)128 * D * 2, 0};
            pg8::ProdOrder S; S.init(67, 4, G, (bid + G - (69 * 24) % G) % G); S.cnt = (unsigned*)(ws + WS_CTL) + 16384 + (l * 2 + 0) * 67 * 64; S.tid = ptid;
            pg8::EpiRes E{(bf16_t*)(ws + WS_XB), (float*)(ws + WS_SS) + (size_t)(2 * l + 1) * MPAD * 16};
            pg8::gemm_phase<pg8::EpiRes, pg8::ProdOrder, true, true>(lds, g, S, E, ptid);
        }
        TEND(5);
        TSTART(6);
        if (PH_MASK & 512) {
            PHASE_ENV();
            pg8::Gemm g{(const bf16_t*)(ws + WS_XB) - 2 * D, (const bf16_t*)(ws + WS_W + (size_t)l * W_LAYER + W_UP), D, 69, 24, (long)248 * D * 2, (long)124 * D * 2, 1};
            pg8::ConsOrder S; S.init(69, 24, G, bid, (REP_MASK & (8 | 512 | 8192 | 16384)) ? 2 : 1); S.cnt = (unsigned*)(ws + WS_CTL) + 16384 + (l * 2 + 0) * 67 * 64; S.need = 4u; S.tmo = (unsigned*)(ws + WS_CTL) + 8; S.ovl = 1; S.wid = wave; S.nP = 67; S.nMg = 67;
            pg8::EpiUp E{(bf16_t*)(ws + WS_ABUF), (const float*)(ws + WS_SS) + (size_t)(2 * l + 1) * MPAD * 16, Q.in[I_FCW] + (size_t)l * 3 * 6144, Q.in[I_FCB] + (size_t)l * 6144,
                         Q.out + OFF_PFC + (size_t)l * NB * 2 * 6144, (float*)(ws + WS_USAMP), (void*)(ws + WS_X)};
            pg8::gemm_phase<pg8::EpiUp, pg8::ConsOrder, true, true>(lds, g, S, E, ptid);
        }
        GRID_BAR();
        TEND(6);
        TSTART(7);
        if (PH_MASK & 512) { PHASE_ENV(); ffn_sample_phase(Q, l, ptid); }
        GRID_BAR();
        TEND(7);
        TSTART(8);
        if (l < DEPTH - 1) TSTART(81);
        if (PH_MASK & 1024) {
            PHASE_ENV();
            pg8::Gemm g{(const bf16_t*)(ws + WS_ABUF), (const bf16_t*)(ws + WS_W + (size_t)l * W_LAYER + W_DOWN), DFF, 67, 4, (long)256 * DFF * 2, (long)128 * DFF * 2, 0};
            pg8::ProdOrder S; S.init(67, 4, G, (bid + G - (67 * 11) % G) % G); S.cnt = (unsigned*)(ws + WS_CTL) + 16384 + (l * 2 + 1) * 67 * 64; S.tid = ptid;
            pg8::EpiRes E{(bf16_t*)(ws + WS_XB), (float*)(ws + WS_SS) + (size_t)(2 * l + 2) * MPAD * 16};
            pg8::gemm_phase<pg8::EpiRes, pg8::ProdOrder, true, true>(lds, g, S, E, ptid);
        }
        if (l == DEPTH - 1) GRID_BAR();
        TEND(8);
    }
    TSTART(9);
    if (PH_MASK & 2048) { PHASE_ENV(); final_phase(Q, wave, lane); }
    TEND(9);
    if (TIME_PHASE >= 0 && blockIdx.x == TIME_WG) { const unsigned long long t0_ = __builtin_amdgcn_s_memrealtime(); while (__builtin_amdgcn_s_memrealtime() - t0_ < 9ull * tacc_) __builtin_amdgcn_s_sleep(8); }
}

extern "C" void kernel_launch(void* const* d_in, const int* in_sizes, int n_in, void* d_out, int out_size, void* d_ws, size_t ws_size, hipStream_t stream) {
    static int grid = 0;
    if (grid == 0) {
        if (n_in != 31 || (size_t)out_size != OUT_TOTAL || ws_size < WS_END) { fprintf(stderr, "kernel_launch: unexpected problem (n_in %d, out %d, ws %zu)\n", n_in, out_size, ws_size); grid = -1; return; }
        int dev = 0, cus = 0, per_cu = 0;
        if (hipGetDevice(&dev) != hipSuccess || hipDeviceGetAttribute(&cus, hipDeviceAttributeMultiprocessorCount, dev) != hipSuccess) { grid = -1; return; }
        if (hipFuncSetAttribute((const void*)hymba_fwd, hipFuncAttributeMaxDynamicSharedMemorySize, LDS_BYTES) != hipSuccess) { fprintf(stderr, "kernel_launch: hipFuncSetAttribute failed\n"); grid = -1; return; }
        if (hipOccupancyMaxActiveBlocksPerMultiprocessor(&per_cu, (const void*)hymba_fwd, 512, LDS_BYTES) != hipSuccess || per_cu < 1) { fprintf(stderr, "kernel_launch: occupancy query says %d\n", per_cu); per_cu = 1; }
        (void)hipGetLastError();
        grid = cus * (per_cu > 1 ? 1 : per_cu);
    }
    if (grid < 0) return;
    (void)hipMemsetAsync((char*)d_ws + WS_CTL, 0, CTL_BYTES, stream);
    Params p{};
    for (int i = 0; i < 31; ++i) p.in[i] = (const float*)d_in[i];
    p.out = (float*)d_out; p.ws = (unsigned char*)d_ws;
    void* args[] = {&p};
    hipError_t e = hipLaunchCooperativeKernel((const void*)hymba_fwd, dim3(grid), dim3(512), args, LDS_BYTES, stream);
    if (e != hipSuccess) fprintf(stderr, "kernel_launch: cooperative launch failed: %s (grid %d)\n", hipGetErrorString(e), grid);
}
```

```cpp
#include <hip/hip_runtime.h>
#include <hip/hip_cooperative_groups.h>
#include <cstdio>
#include <cstdint>
namespace cg = cooperative_groups;
#ifndef PH_MASK
#define PH_MASK 0xFFF
#endif
#ifndef TIME_PHASE
#define TIME_WG 0
#define TIME_PHASE -1
#endif
#ifndef REP_MASK
#define REP_MASK 0
#endif

#define LAS __attribute__((address_space(3)))
#define GAS __attribute__((address_space(1)))
template <class T> __device__ __forceinline__ T* glob(T* p) { return (T*)(GAS T*)p; }
template <class T> __device__ __forceinline__ T* glob_launder(T* p) { GAS T* g = (GAS T*)p; asm volatile("" : "+s"(g)); return (T*)g; }
typedef unsigned short bf16_t;
typedef short bf16x8 __attribute__((ext_vector_type(8)));
typedef float f32x4 __attribute__((ext_vector_type(4)));
typedef float f32x2 __attribute__((ext_vector_type(2)));
typedef unsigned u32x4 __attribute__((ext_vector_type(4)));
typedef unsigned u32x2 __attribute__((ext_vector_type(2)));

constexpr int D = 1024, DEPTH = 4, NB = 8, SEQ = 2048, NMETA = 16, LP = SEQ + NMETA, NS = 128, LS = 4;
constexpr int MP = NB * LP, MS = NS * LS, MT = MP + MS, MPAD = 17152;
constexpr int NH = 8, HD = 64, SST = 128, DFF = 3072, PIN = 2568, PINPAD = 2816;
constexpr int DFFP = DFF + 64;
constexpr int O_LX = 0, O_LG = 512, O_Z = 1024, O_XBC = 1536, PROJ_LD = 2560;
constexpr int NCH = 33;
constexpr float EPS = 1e-6f;

constexpr size_t OFF_YP = 0, OFF_YS = OFF_YP + (size_t)NB * SEQ * D, OFF_PLC = OFF_YS + (size_t)MS * D, OFF_PLH = OFF_PLC + (size_t)DEPTH * NB * 3 * 512,
                 OFF_PSC = OFF_PLH + (size_t)DEPTH * NB * 512, OFF_PSS = OFF_PSC + (size_t)DEPTH * NB * 3 * 1024, OFF_PFC = OFF_PSS + (size_t)DEPTH * NB * 8 * 8192,
                 OFF_SLC = OFF_PFC + (size_t)DEPTH * NB * 2 * 6144, OFF_SLH = OFF_SLC + (size_t)DEPTH * NS * 3 * 512, OFF_SSC = OFF_SLH + (size_t)DEPTH * NS * 512,
                 OFF_SSS = OFF_SSC + (size_t)DEPTH * NS * 3 * 1024, OFF_SFC = OFF_SSS + (size_t)DEPTH * NS * 8 * 8192, OUT_TOTAL = OFF_SFC + (size_t)DEPTH * NS * 2 * 6144;

constexpr size_t MiB = 1u << 20;
constexpr size_t WS_CTL = 0, CTL_BYTES = 1 * MiB;
constexpr size_t WS_SS = 495 * MiB;
constexpr size_t WS_LRUW = 2 * MiB;
constexpr size_t WS_DTRAW = 3 * MiB, WS_CS = 4 * MiB, WS_CDEC = 5 * MiB, WS_LRUA = 6 * MiB, WS_LRUH = 7 * MiB, WS_LRUHIN = 8 * MiB;
constexpr size_t WS_W = 9 * MiB;
constexpr size_t W_LAYER = 25 * MiB + 3 * MiB / 4, W_IN = 0, W_OUT = 5 * MiB + MiB / 2, W_UP = 7 * MiB + MiB / 2, W_DOWN = 19 * MiB + MiB / 2;
constexpr size_t WS_X = 113 * MiB;
constexpr size_t WS_SINB = WS_X;
constexpr size_t WS_XB = 178 * MiB + 8192;
constexpr size_t WS_PROJ = 212 * MiB;
constexpr size_t WS_YBUF = 296 * MiB;
constexpr size_t WS_STATES = 330 * MiB;
constexpr size_t WS_MIXED = 399 * MiB;
constexpr size_t WS_ABUF = 296 * MiB;
constexpr size_t WS_GSCR = 433 * MiB;
constexpr size_t WS_USAMP = WS_GSCR;
constexpr size_t WS_HLAC = 448 * MiB;
constexpr size_t WS_END = 505 * MiB;
static_assert(WS_W + DEPTH * W_LAYER <= WS_X && WS_X + (size_t)34 * MiB <= 178 * MiB && WS_XB + (size_t)MPAD * D * 2 <= WS_PROJ, "ws map 1");
static_assert(WS_PROJ + (size_t)MPAD * PROJ_LD * 2 <= WS_YBUF && WS_YBUF + (size_t)MT * 512 * 4 <= WS_STATES && WS_STATES + (size_t)NB * NCH * 8 * 8192 * 4 <= WS_MIXED, "ws map 2");
static_assert(WS_SS + (size_t)9 * MPAD * 16 * 4 <= WS_END && WS_GSCR + 62 * MiB <= WS_SS && WS_USAMP + (size_t)MS * 6144 * 4 <= WS_SS && WS_MIXED + (size_t)MPAD * D * 2 <= WS_GSCR && WS_ABUF + (size_t)MPAD * DFFP * 2 <= WS_MIXED && WS_USAMP + (size_t)MS * 6144 * 4 <= WS_HLAC && WS_HLAC + (size_t)MPAD * 512 * 4 <= WS_SS && W_DOWN + (size_t)D * DFFP * 2 <= W_LAYER && WS_X + (size_t)NB * NCH * 8 * 8192 * 2 <= 178 * MiB, "ws map 3");

__device__ __forceinline__ float bf2f(unsigned b) { return __uint_as_float(b << 16); }
typedef __bf16 bf16x2n_t __attribute__((ext_vector_type(2)));
typedef float f32x2n_t __attribute__((ext_vector_type(2)));
__device__ __forceinline__ unsigned pk2(float lo, float hi) { const f32x2n_t f = {lo, hi}; return __builtin_bit_cast(unsigned, __builtin_convertvector(f, bf16x2n_t)); }
__device__ __forceinline__ unsigned f2bf(float f) { return (unsigned)__builtin_bit_cast(unsigned short, (__bf16)f); }
__device__ __forceinline__ float sigmoidf_(float x) { return __builtin_amdgcn_rcpf(1.0f + __builtin_amdgcn_exp2f(-1.4426950408889634f * x)); }
__device__ __forceinline__ float siluf_(float x) { return x * sigmoidf_(x); }
__device__ __forceinline__ float softplusf_(float x) { const float e = __builtin_amdgcn_exp2f(-1.4426950408889634f * __builtin_fabsf(x)); const float p = e * (1.0f - e * (0.5f - e * (0.33333334f - e * (0.25f - e * 0.2f)))); const float q = 0.6931471805599453f * __builtin_amdgcn_logf(1.0f + e); return fmaxf(x, 0.f) + (e < 0.0625f ? p : q); }
__device__ __forceinline__ float gelu_tanh(float x) { const float e = __builtin_amdgcn_exp2f(x * __builtin_fmaf(-0.10294324f, x * x, -2.3022082f)); return x * __builtin_amdgcn_rcpf(1.0f + e); }
__device__ __forceinline__ float neg_expm1(float y) { const float p = -y * (1.0f + y * (0.5f + y * (0.16666667f + y * (0.041666668f + y * (0.0083333338f + y * 0.0013888889f))))); const float q = 1.0f - __builtin_amdgcn_exp2f(1.4426950408889634f * y); return y > -0.25f ? p : q; }
__device__ __forceinline__ float dpp_ror1(float v) { return __int_as_float(__builtin_amdgcn_mov_dpp(__float_as_int(v), 0x121, 0xF, 0xF, false)); }
__device__ __forceinline__ float dpp_ror2(float v) { return __int_as_float(__builtin_amdgcn_mov_dpp(__float_as_int(v), 0x122, 0xF, 0xF, false)); }
__device__ __forceinline__ float bperm(float v, int srclane) { return __int_as_float(__builtin_amdgcn_ds_bpermute(srclane << 2, __float_as_int(v))); }
__device__ __forceinline__ float rowss(const float* ss, int row) { const f32x4 a = *(const f32x4*)(ss + (size_t)row * 4); return (a[0] + a[1]) + (a[2] + a[3]); }
__device__ __forceinline__ float conv3_dpp(float um, float upm, float w0, float w1, float w2, float b) {
    float o = __builtin_fmaf(w2, um, b);
    asm("s_nop 1\n\t"
        "v_fmac_f32_dpp %0, %1, %3 row_shr:1 row_mask:0xf bank_mask:0xf\n\t"
        "v_fmac_f32_dpp %0, %2, %3 row_shl:15 row_mask:0xf bank_mask:0xf\n\t"
        "v_fmac_f32_dpp %0, %1, %4 row_shr:2 row_mask:0xf bank_mask:0xf\n\t"
        "v_fmac_f32_dpp %0, %2, %4 row_shl:14 row_mask:0xf bank_mask:0xf"
        : "+v"(o) : "v"(um), "v"(upm), "v"(w1), "v"(w0));
    return o;
}
__device__ __forceinline__ float conv3_dpp_first(float um, float w0, float w1, float w2, float b) {
    float o = __builtin_fmaf(w2, um, b);
    asm("s_nop 1\n\t"
        "v_fmac_f32_dpp %0, %1, %2 row_shr:1 row_mask:0xf bank_mask:0xf\n\t"
        "v_fmac_f32_dpp %0, %1, %3 row_shr:2 row_mask:0xf bank_mask:0xf"
        : "+v"(o) : "v"(um), "v"(w1), "v"(w0));
    return o;
}
__device__ __forceinline__ float wave_sum(float v, int lane) {
#pragma unroll
    for (int o = 1; o < 64; o <<= 1) v += bperm(v, lane ^ o);
    return v;
}
#define LDS_WAIT() asm volatile("s_waitcnt lgkmcnt(0)" ::: "memory")
#define VM_WAIT() asm volatile("s_waitcnt vmcnt(0)" ::: "memory")
__device__ __forceinline__ f32x4 mfma16(bf16x8 p, bf16x8 q, f32x4 c) { return __builtin_amdgcn_mfma_f32_16x16x32_bf16(p, q, c, 0, 0, 0); }
__device__ __forceinline__ bf16x8 ldsfrag(const LAS unsigned char* img, int rs, int row, int kbyte) { return *(const LAS bf16x8*)(img + row * rs + kbyte); }

namespace pg8 {
#define PG8_LAS __attribute__((address_space(3)))
constexpr int BM = 256, BK = 64, HALF = 128, HTB = HALF * BK * 2, STAGE_BYTES = 8 * HTB, NXCD = 8, WGM = 8;
__host__ __device__ __forceinline__ int lds_byte(int r, int c) { const int st = (r >> 4) * 2 + (c >> 5), rr = r & 15, cc = c & 31, ob = rr * 64 + cc * 2; return st * 1024 + (ob ^ (((ob >> 9) & 1) << 5)); }
__host__ __device__ __forceinline__ void stage_rc(int b, int& R, int& C) { const int st = b / 1024, sb = b % 1024, swz = sb ^ (((sb >> 9) & 1) << 5); R = (st >> 1) * 16 + swz / 64; C = (st & 1) * 32 + (swz % 64) / 2; }
__host__ __device__ __forceinline__ int perm32(int rho) { const int n = rho >> 4, i = rho & 15; return 8 * (i >> 2) + 4 * n + (i & 3); }
struct Unit { int pm, pn, dry; };
struct Gemm { const bf16_t* A; const bf16_t* Bt; int K, nM, nN; long a_tstep, a_hstep; int ovl; int ld = 0; };
struct StaticOrder {
    int nM, nN, nwg, G, c, rep;
    __device__ __forceinline__ void init(int nM_, int nN_, int G_, int c_, int rep_ = 1) { nM = nM_; nN = nN_; nwg = nM * nN; G = G_; c = c_; rep = rep_; }
    __device__ __forceinline__ bool next(int i, Unit& u) const { return from_l((long)i * G + c, u); }
    __device__ __forceinline__ bool from_l(const long L, Unit& u) const {
        if (L >= (long)nwg * rep) return false;
        int wgid = (int)(L % nwg); u.dry = (L >= nwg) ? 1 : 0; { const int q = nwg / NXCD, r = nwg % NXCD, xcd = wgid % NXCD, off = wgid / NXCD; wgid = (xcd < r ? xcd * (q + 1) : r * (q + 1) + (xcd - r) * q) + off; }
        const int nig = WGM * nN, gid = wgid / nig, fm = gid * WGM, gsz = (nM - fm) < WGM ? (nM - fm) : WGM;
        u.pm = fm + ((wgid % nig) % gsz); u.pn = (wgid % nig) / gsz; return true;
    }
    __device__ __forceinline__ void a_ready(const Unit&) const {}
    __device__ __forceinline__ void done(const Unit&) const {}
};
struct ProdOrder : StaticOrder {
    unsigned* cnt; int tid;
    __device__ __forceinline__ bool next(int i, Unit& u) const {
        const long L = (long)i * G + c; if (L >= nwg) return false;
        u.dry = 0;
        const int n0 = 64 * nN;
        if (L < n0) { int wgid = (int)L; { const int q = n0 / NXCD, xcd = wgid % NXCD, off = wgid / NXCD; wgid = xcd * q + off; }
            const int nig = WGM * nN; u.pm = (wgid / nig) * WGM + ((wgid % nig) % WGM); u.pn = (wgid % nig) / WGM; }
        else { const int t = (int)L - n0; u.pm = 64 + t / nN; u.pn = t % nN; }
        return true;
    }
    __device__ __forceinline__ void done(const Unit& u) const {
        asm volatile("s_waitcnt vmcnt(0)" ::: "memory");
        __builtin_amdgcn_s_barrier();
        if (tid == 0) { __builtin_amdgcn_fence(__ATOMIC_RELEASE, "agent"); asm volatile("s_waitcnt vmcnt(0)" ::: "memory");
            __hip_atomic_fetch_add(cnt + 64 * u.pm, 1u, __ATOMIC_RELAXED, __HIP_MEMORY_SCOPE_AGENT); }
    }
};
struct ConsOrder : StaticOrder {
    int nMg = 0;
    int rb = 0;
    __device__ __forceinline__ bool next(int i, Unit& u) const {
        if (nMg == 0) {
            long L = (long)i * G + c;
            if (rb && G == 256) {
                int Lr = -2;
                if (c >= 225 && c <= 236) Lr = i == 0 ? (c == 231 ? 487 : c) : -1;
                else if (c == 223) Lr = i < 2 ? i * 256 + 223 : -1;
                else if (i == 2) { if (c == 237) Lr = 231; else if (c == 240) Lr = 488; else if ((c >= 241 && c <= 246) || (c >= 249 && c <= 252)) Lr = 240 + c; else if (c == 253) Lr = 735; }
                if (Lr == -1) return false;
                if (Lr >= 0) L = Lr;
            }
            return StaticOrder::from_l(L, u);
        }
        const long L = (long)i * G + c; if (L >= (long)nwg * rep) return false;
        const int t = (int)(L % nwg); u.dry = (L >= nwg) ? 1 : 0;
        const int n0 = nMg * nN;
        if (t < n0) { int wgid = t; { const int q = n0 / NXCD, r = n0 % NXCD, xcd = wgid % NXCD, off = wgid / NXCD; wgid = (xcd < r ? xcd * (q + 1) : r * (q + 1) + (xcd - r) * q) + off; }
            const int nig = WGM * nN, gid = wgid / nig, fm = gid * WGM, gsz = (nMg - fm) < WGM ? (nMg - fm) : WGM;
            u.pm = fm + ((wgid % nig) % gsz); u.pn = (wgid % nig) / gsz; }
        else { const int tt = t - n0; u.pm = nMg + tt / nN; u.pn = tt % nN; }
        return true;
    }
    unsigned* cnt; unsigned need; unsigned* tmo; int ovl, wid, nP;
    __device__ __forceinline__ void a_ready(const Unit& u) const {
        if (need == 0u) return;
        if (wid == 0) {
            int p0 = u.pm, p1 = u.pm;
            if (ovl) { int r0 = 248 * u.pm - 2; r0 = r0 < 0 ? 0 : r0; p0 = r0 >> 8; p1 = (248 * u.pm + 253) >> 8; p1 = p1 > nP - 1 ? nP - 1 : p1; }
            unsigned spins = 0;
            for (int p = p0; p <= p1; ++p) {
                while ((unsigned)__builtin_amdgcn_readfirstlane((int)__hip_atomic_load(cnt + 64 * p, __ATOMIC_RELAXED, __HIP_MEMORY_SCOPE_AGENT)) < need) {
                    if (++spins > (1u << 15)) { __hip_atomic_store(tmo, 1u, __ATOMIC_RELAXED, __HIP_MEMORY_SCOPE_AGENT); break; }
                    if ((spins & 255u) == 0u && __builtin_amdgcn_readfirstlane((int)__hip_atomic_load(tmo, __ATOMIC_RELAXED, __HIP_MEMORY_SCOPE_AGENT)) != 0) break;
                    __builtin_amdgcn_s_sleep(4); }
            }
            __builtin_amdgcn_fence(__ATOMIC_ACQUIRE, "agent");
            asm volatile("s_waitcnt vmcnt(0)" ::: "memory");
        }
        asm volatile("" ::: "memory"); __builtin_amdgcn_s_barrier(); asm volatile("" ::: "memory");
    }
};
__device__ __forceinline__ unsigned cvt_pk_bf16(float lo, float hi) { unsigned r; asm volatile("v_cvt_pk_bf16_f32 %0, %1, %2" : "=v"(r) : "v"(lo), "v"(hi)); return r; }

template <class Epi, class Sched, bool ALIGN_EPI, bool SP2>
__device__ __forceinline__ void gemm_phase(PG8_LAS unsigned char* lds, const Gemm g, const Sched& S, const Epi& E, const int tid) {
    const int wid = __builtin_amdgcn_readfirstlane(tid >> 6), lane = tid & 63, wr = wid >> 2, wc = wid & 3, fr = lane & 15, fq = lane >> 4;
    const int K = g.K, nt = K / BK, LD = g.ld ? g.ld : g.K;
    unsigned voffA[2], voffB[2];
#pragma unroll
    for (int i = 0; i < 2; ++i) { int R, C; stage_rc(tid * 16 + i * 8192, R, C); const int Rb = Epi::PERM ? ((R & ~31) + perm32(R & 31)) : R; const int Ra = g.ovl ? (R - 2 * (R >> 6)) : R;
        voffA[i] = (unsigned)(Ra * LD + C) * 2u; voffB[i] = (unsigned)(Rb * LD + C) * 2u; }
    const size_t kstep = (size_t)(BK * 2);
    const size_t hstepB = (size_t)HALF * LD * 2, tstepB = 2 * hstepB;
    const size_t hstepA = (size_t)g.a_hstep, tstepA = (size_t)g.a_tstep;
    const unsigned ldsw = (unsigned)wid * 1024u;
    const int aoff = lds_byte(wr * 64 + fr, fq * 8), boff = lds_byte(wc * 32 + fr, fq * 8);
#define PG8_SA(b, h) (((b) * 2 + (h)) * HTB)
#define PG8_SB(b, h) ((4 + (b) * 2 + (h)) * HTB)
#define PG8_STAGE(bufoff, gbase, voff) do { _Pragma("unroll") for (int _i = 0; _i < 2; ++_i) \
        __builtin_amdgcn_global_load_lds((const unsigned*)((const char*)(gbase) + (voff)[_i]), (PG8_LAS unsigned*)(lds + (bufoff) + ldsw + _i * 8192), 16, 0, 0); } while (0)
#define PG8_LDA(dst, b, h) do { _Pragma("unroll") for (int m = 0; m < 4; ++m) _Pragma("unroll") for (int k = 0; k < 2; ++k) dst[m][k] = *(const PG8_LAS bf16x8*)(lds + PG8_SA(b, h) + aoff + m * 2048 + k * 1024); } while (0)
#define PG8_LDB(dst, b, h) do { _Pragma("unroll") for (int n = 0; n < 2; ++n) _Pragma("unroll") for (int k = 0; k < 2; ++k) dst[n][k] = *(const PG8_LAS bf16x8*)(lds + PG8_SB(b, h) + boff + n * 2048 + k * 1024); } while (0)
#define PG8_MMA(ai, bj, At, Bt) do { __builtin_amdgcn_s_setprio(1); _Pragma("unroll") for (int m = 0; m < 4; ++m) _Pragma("unroll") for (int n = 0; n < 2; ++n) _Pragma("unroll") for (int k = 0; k < 2; ++k) \
        acc[ai][bj][m][n] = __builtin_amdgcn_mfma_f32_16x16x32_bf16(Bt[n][k], At[m][k], acc[ai][bj][m][n], 0, 0, 0); __builtin_amdgcn_s_setprio(0); } while (0)
#define PG8_WAIT_V(n) asm volatile("s_waitcnt vmcnt(" #n ")" ::: "memory")
#define PG8_WAIT_L(n) asm volatile("s_waitcnt lgkmcnt(" #n ")" ::: "memory")
#define PG8_BAR __builtin_amdgcn_s_barrier()
#define PG8_SCHED __builtin_amdgcn_sched_barrier(0)
    Unit cur, nxt; int ui = 0;
    if (!S.next(0, cur)) return;
    f32x4 acc[2][2][4][2];
#pragma unroll
    for (int a = 0; a < 2; ++a)
#pragma unroll
        for (int b = 0; b < 2; ++b)
#pragma unroll
            for (int m = 0; m < 4; ++m)
#pragma unroll
                for (int n = 0; n < 2; ++n) acc[a][b][m][n] = (f32x4){0.f, 0.f, 0.f, 0.f};
    bf16x8 At[4][2], B0[2][2], B1[2][2];
    const char* cA = (const char*)g.A + (size_t)cur.pm * tstepA; const char* cB = (const char*)g.Bt + (size_t)cur.pn * tstepB;
    S.a_ready(cur);
    E.prefetch(lds, cur, 0, wid, lane);
    if constexpr (SP2) {
        PG8_STAGE(PG8_SB(0, 0), cB, voffB); PG8_STAGE(PG8_SB(0, 1), cB + hstepB, voffB); PG8_STAGE(PG8_SA(0, 0), cA, voffA); PG8_STAGE(PG8_SA(0, 1), cA + hstepA, voffA);
        if (wr == 1) PG8_BAR;
        PG8_WAIT_V(2); PG8_BAR;
        PG8_STAGE(PG8_SB(1, 0), cB + kstep, voffB); PG8_STAGE(PG8_SA(1, 0), cA + kstep, voffA); PG8_STAGE(PG8_SB(1, 1), cB + hstepB + kstep, voffB);
        PG8_WAIT_V(6); PG8_BAR;
    } else {
        PG8_STAGE(PG8_SB(0, 0), cB, voffB); PG8_STAGE(PG8_SA(0, 0), cA, voffA); PG8_STAGE(PG8_SB(0, 1), cB + hstepB, voffB); PG8_STAGE(PG8_SA(0, 1), cA + hstepA, voffA);
        if (wr == 1) PG8_BAR;
        PG8_WAIT_V(4); PG8_BAR;
        PG8_STAGE(PG8_SB(1, 0), cB + kstep, voffB); PG8_STAGE(PG8_SA(1, 0), cA + kstep, voffA); PG8_STAGE(PG8_SB(1, 1), cB + hstepB + kstep, voffB);
        PG8_WAIT_V(6); PG8_BAR;
    }
    for (;;) {
        const bool has_next = S.next(ui + 1, nxt);
        const char* nA = has_next ? (const char*)g.A + (size_t)nxt.pm * tstepA : cA; const char* nB = has_next ? (const char*)g.Bt + (size_t)nxt.pn * tstepB : cB;
        for (int t = 0; t < nt; t += 2) {
            const bool last = (t == nt - 2);
            const char* a1 = cA + (size_t)(t + 1) * kstep;
            const char* a2 = last ? nA : cA + (size_t)(t + 2) * kstep; const char* b2 = last ? nB : cB + (size_t)(t + 2) * kstep;
            const char* a3 = a2 + kstep; const char* b3 = b2 + kstep;
            if (last && has_next) { S.a_ready(nxt); E.prefetch(lds, nxt, (ui + 1) & 1, wid, lane); }
            if constexpr (SP2) {
            PG8_LDB(B0, 0, 0); PG8_LDB(B1, 0, 1); PG8_SCHED; PG8_LDA(At, 0, 0); PG8_STAGE(PG8_SA(1, 1), a1 + hstepA, voffA);
            PG8_WAIT_V(8); PG8_WAIT_L(0); PG8_BAR; PG8_MMA(0, 0, At, B0); PG8_MMA(0, 1, At, B1); PG8_BAR; PG8_SCHED;
            PG8_LDA(At, 0, 1); PG8_STAGE(PG8_SB(0, 0), b2, voffB); PG8_STAGE(PG8_SB(0, 1), b2 + hstepB, voffB); PG8_STAGE(PG8_SA(0, 0), a2, voffA);
            PG8_WAIT_V(8); PG8_WAIT_L(0); PG8_BAR; PG8_MMA(1, 0, At, B0); PG8_MMA(1, 1, At, B1); PG8_BAR; PG8_SCHED;
            PG8_LDB(B0, 1, 0); PG8_LDB(B1, 1, 1); PG8_SCHED; PG8_LDA(At, 1, 0); PG8_STAGE(PG8_SA(0, 1), a2 + hstepA, voffA);
            PG8_WAIT_V(8); PG8_WAIT_L(0); PG8_BAR; PG8_MMA(0, 0, At, B0); PG8_MMA(0, 1, At, B1); PG8_BAR; PG8_SCHED;
            PG8_LDA(At, 1, 1); PG8_STAGE(PG8_SB(1, 0), b3, voffB); PG8_STAGE(PG8_SB(1, 1), b3 + hstepB, voffB); PG8_STAGE(PG8_SA(1, 0), a3, voffA);
            PG8_WAIT_V(8); PG8_WAIT_L(0); PG8_BAR; PG8_MMA(1, 0, At, B0); PG8_MMA(1, 1, At, B1); PG8_BAR; PG8_SCHED;
            } else {
            PG8_LDB(B0, 0, 0); PG8_SCHED; PG8_LDA(At, 0, 0); PG8_STAGE(PG8_SA(1, 1), a1 + hstepA, voffA);
            PG8_WAIT_L(8); PG8_BAR; PG8_WAIT_L(0); PG8_MMA(0, 0, At, B0); PG8_BAR; PG8_SCHED;
            PG8_LDB(B1, 0, 1); PG8_STAGE(PG8_SB(0, 0), b2, voffB);
            PG8_BAR; PG8_WAIT_L(0); PG8_MMA(0, 1, At, B1); PG8_BAR;
            PG8_LDA(At, 0, 1); PG8_STAGE(PG8_SA(0, 0), a2, voffA);
            PG8_BAR; PG8_WAIT_L(0); PG8_MMA(1, 0, At, B0); PG8_BAR; PG8_SCHED;
            PG8_STAGE(PG8_SB(0, 1), b2 + hstepB, voffB);
            PG8_WAIT_V(6); PG8_BAR; PG8_MMA(1, 1, At, B1); PG8_BAR;
            PG8_LDB(B0, 1, 0); PG8_SCHED; PG8_LDA(At, 1, 0); PG8_STAGE(PG8_SA(0, 1), a2 + hstepA, voffA);
            PG8_WAIT_L(8); PG8_BAR; PG8_WAIT_L(0); PG8_MMA(0, 0, At, B0); PG8_BAR; PG8_SCHED;
            PG8_LDB(B1, 1, 1); PG8_STAGE(PG8_SB(1, 0), b3, voffB);
            PG8_BAR; PG8_WAIT_L(0); PG8_MMA(0, 1, At, B1); PG8_BAR;
            PG8_LDA(At, 1, 1); PG8_STAGE(PG8_SA(1, 0), a3, voffA);
            PG8_BAR; PG8_WAIT_L(0); PG8_MMA(1, 0, At, B0); PG8_BAR; PG8_SCHED;
            PG8_STAGE(PG8_SB(1, 1), b3 + hstepB, voffB);
            PG8_WAIT_V(6); PG8_BAR; PG8_MMA(1, 1, At, B1); PG8_BAR;
            }
        }
        if constexpr (ALIGN_EPI) { if (wr == 0) PG8_BAR; }
        if constexpr (Epi::TWICE) { int nrep_ = 2; asm volatile("" : "+s"(nrep_));
_Pragma("unroll 1") for (int rep_ = 0; rep_ < nrep_; ++rep_) { asm volatile("" ::: "memory"); E(acc, cur, wr, wc, fr, fq, lds, ui & 1); } }
        else E(acc, cur, wr, wc, fr, fq, lds, ui & 1);
        S.done(cur);
        if (!has_next) break;
#pragma unroll
        for (int a = 0; a < 2; ++a)
#pragma unroll
            for (int b = 0; b < 2; ++b)
#pragma unroll
                for (int m = 0; m < 4; ++m)
#pragma unroll
                    for (int n = 0; n < 2; ++n) acc[a][b][m][n] = (f32x4){0.f, 0.f, 0.f, 0.f};
        cur = nxt; cA = nA; cB = nB; ++ui;
        if constexpr (ALIGN_EPI) { if (wr == 1) PG8_BAR; }
    }
    PG8_WAIT_V(0);
    if constexpr (!ALIGN_EPI) { if (wr == 0) PG8_BAR; }
    PG8_BAR;
#undef PG8_SA
#undef PG8_SB
#undef PG8_STAGE
#undef PG8_LDA
#undef PG8_LDB
#undef PG8_MMA
#undef PG8_WAIT_V
#undef PG8_WAIT_L
#undef PG8_BAR
#undef PG8_SCHED
}


struct EpiIn {
    static constexpr bool PERM = true, TWICE = false;
    bf16_t* proj; float* dtraw; const float* ss;
    __device__ __forceinline__ void prefetch(PG8_LAS unsigned char*, const Unit&, int, int, int) const {}
    __device__ __forceinline__ void operator()(const f32x4 (&acc)[2][2][4][2], const Unit& u, int wr, int wc, int fr, int fq, PG8_LAS unsigned char*, int) const {
        const int row0 = u.pm * BM + wr * 64 + fr;
        if (u.pn < 10) {
            const int col0 = u.pn * BM + wc * 32 + 8 * fq;
#pragma unroll
            for (int ai = 0; ai < 2; ++ai)
#pragma unroll
                for (int m = 0; m < 4; ++m) { const int row = row0 + ai * HALF + m * 16; const float rs = __builtin_amdgcn_rsqf(rowss(ss, row) * (1.0f / 1024.0f) + EPS);
                    bf16_t* rowp = proj + (size_t)row * PROJ_LD + col0;
#pragma unroll
                    for (int bj = 0; bj < 2; ++bj) { const f32x4 v0 = acc[ai][bj][m][0] * rs, v1 = acc[ai][bj][m][1] * rs;
                        u32x4 w; w.x = pk2(v0[0], v0[1]); w.y = pk2(v0[2], v0[3]); w.z = pk2(v1[0], v1[1]); w.w = pk2(v1[2], v1[3]);
                        *(u32x4*)(rowp + bj * HALF) = w; } }
        } else if (wc == 0 && fq == 0) {
#pragma unroll
            for (int ai = 0; ai < 2; ++ai)
#pragma unroll
                for (int m = 0; m < 4; ++m) { const int row = row0 + ai * HALF + m * 16; const float rs = __builtin_amdgcn_rsqf(rowss(ss, row) * (1.0f / 1024.0f) + EPS);
                    float* p = dtraw + (size_t)row * 8; *(f32x4*)p = acc[ai][0][m][0] * rs; *(f32x4*)(p + 4) = acc[ai][0][m][1] * rs; }
        }
    }
};
struct EpiRes {
    static constexpr bool PERM = true, TWICE = false;
    bf16_t* xb; float* ssn;
    __device__ __forceinline__ void prefetch(PG8_LAS unsigned char*, const Unit&, int, int, int) const {}
    static constexpr int SSRED_OFF = 131072 + 512 + 8192;
    __device__ __forceinline__ void operator()(const f32x4 (&acc)[2][2][4][2], const Unit& u, int wr, int wc, int fr, int fq, PG8_LAS unsigned char* lds, int) const {
        const int row0 = u.pm * BM + wr * 64 + fr, col0 = u.pn * BM + wc * 32 + 8 * fq;
        PG8_LAS float* red = (PG8_LAS float*)(lds + SSRED_OFF);
#pragma unroll
        for (int ai = 0; ai < 2; ++ai)
#pragma unroll
            for (int m = 0; m < 4; ++m) { const int row = row0 + ai * HALF + m * 16; float part = 0.f;
#pragma unroll
                for (int bj = 0; bj < 2; ++bj) { bf16_t* xp = xb + (size_t)row * D + col0 + bj * HALF; const u32x4 old = *(const u32x4*)xp;
                    f32x4 o0, o1;
                    o0[0] = bf2f(old.x & 0xffffu) + acc[ai][bj][m][0][0]; o0[1] = bf2f(old.x >> 16) + acc[ai][bj][m][0][1]; o0[2] = bf2f(old.y & 0xffffu) + acc[ai][bj][m][0][2]; o0[3] = bf2f(old.y >> 16) + acc[ai][bj][m][0][3];
                    o1[0] = bf2f(old.z & 0xffffu) + acc[ai][bj][m][1][0]; o1[1] = bf2f(old.z >> 16) + acc[ai][bj][m][1][1]; o1[2] = bf2f(old.w & 0xffffu) + acc[ai][bj][m][1][2]; o1[3] = bf2f(old.w >> 16) + acc[ai][bj][m][1][3];
                    part += (o0[0] * o0[0] + o0[1] * o0[1]) + (o0[2] * o0[2] + o0[3] * o0[3]) + (o1[0] * o1[0] + o1[1] * o1[1]) + (o1[2] * o1[2] + o1[3] * o1[3]);
                    u32x4 w; w.x = pk2(o0[0], o0[1]); w.y = pk2(o0[2], o0[3]); w.z = pk2(o1[0], o1[1]); w.w = pk2(o1[2], o1[3]);
                    *(u32x4*)xp = w; }
                { const int ln = fr + 16 * fq; part += bperm(part, ln ^ 16); part += bperm(part, ln ^ 32); }
                if (fq == 0) red[wc * 256 + ai * HALF + wr * 64 + m * 16 + fr] = part; }
        asm volatile("s_waitcnt lgkmcnt(0)" ::: "memory"); __builtin_amdgcn_s_barrier(); asm volatile("" ::: "memory");
        const int r = (wr * 4 + wc) * 64 + fq * 16 + fr;
        if (r < 256) ssn[(size_t)(u.pm * BM + r) * 4 + u.pn] = (red[r] + red[256 + r]) + (red[512 + r] + red[768 + r]);
    }
};
struct EpiUp {
    static constexpr bool PERM = true, TWICE = (REP_MASK & 1024) != 0;
    bf16_t* a; const float* ss; const float* cw; const float* cb; float* pf; float* usamp; void* dummy;
    static constexpr int CWS_OFF = 131072 + 512;
    __device__ __forceinline__ void prefetch(PG8_LAS unsigned char* lds, const Unit& u, int slot, int wid, int lane) const {
        if (wid < 4) { const int seg = 2 * wid + (lane >> 5), k = seg & 3, el = (lane & 31) * 4;
            const float* src = (k < 3 ? cw + k * 6144 : cb) + (seg >> 2) * 3072 + u.pn * 128 + el;
            __builtin_amdgcn_global_load_lds((const unsigned*)src, (PG8_LAS unsigned*)(lds + CWS_OFF + slot * 4096 + wid * 1024), 16, 0, 0); }
    }
    __device__ __forceinline__ void operator()(const f32x4 (&acc)[2][2][4][2], const Unit& u, int wr, int wc, int fr, int fq, PG8_LAS unsigned char* lds, int slot) const {
        const int ch0 = u.pn * 128 + wc * 32 + 8 * fq;
        const PG8_LAS float* cws = (const PG8_LAS float*)(lds + CWS_OFF + slot * 4096) + wc * 32 + 8 * fq;
        if ((REP_MASK & 512) && u.dry) return;
        bf16_t* a = this->a;
        int rmask = 0x7fffffff;
        if ((REP_MASK & (8192 | 16384)) && u.dry) { a = (bf16_t*)dummy; rmask = 8191; }
        if ((REP_MASK & 16384) && u.dry) {
#pragma unroll
            for (int ai = 0; ai < 2; ++ai) { const int gr0 = u.pm * 248 + 62 * (2 * ai + wr) - 2;
#pragma unroll
                for (int m = 0; m < 4; ++m) { const int gr = gr0 + 16 * m + fr; const int idx = gr < 0 ? 0 : gr; const float rs = __builtin_amdgcn_rsqf(rowss(ss, idx) * (1.0f / 1024.0f) + EPS);
#pragma unroll
                    for (int n = 0; n < 2; ++n) { const f32x4 g4 = acc[ai][0][m][n] * rs, v4 = acc[ai][1][m][n] * rs; u32x2 w; w.x = cvt_pk_bf16(g4[0] * v4[0], g4[1] * v4[1]); w.y = cvt_pk_bf16(g4[2] * v4[2], g4[3] * v4[3]);
                        if (gr >= 0 && gr < MP) *(u32x2*)(a + (size_t)(gr & rmask) * DFFP + ch0 + 4 * n) = w; } } }
            return;
        }
        constexpr int INV = (int)0x80000000;
#pragma unroll
        for (int ai = 0; ai < 2; ++ai) {
            const int gr0 = u.pm * 248 + 62 * (2 * ai + wr) - 2;
            float rs[4]; int tk[4];
            bool plain = true;
#pragma unroll
            for (int m = 0; m < 4; ++m) { const int lr = 16 * m + fr, gr = gr0 + lr; const int idx = gr < 0 ? 0 : gr; rs[m] = __builtin_amdgcn_rsqf(rowss(ss, idx) * (1.0f / 1024.0f) + EPS);
                tk[m] = (lr >= 2 && gr < MT) ? (gr < MP ? gr % LP : -1 - (gr - MP)) : INV;
                plain = plain && (tk[m] == INV || (tk[m] >= 2 && tk[m] < LP - 2)); }
            const bool all_plain = __builtin_amdgcn_ballot_w64(!plain) == 0ull;
            bool smp = true;
#pragma unroll
            for (int m = 0; m < 4; ++m) smp = smp && (tk[m] < 0);
            if (__builtin_amdgcn_ballot_w64(!smp) == 0ull) {
#pragma unroll
                for (int m = 0; m < 4; ++m) if (tk[m] != INV) { float* o = usamp + (size_t)(-1 - tk[m]) * 6144 + ch0;
#pragma unroll
                    for (int n = 0; n < 2; ++n) { *(f32x4*)(o + 4 * n) = acc[ai][0][m][n] * rs[m]; *(f32x4*)(o + 3072 + 4 * n) = acc[ai][1][m][n] * rs[m]; } }
            } else
            if (all_plain) {
                unsigned pk[4][4];
#pragma unroll
                for (int n = 0; n < 2; ++n) {
                    float keep[4];
#pragma unroll
                    for (int j = 0; j < 4; ++j) {
                        const float wg0 = cws[4 * n + j], wg1 = cws[128 + 4 * n + j], wg2 = cws[256 + 4 * n + j], bg = cws[384 + 4 * n + j];
                        const float wv0 = cws[512 + 4 * n + j], wv1 = cws[640 + 4 * n + j], wv2 = cws[768 + 4 * n + j], bv = cws[896 + 4 * n + j];
                        float ug[4], uv[4];
#pragma unroll
                        for (int m = 0; m < 4; ++m) { ug[m] = acc[ai][0][m][n][j] * rs[m]; uv[m] = acc[ai][1][m][n][j] * rs[m]; }
#pragma unroll
                        for (int m = 0; m < 4; ++m) {
                            const float cg_ = m == 0 ? conv3_dpp_first(ug[0], wg0, wg1, wg2, bg) : conv3_dpp(ug[m], ug[m > 0 ? m - 1 : 0], wg0, wg1, wg2, bg);
                            const float cv_ = m == 0 ? conv3_dpp_first(uv[0], wv0, wv1, wv2, bv) : conv3_dpp(uv[m], uv[m > 0 ? m - 1 : 0], wv0, wv1, wv2, bv);
                            const float r_ = gelu_tanh(cg_) * cv_;
                            if (j & 1) pk[m][2 * n + (j >> 1)] = cvt_pk_bf16(keep[m], r_); else keep[m] = r_;
                        }
                    }
                }
#pragma unroll
                for (int m = 0; m < 4; ++m) { if (tk[m] >= 0) { u32x4 w; w.x = pk[m][0]; w.y = pk[m][1]; w.z = pk[m][2]; w.w = pk[m][3]; *(u32x4*)(a + (size_t)((gr0 + 16 * m + fr) & rmask) * DFFP + ch0) = w; } }
            } else {
#pragma unroll
                for (int n = 0; n < 2; ++n) {
                    float keep[4]; unsigned pk[4][2];
#pragma unroll
                    for (int j = 0; j < 4; ++j) {
                        const int col = ch0 + 4 * n + j;
                        const float wg0 = cws[4 * n + j], wg1 = cws[128 + 4 * n + j], wg2 = cws[256 + 4 * n + j], bg = cws[384 + 4 * n + j];
                        const float wv0 = cws[512 + 4 * n + j], wv1 = cws[640 + 4 * n + j], wv2 = cws[768 + 4 * n + j], bv = cws[896 + 4 * n + j];
                        float pv1g = 0.f, pv2g = 0.f, pv1v = 0.f, pv2v = 0.f;
#pragma unroll
                        for (int m = 0; m < 4; ++m) {
                            const float ug = acc[ai][0][m][n][j] * rs[m], uv = acc[ai][1][m][n][j] * rs[m];
                            const float r1g = dpp_ror1(ug), r2g = dpp_ror2(ug), r1v = dpp_ror1(uv), r2v = dpp_ror2(uv);
                            float p1g = fr >= 1 ? r1g : pv1g, p2g = fr >= 2 ? r2g : pv2g, p1v = fr >= 1 ? r1v : pv1v, p2v = fr >= 2 ? r2v : pv2v;
                            pv1g = r1g; pv2g = r2g; pv1v = r1v; pv2v = r2v;
                            const int t = tk[m];
                            if (t >= 0) { if (t < 1) { p1g = 0.f; p1v = 0.f; } if (t < 2) { p2g = 0.f; p2v = 0.f; }
                                if (t >= LP - 2) { const int gr = gr0 + 16 * m + fr; float* o = pf + ((size_t)(gr / LP) * 2 + (t - (LP - 2))) * 6144 + col; o[0] = ug; o[3072] = uv; } }
                            else if (t != INV) { float* o = usamp + (size_t)(-1 - t) * 6144 + col; o[0] = ug; o[3072] = uv; }
                            const float cg_ = bg + wg0 * p2g + wg1 * p1g + wg2 * ug, cv_ = bv + wv0 * p2v + wv1 * p1v + wv2 * uv;
                            const float r_ = gelu_tanh(cg_) * cv_;
                            if (j & 1) pk[m][j >> 1] = cvt_pk_bf16(keep[m], r_); else keep[m] = r_;
                        }
                    }
#pragma unroll
                    for (int m = 0; m < 4; ++m) { if (tk[m] >= 0) { u32x2 w; w.x = pk[m][0]; w.y = pk[m][1]; *(u32x2*)(a + (size_t)((gr0 + 16 * m + fr) & rmask) * DFFP + ch0 + 4 * n) = w; } }
                }
            }
        }
    }
};
}

#define XB_TMO      128
#define XB_XCNT(j)  (256  + 64 * (j))
#define XB_XSUB(j)  (1280 + 64 * (j))
#define XB_XGEN(j)  (2304 + 64 * (j))
#define XB_TOP      3328
#define XB_TOPGEN   3392
#define XCD_BAR_WORDS 3456
#define XB_SPIN_CAP (1u << 18)
__device__ __forceinline__ unsigned xb_ld(unsigned* p)              { return __hip_atomic_load(p, __ATOMIC_RELAXED, __HIP_MEMORY_SCOPE_AGENT); }
__device__ __forceinline__ unsigned xb_add(unsigned* p, unsigned v) { return __hip_atomic_fetch_add(p, v, __ATOMIC_RELAXED, __HIP_MEMORY_SCOPE_AGENT); }
__device__ __forceinline__ unsigned xb_xcc_id() { return (unsigned)__builtin_amdgcn_s_getreg((3 << 11) | 20) & 0xFu; }
#define XB_SPIN(cond, bar) do { unsigned _sp = 0; while (cond) { __builtin_amdgcn_s_sleep(1); \
    if ((++_sp & 255u) == 0u) { if (xb_ld(&(bar)[XB_TMO])) break; if (_sp > XB_SPIN_CAP) { atomicAdd(&(bar)[XB_TMO], 1u); break; } } } } while (0)
struct XcdBarrier { unsigned* bar; unsigned x; volatile LAS unsigned* st; };
__device__ __forceinline__ XcdBarrier xcd_barrier_post(unsigned* bar, volatile LAS unsigned* st, const int tid) {
    XcdBarrier b; b.bar = bar; b.x = xb_xcc_id(); b.st = st;
    if (tid == 0) (void)xb_add(&bar[XB_XCNT(b.x)], 1u);
    return b;
}
__device__ __forceinline__ void xcd_barrier_complete(unsigned* bar, unsigned x, unsigned& nloc, unsigned& nx) {
    const unsigned G = gridDim.x * gridDim.y * gridDim.z;
    unsigned sum, cnt, mine, sp = 0u;
    for (;;) {
        sum = 0u; cnt = 0u; mine = 0u;
#pragma unroll
        for (unsigned j = 0; j < 16; ++j) { const unsigned c = xb_ld(&bar[XB_XCNT(j)]); sum += c; cnt += (c > 0u) ? 1u : 0u; mine = (j == x) ? c : mine; }
        if (sum == G) break;
        __builtin_amdgcn_s_sleep(1);
        if ((++sp & 255u) == 0u) { if (xb_ld(&bar[XB_TMO])) break; if (sp > XB_SPIN_CAP) { atomicAdd(&bar[XB_TMO], 1u); break; } }
    }
    nloc = mine > 0u ? mine : 1u; nx = cnt > 0u ? cnt : 1u;
}
__device__ __forceinline__ void xcd_barrier(const XcdBarrier& b, const int tid) {
    asm volatile("s_waitcnt vmcnt(0)" ::: "memory");
    __syncthreads();
    if (tid == 0) {
        unsigned* bar = b.bar;
        __builtin_amdgcn_s_waitcnt(0);
        unsigned nloc = b.st[0], nx = b.st[1];
        if (nloc == 0u) { xcd_barrier_complete(bar, b.x, nloc, nx); b.st[0] = nloc; b.st[1] = nx; }
        const unsigned old = xb_add(&bar[XB_XSUB(b.x)], 1u);
        const unsigned gen = old / nloc;
        if (old + 1u == (gen + 1u) * nloc) {
            __builtin_amdgcn_fence(__ATOMIC_RELEASE, "agent");
            asm volatile("s_waitcnt vmcnt(0)" ::: "memory");
            const unsigned og = xb_add(&bar[XB_TOP], 1u);
            const unsigned tg = og / nx;
            if (og + 1u == (tg + 1u) * nx) xb_add(&bar[XB_TOPGEN], 1u);
            else XB_SPIN(xb_ld(&bar[XB_TOPGEN]) == tg, bar);
            __builtin_amdgcn_fence(__ATOMIC_ACQUIRE, "agent");
            xb_add(&bar[XB_XGEN(b.x)], 1u);
            asm volatile("s_waitcnt vmcnt(0)" ::: "memory");
        } else {
            XB_SPIN(xb_ld(&bar[XB_XGEN(b.x)]) == gen, bar);
            __builtin_amdgcn_fence(__ATOMIC_ACQUIRE, "agent");
            asm volatile("s_waitcnt vmcnt(0)" ::: "memory");
        }
    }
    __syncthreads();
}

__device__ __forceinline__ int my_lane_volatile() { int x; asm volatile("v_mbcnt_lo_u32_b32 %0, -1, 0\n\tv_mbcnt_hi_u32_b32 %0, -1, %0" : "=v"(x)); return x; }
struct Params { const float* in[31]; float* out; unsigned char* ws; };
enum { I_XP = 0, I_XS, I_SLC, I_SLH, I_SSC, I_SSS, I_SFC, I_META, I_NMIX, I_WIN, I_LCW, I_LCB, I_WA, I_BA, I_WX, I_BX, I_APAR, I_LON, I_SCW, I_SCB, I_DTB, I_ALOG, I_SSD_D, I_SON, I_WOUT, I_NFFN, I_WUP, I_FCW, I_FCB, I_WDOWN, I_NFIN };

constexpr int LDS_MISC = 131072, LDS_BYTES = 147456;


__device__ __forceinline__ void p0_transpose_item(const float* W, int ldw, int nvalid, const float* gain, bf16_t* WT, int ldt, int k0, int n0, int drow0, LAS float* scr, int lane) {
    const int nn = n0 + (lane & 31);
    float vv[32];
#pragma unroll
    for (int i = 0; i < 32; ++i) { const int kk = 2 * i + (lane >> 5); vv[i] = nn < nvalid ? W[(size_t)(k0 + kk) * ldw + nn] : 0.f; }
#pragma unroll
    for (int i = 0; i < 32; ++i) { const int kk = 2 * i + (lane >> 5); float v = vv[i]; if (gain) v *= gain[k0 + kk]; scr[kk * 33 + (lane & 31)] = v; }
    LDS_WAIT(); asm volatile("" ::: "memory");
    const int c = lane & 7;
#pragma unroll
    for (int j = 0; j < 4; ++j) { const int n = (lane >> 3) + 8 * j; const LAS float* s = scr + (8 * c) * 33 + n;
        u32x4 o; o.x = pk2(s[0 * 33], s[1 * 33]); o.y = pk2(s[2 * 33], s[3 * 33]); o.z = pk2(s[4 * 33], s[5 * 33]); o.w = pk2(s[6 * 33], s[7 * 33]);
        *(u32x4*)(WT + (size_t)(drow0 + n) * ldt + k0 + 8 * c) = o; }
    LDS_WAIT(); asm volatile("" ::: "memory");
}
__device__ __forceinline__ void p0_prologue(const Params& P, LAS unsigned char* lds, int wave, int lane, const int tid) {
    LAS float* scr = (LAS float*)(lds + wave * 16384);
    const int gw = blockIdx.x * 8 + wave, NGW = gridDim.x * 8;
    unsigned char* ws = P.ws;
    constexpr int I_IN = 16 * 88, I_OUT = 16 * 32, I_UP = 16 * 192, I_DN = 48 * 32, I_L = I_IN + I_OUT + I_UP + I_DN, I_LRU = DEPTH * 8 * 2 * 2;
    for (int it = gw; it < DEPTH * I_L + I_LRU; it += NGW) {
        if (it < DEPTH * I_L) {
            const int l = it / I_L; int r = it % I_L; unsigned char* wl = ws + WS_W + (size_t)l * W_LAYER;
            if (r < I_IN) { const int kb = r / 88, nb = r % 88; p0_transpose_item(P.in[I_WIN] + (size_t)l * D * PIN, PIN, PIN, P.in[I_NMIX] + l * D, (bf16_t*)(wl + W_IN), D, 64 * kb, 32 * nb, 32 * nb, scr, lane); continue; } r -= I_IN;
            if (r < I_OUT) { const int kb = r / 32, nb = r % 32; p0_transpose_item(P.in[I_WOUT] + (size_t)l * D * D, D, D, nullptr, (bf16_t*)(wl + W_OUT), D, 64 * kb, 32 * nb, 32 * nb, scr, lane); continue; } r -= I_OUT;
            if (r < I_UP) { const int kb = r / 192, nb = r % 192, n0 = 32 * nb; const int drow = n0 < DFF ? (n0 / 128) * 256 + (n0 % 128) : ((n0 - DFF) / 128) * 256 + 128 + ((n0 - DFF) % 128);
                p0_transpose_item(P.in[I_WUP] + (size_t)l * D * 2 * DFF, 2 * DFF, 2 * DFF, P.in[I_NFFN] + l * D, (bf16_t*)(wl + W_UP), D, 64 * kb, n0, drow, scr, lane); continue; } r -= I_UP;
            { const int kb = r / 32, nb = r % 32; p0_transpose_item(P.in[I_WDOWN] + (size_t)l * DFF * D, D, D, nullptr, (bf16_t*)(wl + W_DOWN), DFFP, 64 * kb, 32 * nb, 32 * nb, scr, lane); }
        } else {
            const int r = it - DEPTH * I_L, lh = r >> 2, which = (r >> 1) & 1, nb = r & 1;
            p0_transpose_item(P.in[which ? I_WX : I_WA] + (size_t)lh * 4096, 64, 64, nullptr, (bf16_t*)(ws + WS_LRUW) + (size_t)which * DEPTH * 8 * 4096 + (size_t)lh * 4096, 64, 0, 32 * nb, 32 * nb, scr, lane);
        }
    }
    bf16_t* xb = (bf16_t*)(ws + WS_XB); float* ss = (float*)(ws + WS_SS);
    for (int m = gw; m < MPAD; m += NGW) {
        const float* src = nullptr;
        if (m < MP) { const int b = m / LP, t = m % LP; src = t < NMETA ? P.in[I_META] + (size_t)t * D : P.in[I_XP] + ((size_t)b * SEQ + (t - NMETA)) * D; }
        else if (m < MT) src = P.in[I_XS] + (size_t)(m - MP) * D;
        f32x4 v[4]; float s = 0.f;
#pragma unroll
        for (int j = 0; j < 4; ++j) { v[j] = src ? *((const f32x4*)src + lane + 64 * j) : (f32x4){0.f, 0.f, 0.f, 0.f}; s += (v[j][0] * v[j][0] + v[j][1] * v[j][1]) + (v[j][2] * v[j][2] + v[j][3] * v[j][3]); }
        s = wave_sum(s, lane);
#pragma unroll
        for (int j = 0; j < 4; ++j) {
            u32x2 w; w.x = pk2(v[j][0], v[j][1]); w.y = pk2(v[j][2], v[j][3]); *((u32x2*)(xb + (size_t)m * D) + lane + 64 * j) = w; }
        if (lane < 4) ss[(size_t)m * 4 + lane] = lane == 0 ? s : 0.f;
    }
    if (blockIdx.x == 0) for (int i = tid; i < 4 * D / 2; i += 512) ((unsigned*)(ws + WS_XB - 8192))[i] = 0u;
}

constexpr int M1_BG = 0, M1_CG = 17408, M1_BGT = 34816, M1_XT = 53248, M1_XST = 71680, M1_WIM = 90112, M1_SDT = 108544, M1_SCS = 109568;
constexpr int M3_XC = 0, XC_RS = 1040, M3_CG = 66560, M3_SSQS = 101376, M3_SSQL = 103424;

struct LayerPtrs {
    const float *lcw, *lcb, *ba, *bx, *apar, *lon, *scw, *scb, *dtb, *alog, *sdd, *son;
    const bf16_t *waT, *wxT;
};
__device__ __forceinline__ LayerPtrs layer_ptrs(const Params& P, int l) {
    LayerPtrs L;
    L.lcw = P.in[I_LCW] + (size_t)l * 4 * 512; L.lcb = P.in[I_LCB] + l * 512; L.ba = P.in[I_BA] + l * 512; L.bx = P.in[I_BX] + l * 512; L.apar = P.in[I_APAR] + l * 512; L.lon = P.in[I_LON] + l * 512;
    L.scw = P.in[I_SCW] + (size_t)l * 4 * 1024; L.scb = P.in[I_SCB] + l * 1024; L.dtb = P.in[I_DTB] + l * 8; L.alog = P.in[I_ALOG] + l * 8; L.sdd = P.in[I_SSD_D] + l * 8; L.son = P.in[I_SON] + l * 512;
    L.waT = (const bf16_t*)(P.ws + WS_LRUW) + (size_t)l * 8 * 4096; L.wxT = L.waT + (size_t)DEPTH * 8 * 4096;
    return L;
}

template <int CNT>
__device__ __forceinline__ void conv4_run(const bf16_t* src, size_t rowb, int tok0, float w0, float w1, float w2, float w3, float bias, bool do_silu, float (&out)[CNT]) {
    float x3 = tok0 - 3 >= 0 ? bf2f(src[(rowb + tok0 - 3) * PROJ_LD]) : 0.f, x2 = tok0 - 2 >= 0 ? bf2f(src[(rowb + tok0 - 2) * PROJ_LD]) : 0.f, x1 = tok0 - 1 >= 0 ? bf2f(src[(rowb + tok0 - 1) * PROJ_LD]) : 0.f;
#pragma unroll
    for (int i = 0; i < CNT; ++i) { const float x0 = bf2f(src[(rowb + tok0 + i) * PROJ_LD]); const float v = bias + w0 * x3 + w1 * x2 + w2 * x1 + w3 * x0; out[i] = do_silu ? siluf_(v) : v; x3 = x2; x2 = x1; x1 = x0; }
}

template <int CNT>
__device__ __forceinline__ void conv4_load(const bf16_t* src, size_t rowb, int tok0, float (&raw)[CNT + 3]) {
#pragma unroll
    for (int i = 0; i < 3; ++i) raw[i] = (tok0 - 3 + i >= 0) ? bf2f(src[(rowb + tok0 - 3 + i) * PROJ_LD]) : 0.f;
#pragma unroll
    for (int i = 3; i < CNT + 3; ++i) raw[i] = bf2f(src[(rowb + tok0 - 3 + i) * PROJ_LD]);
}
template <int CNT>
__device__ __forceinline__ void conv4_silu(const float (&raw)[CNT + 3], float w0, float w1, float w2, float w3, float bias, float (&out)[CNT]) {
#pragma unroll
    for (int i = 0; i < CNT; ++i) out[i] = siluf_(bias + w0 * raw[i] + w1 * raw[i + 1] + w2 * raw[i + 2] + w3 * raw[i + 3]);
}
__device__ __forceinline__ void m1_ssd_unit(const Params& P, const LayerPtrs& L, int l, int b, int c, int g, LAS unsigned char* lds, int wave, int lane_in) {
    int lane = lane_in; asm volatile("" : "+v"(lane));
    const int tid = wave * 64 + lane, fr = lane & 15, fq = lane >> 4;
    unsigned char* ws = P.ws;
    const bf16_t* proj = (const bf16_t*)(ws + WS_PROJ); const float* dtraw = (const float*)(ws + WS_DTRAW);
    float* csbuf = (float*)(ws + WS_CS); float* cdec = (float*)(ws + WS_CDEC); bf16_t* ybuf = (bf16_t*)(ws + WS_YBUF); bf16_t* states = (bf16_t*)(ws + WS_STATES);
    const size_t rowb = (size_t)b * LP; const int t0 = 64 * c;
    LAS float* SDT = (LAS float*)(lds + M1_SDT); LAS float* SCS = (LAS float*)(lds + M1_SCS);
    const int xi2 = tid & 127, q2 = tid >> 7;
    float raw2[2][19];
#pragma unroll
    for (int pr = 0; pr < 2; ++pr) conv4_load<16>(proj + O_XBC + 256 * g + 64 * (2 * pr + (xi2 >> 6)) + (xi2 & 63), rowb, t0 + 16 * q2, raw2[pr]);
    if (wave < 4) {
        const int head = 4 * g + wave, tok = t0 + lane; const bool ok = tok < LP;
        const float raw = ok ? dtraw[(rowb + tok) * 8 + head] : 0.f; const float dt = ok ? softplusf_(raw + L.dtb[head]) : 0.f;
        const float Ah = -__expf(L.alog[head]); float cs = dt * Ah;
#pragma unroll
        for (int o = 1; o < 64; o <<= 1) { const float v = bperm(cs, lane - o); if (lane >= o) cs += v; }
        SDT[wave * 64 + lane] = dt; SCS[wave * 64 + lane] = cs;
        if (ok) csbuf[(rowb + tok) * 8 + head] = cs;
        if (lane == 63) cdec[((size_t)b * NCH + c) * 8 + head] = __expf(cs);
    }
    {
        const int cg = tid & 31, rg = tid >> 5, isC = cg >> 4, n0 = (cg & 15) * 8, chan0 = 512 + 256 * isC + 128 * g + n0; const int tq = t0 + 4 * rg;
        u32x4 raw[7];
#pragma unroll
        for (int i = 0; i < 7; ++i) { const int tok = tq - 3 + i; raw[i] = *(const u32x4*)(proj + (rowb + (tok < 0 ? 0 : tok)) * PROJ_LD + O_XBC + chan0); }
        f32x4 w[4][2], bs[2];
#pragma unroll
        for (int k = 0; k < 4; ++k) { w[k][0] = *(const f32x4*)(L.scw + k * 1024 + chan0); w[k][1] = *(const f32x4*)(L.scw + k * 1024 + chan0 + 4); }
        bs[0] = *(const f32x4*)(L.scb + chan0); bs[1] = *(const f32x4*)(L.scb + chan0 + 4);
        if (tq < 3) {
#pragma unroll
            for (int i = 0; i < 3; ++i) if (tq - 3 + i < 0) raw[i] = (u32x4){0u, 0u, 0u, 0u};
        }
        LAS unsigned char* img = lds + (isC ? M1_CG : M1_BG);
        float ov[4][8];
#pragma unroll
        for (int r = 0; r < 4; ++r) {
            f32x4 o0 = bs[0], o1 = bs[1];
#pragma unroll
            for (int k = 0; k < 4; ++k) { const u32x4 x = raw[r + k];
                o0 += w[k][0] * (f32x4){bf2f(x[0] & 0xffffu), bf2f(x[0] >> 16), bf2f(x[1] & 0xffffu), bf2f(x[1] >> 16)};
                o1 += w[k][1] * (f32x4){bf2f(x[2] & 0xffffu), bf2f(x[2] >> 16), bf2f(x[3] & 0xffffu), bf2f(x[3] >> 16)}; }
#pragma unroll
            for (int j = 0; j < 4; ++j) { ov[r][j] = siluf_(o0[j]); ov[r][4 + j] = siluf_(o1[j]); }
            u32x4 q; q.x = pk2(ov[r][0], ov[r][1]); q.y = pk2(ov[r][2], ov[r][3]); q.z = pk2(ov[r][4], ov[r][5]); q.w = pk2(ov[r][6], ov[r][7]);
            *(LAS u32x4*)(img + (4 * rg + r) * 272 + n0 * 2) = q;
        }
        if (!isC) {
#pragma unroll
            for (int j = 0; j < 8; ++j) { u32x2 q; q.x = pk2(ov[0][j], ov[1][j]); q.y = pk2(ov[2][j], ov[3][j]); *(LAS u32x2*)(lds + M1_BGT + (n0 + j) * 144 + (4 * rg) * 2) = q; }
        }
        if (c == NCH - 1 && rg == 3) {
#pragma unroll
            for (int k = 0; k < 3; ++k) { const u32x4 x = raw[4 + k]; float* dst = P.out + OFF_PSC + (((size_t)l * NB + b) * 3 + k) * 1024 + chan0;
                *(f32x4*)dst = (f32x4){bf2f(x[0] & 0xffffu), bf2f(x[0] >> 16), bf2f(x[1] & 0xffffu), bf2f(x[1] >> 16)}; *(f32x4*)(dst + 4) = (f32x4){bf2f(x[2] & 0xffffu), bf2f(x[2] >> 16), bf2f(x[3] & 0xffffu), bf2f(x[3] >> 16)}; }
        }
    }
    __syncthreads();
#pragma unroll
    for (int pr = 0; pr < 2; ++pr) {
        {
            const int xi = tid & 127, q = tid >> 7, hl2 = xi >> 6, p = xi & 63, hl = 2 * pr + hl2, chan = 256 * g + 64 * hl + p;
            float o[16]; if (pr == 0) conv4_silu<16>(raw2[0], L.scw[chan], L.scw[1024 + chan], L.scw[2048 + chan], L.scw[3072 + chan], L.scb[chan], o); else conv4_silu<16>(raw2[1], L.scw[chan], L.scw[1024 + chan], L.scw[2048 + chan], L.scw[3072 + chan], L.scb[chan], o);
            const float cl = SCS[hl * 64 + 63];
            float os[16];
#pragma unroll
            for (int i = 0; i < 16; ++i) { const int s = 16 * q + i; os[i] = o[i] * SDT[hl * 64 + s] * __expf(cl - SCS[hl * 64 + s]); }
#pragma unroll
            for (int i = 0; i < 2; ++i) { u32x4 w; w.x = pk2(o[8 * i], o[8 * i + 1]); w.y = pk2(o[8 * i + 2], o[8 * i + 3]); w.z = pk2(o[8 * i + 4], o[8 * i + 5]); w.w = pk2(o[8 * i + 6], o[8 * i + 7]);
                *(LAS u32x4*)(lds + M1_XT + hl2 * 9216 + p * 144 + (16 * q + 8 * i) * 2) = w;
                u32x4 v; v.x = pk2(os[8 * i], os[8 * i + 1]); v.y = pk2(os[8 * i + 2], os[8 * i + 3]); v.z = pk2(os[8 * i + 4], os[8 * i + 5]); v.w = pk2(os[8 * i + 6], os[8 * i + 7]);
                *(LAS u32x4*)(lds + M1_XST + hl2 * 9216 + p * 144 + (16 * q + 8 * i) * 2) = v; }
            if (c == NCH - 1 && q == 0) {
#pragma unroll
                for (int k = 0; k < 3; ++k) P.out[OFF_PSC + (((size_t)l * NB + b) * 3 + k) * 1024 + chan] = bf2f(proj[(rowb + LP - 3 + k) * PROJ_LD + O_XBC + chan]);
            }
        }
        __syncthreads();
        {
            const int hl2 = wave >> 2, tt = wave & 3, hl = 2 * pr + hl2, head = 4 * g + hl;
            LAS unsigned char* Wm = lds + M1_WIM + wave * 2304;
            const LAS unsigned char* XT = lds + M1_XT + hl2 * 9216; const LAS unsigned char* XST = lds + M1_XST + hl2 * 9216;
            const int kb0 = 16 * fq;
            const int tl = 16 * tt + fr; const float cs_t = SCS[hl * 64 + tl];
#pragma unroll
            for (int st = 0; st < 4; ++st) {
                u32x2 wpk; wpk.x = 0u; wpk.y = 0u;
                if (st <= tt) {
                    f32x4 acc = (f32x4){0.f, 0.f, 0.f, 0.f};
#pragma unroll
                    for (int ks = 0; ks < 4; ++ks) acc = mfma16(ldsfrag(lds + M1_BG, 272, 16 * st + fr, 64 * ks + kb0), ldsfrag(lds + M1_CG, 272, tl, 64 * ks + kb0), acc);
                    const f32x4 css = *(const LAS f32x4*)(SCS + hl * 64 + 16 * st + 4 * fq), dts = *(const LAS f32x4*)(SDT + hl * 64 + 16 * st + 4 * fq);
                    float w[4];
#pragma unroll
                    for (int r = 0; r < 4; ++r) { const int s = 16 * st + 4 * fq + r; w[r] = (s <= tl) ? acc[r] * __expf(cs_t - css[r]) * dts[r] : 0.f; }
                    wpk.x = pk2(w[0], w[1]); wpk.y = pk2(w[2], w[3]);
                }
                *(LAS u32x2*)(Wm + fr * 144 + (16 * st + 4 * fq) * 2) = wpk;
            }
            LDS_WAIT();
            const int tok = t0 + tl; const float Dh = L.sdd[head];
#pragma unroll
            for (int pt = 0; pt < 4; ++pt) {
                f32x4 acc = (f32x4){0.f, 0.f, 0.f, 0.f};
#pragma unroll
                for (int ks = 0; ks < 2; ++ks) acc = mfma16(ldsfrag(XT, 144, 16 * pt + fr, 64 * ks + kb0), ldsfrag(Wm, 144, fr, 64 * ks + kb0), acc);
#pragma unroll
                for (int r = 0; r < 4; ++r) acc[r] += Dh * bf2f(*(const LAS bf16_t*)(XT + (16 * pt + 4 * fq + r) * 144 + tl * 2));
                if (tok < LP) { u32x2 w; w.x = pk2(acc[0], acc[1]); w.y = pk2(acc[2], acc[3]); *(u32x2*)(ybuf + (rowb + tok) * 512 + head * 64 + 16 * pt + 4 * fq) = w; }
            }
            bf16_t* sdst = states + (((size_t)b * NCH + c) * 8 + head) * 8192;
#pragma unroll
            for (int n2 = 0; n2 < 2; ++n2) { const int nt = 2 * tt + n2;
#pragma unroll
                for (int pt = 0; pt < 4; ++pt) {
                    f32x4 acc = (f32x4){0.f, 0.f, 0.f, 0.f};
#pragma unroll
                    for (int ks = 0; ks < 2; ++ks) acc = mfma16(ldsfrag(lds + M1_BGT, 144, 16 * nt + fr, 64 * ks + kb0), ldsfrag(XST, 144, 16 * pt + fr, 64 * ks + kb0), acc);
                    { u32x2 w; w.x = pk2(acc[0], acc[1]); w.y = pk2(acc[2], acc[3]); *(u32x2*)(sdst + (16 * pt + fr) * 128 + 16 * nt + 4 * fq) = w; }
                } }
        }
        __syncthreads();
    }
}

__device__ __forceinline__ void m1_sample_ssd_unit(const Params& P, const LayerPtrs& L, int l, int sq, LAS unsigned char* lds, int wave, int lane_in) {
    int lane = lane_in; asm volatile("" : "+v"(lane));
    unsigned char* ws = P.ws;
    const bf16_t* proj = (const bf16_t*)(ws + WS_PROJ); const float* dtraw = (const float*)(ws + WS_DTRAW); bf16_t* ybuf = (bf16_t*)(ws + WS_YBUF);
    const int head = wave, g = head >> 2; const size_t row0 = (size_t)MP + (size_t)sq * 4;
    LAS float* SX = (LAS float*)(lds + wave * 5120); LAS float* SB = SX + 256; LAS float* SC = SX + 768;
    const float* stc = P.in[I_SSC] + ((size_t)l * NS + sq) * 3 * 1024;
    const int p8 = lane >> 3, nq = lane & 7;
    const float* sin_ = P.in[I_SSS] + (((size_t)l * NS + sq) * 8 + head) * 8192;
    float* sout = P.out + OFF_SSS + (((size_t)l * NS + sq) * 8 + head) * 8192;
    f32x4 S[2][4][4];
#pragma unroll
    for (int pg = 0; pg < 4; ++pg)
#pragma unroll
        for (int k = 0; k < 4; ++k) S[0][pg][k] = *(const f32x4*)(sin_ + (8 * pg + p8) * 128 + 16 * nq + 4 * k);
    float dtr[4];
#pragma unroll
    for (int t = 0; t < 4; ++t) dtr[t] = dtraw[(row0 + t) * 8 + head];
    const float dtb_h = L.dtb[head];
    const float Ah = -__expf(L.alog[head]), Dh = L.sdd[head];
#pragma unroll 1
    for (int slot = 0; slot < 5; ++slot) {
        const int chan = slot == 0 ? head * 64 + lane : (slot < 3 ? 512 + g * 128 + lane + 64 * (slot - 1) : 768 + g * 128 + lane + 64 * (slot - 3));
        const float w0 = L.scw[chan], w1 = L.scw[1024 + chan], w2 = L.scw[2048 + chan], w3 = L.scw[3072 + chan], bs = L.scb[chan];
        const float s0 = stc[chan], s1 = stc[1024 + chan], s2 = stc[2048 + chan];
        float xr[4];
#pragma unroll
        for (int t = 0; t < 4; ++t) xr[t] = bf2f(proj[(row0 + t) * PROJ_LD + O_XBC + chan]);
        float y[4];
        y[0] = siluf_(bs + w0 * s0 + w1 * s1 + w2 * s2 + w3 * xr[0]); y[1] = siluf_(bs + w0 * s1 + w1 * s2 + w2 * xr[0] + w3 * xr[1]);
        y[2] = siluf_(bs + w0 * s2 + w1 * xr[0] + w2 * xr[1] + w3 * xr[2]); y[3] = siluf_(bs + w0 * xr[0] + w1 * xr[1] + w2 * xr[2] + w3 * xr[3]);
        LAS float* dst = slot == 0 ? SX + lane : (slot < 3 ? SB + lane + 64 * (slot - 1) : SC + lane + 64 * (slot - 3));
        const int rs = slot == 0 ? 64 : 128;
#pragma unroll
        for (int t = 0; t < 4; ++t) dst[t * rs] = y[t];
        if (slot == 0 || (head & 3) == 0) {
#pragma unroll
            for (int k = 0; k < 3; ++k) P.out[OFF_SSC + (((size_t)l * NS + sq) * 3 + k) * 1024 + chan] = xr[k + 1];
        }
    }
#pragma unroll
    for (int pg = 0; pg < 4; ++pg)
#pragma unroll
        for (int k = 0; k < 4; ++k) S[1][pg][k] = *(const f32x4*)(sin_ + (8 * (4 + pg) + p8) * 128 + 16 * nq + 4 * k);
    LAS float* SDTV = (LAS float*)(lds + 40960 + wave * 32);
#pragma unroll
    for (int t = 0; t < 4; ++t) { const float d_ = softplusf_(dtr[t] + dtb_h); if (lane == 0) { SDTV[t] = d_; SDTV[4 + t] = __expf(d_ * Ah); } }
    LDS_WAIT(); asm volatile("" ::: "memory");
#pragma unroll
    for (int hf = 0; hf < 2; ++hf) {
#pragma unroll 1
        for (int t = 0; t < 4; ++t) {
            const float dtv_t = SDTV[t], dec = SDTV[4 + t];
            f32x4 Bv[4], Cv[4];
#pragma unroll
            for (int k = 0; k < 4; ++k) { Bv[k] = *(const LAS f32x4*)(SB + t * 128 + 16 * nq + 4 * k); Cv[k] = *(const LAS f32x4*)(SC + t * 128 + 16 * nq + 4 * k); }
#pragma unroll
            for (int pg = 0; pg < 4; ++pg) {
                const int p = 8 * (4 * hf + pg) + p8; const float xv = SX[t * 64 + p]; const float xp = xv * dtv_t;
                float ys = 0.f;
#pragma unroll
                for (int k = 0; k < 4; ++k) { S[hf][pg][k] = S[hf][pg][k] * dec + Bv[k] * xp; const f32x4 pc = S[hf][pg][k] * Cv[k]; ys += (pc[0] + pc[1]) + (pc[2] + pc[3]); }
                ys += bperm(ys, lane ^ 1); ys += bperm(ys, lane ^ 2); ys += bperm(ys, lane ^ 4);
                if (nq == 0) ybuf[(row0 + t) * 512 + head * 64 + p] = (bf16_t)f2bf(ys + Dh * xv);
            }
        }
#pragma unroll
        for (int pg = 0; pg < 4; ++pg)
#pragma unroll
            for (int k = 0; k < 4; ++k) *(f32x4*)(sout + (8 * (4 * hf + pg) + p8) * 128 + 16 * nq + 4 * k) = S[hf][pg][k];
    }
    LDS_WAIT(); asm volatile("" ::: "memory");
}

template <bool SAMPLE, bool WRITE_STATE>
__device__ __forceinline__ void lru_build_xc(const Params& P, const LayerPtrs& L, int l, int b, int c, int u, LAS unsigned char* lds, const int ci) {
    const bf16_t* proj = (const bf16_t*)(P.ws + WS_PROJ);
    const float w0 = L.lcw[ci], w1 = L.lcw[512 + ci], w2 = L.lcw[1024 + ci], w3 = L.lcw[1536 + ci], bs = L.lcb[ci];
    if constexpr (!SAMPLE) {
        const size_t rowb = (size_t)b * LP; const int t0 = 64 * c;
#pragma unroll
        for (int h = 0; h < 2; ++h) { float o[32]; conv4_run<32>(proj + O_LX + ci, rowb, t0 + 32 * h, w0, w1, w2, w3, bs, false, o);
#pragma unroll
            for (int i = 0; i < 32; ++i) *(LAS bf16_t*)(lds + M3_XC + (32 * h + i) * XC_RS + ci * 2) = (bf16_t)f2bf(o[i]); }
        if (WRITE_STATE && c == NCH - 1) {
#pragma unroll
            for (int k = 0; k < 3; ++k) P.out[OFF_PLC + (((size_t)l * NB + b) * 3 + k) * 512 + ci] = bf2f(proj[(rowb + LP - 3 + k) * PROJ_LD + O_LX + ci]);
        }
    } else {
#pragma unroll 4
        for (int s = 0; s < 16; ++s) { const int sq = 16 * u + s; const size_t row0 = (size_t)MP + (size_t)sq * 4;
            const float* stc = P.in[I_SLC] + ((size_t)l * NS + sq) * 3 * 512; const float s0 = stc[ci], s1 = stc[512 + ci], s2 = stc[1024 + ci];
            float xr[4];
#pragma unroll
            for (int t = 0; t < 4; ++t) xr[t] = bf2f(proj[(row0 + t) * PROJ_LD + O_LX + ci]);
            float y[4];
            y[0] = bs + w0 * s0 + w1 * s1 + w2 * s2 + w3 * xr[0]; y[1] = bs + w0 * s1 + w1 * s2 + w2 * xr[0] + w3 * xr[1];
            y[2] = bs + w0 * s2 + w1 * xr[0] + w2 * xr[1] + w3 * xr[2]; y[3] = bs + w0 * xr[0] + w1 * xr[1] + w2 * xr[2] + w3 * xr[3];
#pragma unroll
            for (int t = 0; t < 4; ++t) *(LAS bf16_t*)(lds + M3_XC + (4 * s + t) * XC_RS + ci * 2) = (bf16_t)f2bf(y[t]);
            if (WRITE_STATE) {
#pragma unroll
                for (int k = 0; k < 3; ++k) P.out[OFF_SLC + (((size_t)l * NS + sq) * 3 + k) * 512 + ci] = xr[k + 1];
            } }
    }
}

__device__ __forceinline__ void lru_build_xc_wave(const Params& P, const LayerPtrs& L, int l, int b, int c, LAS unsigned char* lds, int wave, int lane) {
    const bf16_t* proj = (const bf16_t*)(P.ws + WS_PROJ);
    const int c8 = lane & 7, g = lane >> 3, ch0 = 64 * wave + 8 * c8;
    const size_t rowb = (size_t)b * LP; const int t0 = 64 * c + 8 * g;
    u32x4 raw[11];
#pragma unroll
    for (int i = 0; i < 11; ++i) { const int tok = t0 - 3 + i; raw[i] = *(const u32x4*)(proj + (rowb + (tok < 0 ? 0 : tok)) * PROJ_LD + O_LX + ch0); }
    f32x4 w[4][2], bs[2];
#pragma unroll
    for (int k = 0; k < 4; ++k) { w[k][0] = *(const f32x4*)(L.lcw + k * 512 + ch0); w[k][1] = *(const f32x4*)(L.lcw + k * 512 + ch0 + 4); }
    bs[0] = *(const f32x4*)(L.lcb + ch0); bs[1] = *(const f32x4*)(L.lcb + ch0 + 4);
    if (t0 < 3) {
#pragma unroll
        for (int i = 0; i < 3; ++i) if (t0 - 3 + i < 0) raw[i] = (u32x4){0u, 0u, 0u, 0u};
    }
#pragma unroll
    for (int r = 0; r < 8; ++r) {
        f32x4 o0 = bs[0], o1 = bs[1];
#pragma unroll
        for (int k = 0; k < 4; ++k) { const u32x4 x = raw[r + k];
            o0 += w[k][0] * (f32x4){bf2f(x[0] & 0xffffu), bf2f(x[0] >> 16), bf2f(x[1] & 0xffffu), bf2f(x[1] >> 16)};
            o1 += w[k][1] * (f32x4){bf2f(x[2] & 0xffffu), bf2f(x[2] >> 16), bf2f(x[3] & 0xffffu), bf2f(x[3] >> 16)}; }
        u32x4 q; q.x = pg8::cvt_pk_bf16(o0[0], o0[1]); q.y = pg8::cvt_pk_bf16(o0[2], o0[3]); q.z = pg8::cvt_pk_bf16(o1[0], o1[1]); q.w = pg8::cvt_pk_bf16(o1[2], o1[3]);
        *(LAS u32x4*)(lds + M3_XC + (8 * g + r) * XC_RS + ch0 * 2) = q;
    }
    if (c == NCH - 1 && g == 1) {
#pragma unroll
        for (int k = 0; k < 3; ++k) { const u32x4 x = raw[8 + k]; float* dst = P.out + OFF_PLC + (((size_t)l * NB + b) * 3 + k) * 512 + ch0;
            *(f32x4*)dst = (f32x4){bf2f(x[0] & 0xffffu), bf2f(x[0] >> 16), bf2f(x[1] & 0xffffu), bf2f(x[1] >> 16)}; *(f32x4*)(dst + 4) = (f32x4){bf2f(x[2] & 0xffffu), bf2f(x[2] >> 16), bf2f(x[3] & 0xffffu), bf2f(x[3] >> 16)}; }
    }
    LDS_WAIT();
}

template <bool SAMPLE>
__device__ __forceinline__ void lru_wave(const Params& P, const LayerPtrs& L, int l, int b, int c, int u, int len, LAS unsigned char* lds, int wave, int lane, bf16_t* hdst) {
    const int fr = lane & 15, fq = lane >> 4, h = wave; unsigned char* ws = P.ws;
    const bf16_t* proj = (const bf16_t*)(ws + WS_PROJ);
    float* lruA = (float*)(ws + WS_LRUA); float* lruH = (float*)(ws + WS_LRUH);
    const size_t rowbase = SAMPLE ? (size_t)MP + 64 * (size_t)u : (size_t)b * LP + 64 * (size_t)c;
    bf16x8 qan[2], qxn[2];
#pragma unroll
    for (int ks = 0; ks < 2; ++ks) { qan[ks] = *(const bf16x8*)(L.waT + ((size_t)(h * 64 + fr) * 64 + 32 * ks + 8 * fq)); qxn[ks] = *(const bf16x8*)(L.wxT + ((size_t)(h * 64 + fr) * 64 + 32 * ks + 8 * fq)); }
    float ban = L.ba[64 * h + fr], bxn = L.bx[64 * h + fr], apn = L.apar[64 * h + fr];
#pragma unroll 1
    for (int jt = 0; jt < 4; ++jt) {
        const int ch = 64 * h + 16 * jt + fr;
        bf16x8 qa[2], qx[2];
#pragma unroll
        for (int ks = 0; ks < 2; ++ks) { qa[ks] = qan[ks]; qx[ks] = qxn[ks]; }
        const float ba_c = ban, bx_c = bxn, ap_c = apn;
        { const int jn = jt < 3 ? jt + 1 : 3; ban = L.ba[64 * h + 16 * jn + fr]; bxn = L.bx[64 * h + 16 * jn + fr]; apn = L.apar[64 * h + 16 * jn + fr];
#pragma unroll
          for (int ks = 0; ks < 2; ++ks) { qan[ks] = *(const bf16x8*)(L.waT + ((size_t)(h * 64 + 16 * jn + fr) * 64 + 32 * ks + 8 * fq)); qxn[ks] = *(const bf16x8*)(L.wxT + ((size_t)(h * 64 + 16 * jn + fr) * 64 + 32 * ks + 8 * fq)); } }
        f32x4 ar[4], ai[4];
#pragma unroll
        for (int tt = 0; tt < 4; ++tt) { ar[tt] = (f32x4){0.f, 0.f, 0.f, 0.f}; ai[tt] = (f32x4){0.f, 0.f, 0.f, 0.f};
#pragma unroll
            for (int ks = 0; ks < 2; ++ks) { const bf16x8 pf = ldsfrag(lds + M3_XC, XC_RS, 16 * tt + fr, (64 * h + 32 * ks + 8 * fq) * 2); ar[tt] = mfma16(pf, qa[ks], ar[tt]); ai[tt] = mfma16(pf, qx[ks], ai[tt]); } }
        constexpr float L2E = 1.4426950408889634f;
        const float bav2 = -L2E * ba_c, bxv2 = -L2E * bx_c, sp = softplusf_(-ap_c), spa = -8.0f * L2E * sp, spy = -16.0f * sp;
        float av[4][4], bv[4][4], A4[4], B4[4];
#pragma unroll
        for (int tt = 0; tt < 4; ++tt) {
#pragma unroll
            for (int r = 0; r < 4; ++r) { const int t = 16 * tt + 4 * fq + r;
                const float rg = __builtin_amdgcn_rcpf(1.0f + __builtin_amdgcn_exp2f(__builtin_fmaf(ar[tt][r], -L2E, bav2))), ig = __builtin_amdgcn_rcpf(1.0f + __builtin_amdgcn_exp2f(__builtin_fmaf(ai[tt][r], -L2E, bxv2)));
                const float a_ = __builtin_amdgcn_exp2f(rg * spa), y = rg * spy;
                const float p = -y * (1.0f + y * (0.5f + y * (0.16666667f + y * (0.041666668f + y * 0.0083333338f)))), q = __builtin_fmaf(-a_, a_, 1.0f);
                const float mult = __builtin_amdgcn_sqrtf(y > -0.125f ? p : q); const float xc = bf2f(*(const LAS bf16_t*)(lds + M3_XC + t * XC_RS + ch * 2));
                av[tt][r] = t >= len ? 1.f : a_; bv[tt][r] = t >= len ? 0.f : mult * ig * xc; }
            float A = av[tt][0], B = bv[tt][0];
#pragma unroll
            for (int r = 1; r < 4; ++r) { B = av[tt][r] * B + bv[tt][r]; A *= av[tt][r]; }
            A4[tt] = A; B4[tt] = B; }
        if constexpr (!SAMPLE) {
            float cin[4], pin[4];
            float stv = 0.f, prd = 1.f;
#pragma unroll
            for (int tt = 0; tt < 4; ++tt)
#pragma unroll
                for (int q = 0; q < 4; ++q) { const float Aq = bperm(A4[tt], fr + 16 * q), Bq = bperm(B4[tt], fr + 16 * q); if (q == fq) { cin[tt] = stv; pin[tt] = prd; } stv = Aq * stv + Bq; prd *= Aq; }
            if (fq == 0) { lruA[((size_t)b * NCH + c) * 512 + ch] = prd; lruH[((size_t)b * NCH + c) * 512 + ch] = stv; }
            LAS unsigned char* stg = lds + M3_CG + wave * 4096;
#pragma unroll
            for (int tt = 0; tt < 4; ++tt) { float s = cin[tt], pa = pin[tt];
#pragma unroll
                for (int r = 0; r < 4; ++r) { s = av[tt][r] * s + bv[tt][r]; pa *= av[tt][r]; *(LAS unsigned*)(stg + (((4 * tt + r) * 4 + fq) << 6) + fr * 4) = pg8::cvt_pk_bf16(s, pa); } }
            LDS_WAIT();
            unsigned* pdst = (unsigned*)(ws + WS_HLAC) + rowbase * 512 + 64 * h + 16 * jt + 4 * (lane & 3);
#pragma unroll
            for (int j = 0; j < 4; ++j) { const int slot = 16 * j + (lane >> 2), t = 16 * (slot >> 4) + 4 * (slot & 3) + ((slot >> 2) & 3);
                const u32x4 w = *(const LAS u32x4*)(stg + (slot << 6) + (lane & 3) * 16);
                if (t < len) *(u32x4*)(pdst + (size_t)t * 512) = w; }
            LDS_WAIT();
        } else {
#pragma unroll
            for (int tt = 0; tt < 4; ++tt) { float s = P.in[I_SLH][((size_t)l * NS + 16 * u + 4 * tt + fq) * 512 + ch];
#pragma unroll
                for (int r = 0; r < 4; ++r) { const int t = 16 * tt + 4 * fq + r; s = av[tt][r] * s + bv[tt][r]; hdst[(size_t)t * D + ch] = (bf16_t)f2bf(s); }
                P.out[OFF_SLH + ((size_t)l * NS + 16 * u + 4 * tt + fq) * 512 + ch] = s; }
        }
    }
}

__device__ __forceinline__ void m1_lru_unit(const Params& P, const LayerPtrs& L, int l, int b, int c, LAS unsigned char* lds, int wave, int lane_in) {
    int lane = lane_in; asm volatile("" : "+v"(lane));
    lru_build_xc_wave(P, L, l, b, c, lds, wave, lane);
    const int len = (LP - 64 * c) < 64 ? (LP - 64 * c) : 64;
    lru_wave<false>(P, L, l, b, c, 0, len, lds, wave, lane, nullptr);
    __syncthreads();
}

template <bool FROM_LDS, bool GELU, bool CARRY>
__device__ __forceinline__ void m3_finish(const LAS unsigned char* gl, const bf16_t* gate_rows  , const float* gain, bf16_t* mixed_rows, int len, int wave, int lane,
                                          const u32x4* gpre = nullptr  , const unsigned* pair_rows = nullptr  , const float* hin = nullptr) {
    if constexpr (!CARRY) { VM_WAIT(); LDS_WAIT(); __syncthreads(); }
    const int c8 = lane * 8;
    const f32x4 g0 = *(const f32x4*)(gain + c8), g1 = *(const f32x4*)(gain + c8 + 4);
    f32x4 h0 = (f32x4){0.f, 0.f, 0.f, 0.f}, h1 = h0;
    if constexpr (CARRY) { h0 = *(const f32x4*)(hin + c8); h1 = *(const f32x4*)(hin + c8 + 4); }
    u32x4 sv[8], gv[8], cv[8];
#pragma unroll
    for (int i = 0; i < 8; ++i) { const int row = wave * 8 + i;
        if constexpr (CARRY) { sv[i] = *(const u32x4*)(pair_rows + (size_t)row * 512 + c8); cv[i] = *(const u32x4*)(pair_rows + (size_t)row * 512 + c8 + 4); }
        else if (FROM_LDS) sv[i] = *(const LAS u32x4*)(gl + row * 1024 + ((lane ^ (row & 15)) << 4)); else sv[i] = *(const u32x4*)(mixed_rows + (size_t)row * D + c8);
        gv[i] = gpre ? gpre[i] : *(const u32x4*)(gate_rows + (size_t)row * PROJ_LD + c8); }
#pragma unroll
    for (int i = 0; i < 8; ++i) { const int row = wave * 8 + i;
        float v[8];
        if constexpr (CARRY) {
#pragma unroll
            for (int j = 0; j < 4; ++j) { v[j] = bf2f(sv[i][j] & 0xffffu) + bf2f(sv[i][j] >> 16) * h0[j]; v[4 + j] = bf2f(cv[i][j] & 0xffffu) + bf2f(cv[i][j] >> 16) * h1[j]; }
        } else {
#pragma unroll
            for (int k = 0; k < 4; ++k) { v[2 * k] = bf2f(sv[i][k] & 0xffffu); v[2 * k + 1] = bf2f(sv[i][k] >> 16); }
        }
        float sq = 0.f;
#pragma unroll
        for (int k = 0; k < 4; ++k) { const float z0 = bf2f(gv[i][k] & 0xffffu), z1 = bf2f(gv[i][k] >> 16);
            v[2 * k] *= (GELU ? gelu_tanh(z0) : siluf_(z0)); v[2 * k + 1] *= (GELU ? gelu_tanh(z1) : siluf_(z1)); sq += v[2 * k] * v[2 * k] + v[2 * k + 1] * v[2 * k + 1]; }
        const float rs = __builtin_amdgcn_rsqf(wave_sum(sq, lane) * (1.0f / 512.0f) + EPS);
        if (row < len) { u32x4 w; w.x = pk2(v[0] * rs * g0[0], v[1] * rs * g0[1]); w.y = pk2(v[2] * rs * g0[2], v[3] * rs * g0[3]); w.z = pk2(v[4] * rs * g1[0], v[5] * rs * g1[1]); w.w = pk2(v[6] * rs * g1[2], v[7] * rs * g1[3]);
            *(u32x4*)(mixed_rows + (size_t)row * D + c8) = w; }
    }
    if constexpr (!CARRY) __syncthreads();
}
__device__ __forceinline__ void lru_sample_unit(const Params& P, const LayerPtrs& L, int l, int u, LAS unsigned char* lds, int wave, int lane_in) {
    int lane = lane_in; asm volatile("" : "+v"(lane));
    const int tid = wave * 64 + lane; unsigned char* ws = P.ws;
    bf16_t* mixed = (bf16_t*)(ws + WS_MIXED); const bf16_t* proj = (const bf16_t*)(ws + WS_PROJ);
    const size_t rowbase = (size_t)MP + 64 * (size_t)u;
    lru_build_xc<true, true>(P, L, l, 0, 0, u, lds, tid);
    __syncthreads();
    lru_wave<true>(P, L, l, 0, 0, u, 64, lds, wave, lane, mixed + rowbase * D);
    m3_finish<false, true, false>(nullptr, proj + rowbase * PROJ_LD + O_LG, L.lon, mixed + rowbase * D, 64, wave, lane);
}
__device__ __forceinline__ void m3_lru_light(const Params& P, const LayerPtrs& L, int b, int c, int wave, int lane_in) {
    int lane = lane_in; asm volatile("" : "+v"(lane));
    unsigned char* ws = P.ws;
    const size_t rowbase = (size_t)b * LP + 64 * (size_t)c;
    const int len = (LP - 64 * c) < 64 ? (LP - 64 * c) : 64;
    m3_finish<false, true, true>(nullptr, (const bf16_t*)(ws + WS_PROJ) + rowbase * PROJ_LD + O_LG, L.lon, (bf16_t*)(ws + WS_MIXED) + rowbase * D, len, wave, lane, nullptr,
                                 (const unsigned*)(ws + WS_HLAC) + rowbase * 512, (const float*)(ws + WS_LRUHIN) + ((size_t)b * NCH + c) * 512);
}
template <bool SAMPLE>
__device__ __forceinline__ void m3_ssd_unit(const Params& P, const LayerPtrs& L, int l, int b, int c, int u, LAS unsigned char* lds, int wave, int lane_in) {
    int lane = lane_in; asm volatile("" : "+v"(lane));
    const int tid = wave * 64 + lane, fr = lane & 15, fq = lane >> 4, h = wave; unsigned char* ws = P.ws;
    const bf16_t* proj = (const bf16_t*)(ws + WS_PROJ); const float* csbuf = (const float*)(ws + WS_CS); const bf16_t* ybuf = (const bf16_t*)(ws + WS_YBUF);
    bf16_t* mixed = (bf16_t*)(ws + WS_MIXED);
    const size_t rowbase = SAMPLE ? (size_t)MP + 64 * (size_t)u : (size_t)b * LP + 64 * (size_t)c;
    const int len = SAMPLE ? 64 : ((LP - 64 * c) < 64 ? (LP - 64 * c) : 64);
    u32x2 yy[4][4]; float ev[4];
#pragma unroll
    for (int tt = 0; tt < 4; ++tt) { const size_t row = rowbase + 16 * tt + fr; ev[tt] = SAMPLE ? 0.f : csbuf[row * 8 + h];
#pragma unroll
        for (int pt = 0; pt < 4; ++pt) yy[tt][pt] = *(const u32x2*)(ybuf + row * 512 + h * 64 + 16 * pt + 4 * fq); }
    bf16x8 pfr[4][4];
    if constexpr (!SAMPLE) {
        const bf16_t* hp = (const bf16_t*)(ws + WS_SINB) + (((size_t)b * NCH + c) * 8 + h) * 8192;
#pragma unroll
        for (int pt = 0; pt < 4; ++pt)
#pragma unroll
            for (int ks = 0; ks < 4; ++ks) pfr[pt][ks] = *(const bf16x8*)(hp + (16 * pt + fr) * 128 + 32 * ks + 8 * fq);
    }
    u32x4 zpre[8];
#pragma unroll
    for (int i = 0; i < 8; ++i) zpre[i] = *(const u32x4*)(proj + (rowbase + wave * 8 + i) * PROJ_LD + O_Z + lane * 8);
    if constexpr (!SAMPLE) {
        const int cg = tid & 31, rg = tid >> 5, chan0 = 768 + 8 * cg; const size_t rowb = (size_t)b * LP; const int t0 = 64 * c + 4 * rg;
        u32x4 raw[7];
#pragma unroll
        for (int i = 0; i < 7; ++i) { const int tok = t0 - 3 + i; raw[i] = *(const u32x4*)(proj + (rowb + (tok < 0 ? 0 : tok)) * PROJ_LD + O_XBC + chan0); }
        f32x4 w[4][2], bs[2];
#pragma unroll
        for (int k = 0; k < 4; ++k) { w[k][0] = *(const f32x4*)(L.scw + k * 1024 + chan0); w[k][1] = *(const f32x4*)(L.scw + k * 1024 + chan0 + 4); }
        bs[0] = *(const f32x4*)(L.scb + chan0); bs[1] = *(const f32x4*)(L.scb + chan0 + 4);
        if (t0 < 3) {
#pragma unroll
            for (int i = 0; i < 3; ++i) if (t0 - 3 + i < 0) raw[i] = (u32x4){0u, 0u, 0u, 0u};
        }
#pragma unroll
        for (int r = 0; r < 4; ++r) {
            f32x4 o0 = bs[0], o1 = bs[1];
#pragma unroll
            for (int k = 0; k < 4; ++k) { const u32x4 x = raw[r + k];
                o0 += w[k][0] * (f32x4){bf2f(x[0] & 0xffffu), bf2f(x[0] >> 16), bf2f(x[1] & 0xffffu), bf2f(x[1] >> 16)};
                o1 += w[k][1] * (f32x4){bf2f(x[2] & 0xffffu), bf2f(x[2] >> 16), bf2f(x[3] & 0xffffu), bf2f(x[3] >> 16)}; }
            u32x4 q; q.x = pg8::cvt_pk_bf16(siluf_(o0[0]), siluf_(o0[1])); q.y = pg8::cvt_pk_bf16(siluf_(o0[2]), siluf_(o0[3])); q.z = pg8::cvt_pk_bf16(siluf_(o1[0]), siluf_(o1[1])); q.w = pg8::cvt_pk_bf16(siluf_(o1[2]), siluf_(o1[3]));
            *(LAS u32x4*)(lds + M3_CG + (cg >> 4) * 17408 + (4 * rg + r) * 272 + (cg & 15) * 16) = q;
        }
        __syncthreads();
    }
    LAS unsigned char* GL = lds + M3_XC;
    {
        const LAS unsigned char* CG = lds + M3_CG + (h >> 2) * 17408;
#pragma unroll
        for (int tt = 0; tt < 4; ++tt) {
            f32x4 acc[4];
#pragma unroll
            for (int pt = 0; pt < 4; ++pt) acc[pt] = (f32x4){0.f, 0.f, 0.f, 0.f};
            if constexpr (!SAMPLE) {
#pragma unroll
                for (int ks = 0; ks < 4; ++ks) { const bf16x8 cf = ldsfrag(CG, 272, 16 * tt + fr, 64 * ks + 16 * fq);
#pragma unroll
                    for (int pt = 0; pt < 4; ++pt) acc[pt] = mfma16(pfr[pt][ks], cf, acc[pt]); }
            }
            const int t = 16 * tt + fr; const float e = SAMPLE ? 0.f : __expf(ev[tt]);
#pragma unroll
            for (int pt = 0; pt < 4; ++pt) {
                const f32x4 y = (f32x4){bf2f(yy[tt][pt].x & 0xffffu), bf2f(yy[tt][pt].x >> 16), bf2f(yy[tt][pt].y & 0xffffu), bf2f(yy[tt][pt].y >> 16)} + acc[pt] * e;
                u32x2 w; w.x = pk2(y[0], y[1]); w.y = pk2(y[2], y[3]); const int c16 = (h * 8 + 2 * pt + (fq >> 1)) ^ (t & 15); *(LAS u32x2*)(GL + t * 1024 + c16 * 16 + (fq & 1) * 8) = w;
            }
        }
    }
    m3_finish<true, false, false>(GL, proj + rowbase * PROJ_LD + O_Z, L.son, mixed + rowbase * D + 512, len, wave, lane, zpre);
}

__device__ __forceinline__ void m2_phase(const Params& P, int l, const int tid, const int dry) {
    unsigned char* ws = P.ws; const bf16_t* states = (const bf16_t*)(ws + WS_STATES); const float* cdec = (const float*)(ws + WS_CDEC);
    for (int e4 = blockIdx.x * 512 + tid; e4 < NB * 8 * 2048; e4 += gridDim.x * 512) {
        const int bh = e4 >> 11, off = (e4 & 2047) * 4, b = bh >> 3, h = bh & 7;
        f32x4 run = (f32x4){0.f, 0.f, 0.f, 0.f};
        const size_t e0 = (((size_t)b * NCH) * 8 + h) * 8192 + off; constexpr size_t CST = (size_t)8 * 8192;
        u32x2 sc[NCH]; float dc[NCH];
        {
            constexpr int c0 = 0;
#pragma unroll
            for (int k = 0; k < NCH; ++k) { sc[k] = *(const u32x2*)(states + e0 + (size_t)(c0 + k) * CST); dc[k] = cdec[((size_t)b * NCH + c0 + k) * 8 + h]; }
#pragma unroll
            for (int k = 0; k < NCH; ++k) { u32x2 w; w.x = pk2(run[0], run[1]); w.y = pk2(run[2], run[3]); *(u32x2*)((bf16_t*)(ws + WS_SINB) + e0 + (size_t)(c0 + k) * CST) = w; run = run * dc[k] + (f32x4){bf2f(sc[k].x & 0xffffu), bf2f(sc[k].x >> 16), bf2f(sc[k].y & 0xffffu), bf2f(sc[k].y >> 16)}; }
        }
        if (!dry || run[0] == 12345.678f) *(f32x4*)(P.out + OFF_PSS + (((size_t)l * NB + b) * 8 + h) * 8192 + off) = run;
    }
    if (dry) return;
    const float* lruA = (const float*)(ws + WS_LRUA); const float* lruH = (const float*)(ws + WS_LRUH); float* lruHin = (float*)(ws + WS_LRUHIN);
    if (tid < 16) for (int i = blockIdx.x * 16 + tid; i < NB * 512; i += gridDim.x * 16) {
        const int b = i >> 9, ch = i & 511; float av[NCH], bv[NCH];
#pragma unroll
        for (int c = 0; c < NCH; ++c) { const size_t o = ((size_t)b * NCH + c) * 512 + ch; av[c] = lruA[o]; bv[c] = lruH[o]; }
        float hv = 0.f;
#pragma unroll
        for (int c = 0; c < NCH; ++c) { lruHin[((size_t)b * NCH + c) * 512 + ch] = hv; hv = av[c] * hv + bv[c]; }
        P.out[OFF_PLH + ((size_t)l * NB + b) * 512 + ch] = hv;
    }
}


__device__ __forceinline__ void ffn_sample_phase(const Params& P, int l, const int tid) {
    unsigned char* ws = P.ws; const float* us = (const float*)(ws + WS_USAMP); bf16_t* abuf = (bf16_t*)(ws + WS_ABUF);
    const float* cw = P.in[I_FCW] + (size_t)l * 3 * 6144; const float* cb = P.in[I_FCB] + (size_t)l * 6144; const float* st = P.in[I_SFC] + (size_t)l * NS * 2 * 6144;
    float* sf = P.out + OFF_SFC + (size_t)l * NS * 2 * 6144;
    for (int i = blockIdx.x * 512 + tid; i < NS * 768; i += gridDim.x * 512) {
        const int sq = i / 768, c = (i % 768) * 4;
        f32x4 res[4];
#pragma unroll
        for (int half = 0; half < 2; ++half) {
            const int col = c + 3072 * half;
            const f32x4 w0 = *(const f32x4*)(cw + col), w1 = *(const f32x4*)(cw + 6144 + col), w2 = *(const f32x4*)(cw + 2 * 6144 + col), bb = *(const f32x4*)(cb + col);
            f32x4 p2 = *(const f32x4*)(st + ((size_t)sq * 2) * 6144 + col), p1 = *(const f32x4*)(st + ((size_t)sq * 2 + 1) * 6144 + col);
#pragma unroll
            for (int t = 0; t < 4; ++t) {
                const f32x4 uu = *(const f32x4*)(us + ((size_t)sq * 4 + t) * 6144 + col);
                f32x4 cv = bb + w0 * p2 + w1 * p1 + w2 * uu;
                if (half == 0) { cv[0] = gelu_tanh(cv[0]); cv[1] = gelu_tanh(cv[1]); cv[2] = gelu_tanh(cv[2]); cv[3] = gelu_tanh(cv[3]); res[t] = cv; } else res[t] = res[t] * cv;
                if (t >= 2) *(f32x4*)(sf + ((size_t)sq * 2 + (t - 2)) * 6144 + col) = uu;
                p2 = p1; p1 = uu;
            }
        }
#pragma unroll
        for (int t = 0; t < 4; ++t) { u32x2 w; w.x = pk2(res[t][0], res[t][1]); w.y = pk2(res[t][2], res[t][3]); *(u32x2*)(abuf + ((size_t)MP + (size_t)sq * 4 + t) * DFFP + c) = w; }
    }
}

__device__ __forceinline__ void final_phase(const Params& P, int wave, int lane) {
    const bf16_t* xb = (const bf16_t*)(P.ws + WS_XB); const float* gn = P.in[I_NFIN];
    const int gw = blockIdx.x * 8 + wave, NGW = gridDim.x * 8;
    for (int m = gw; m < MT; m += NGW) {
        float* dst;
        if (m < MP) { const int b = m / LP, t = m % LP; if (t < NMETA) continue; dst = P.out + OFF_YP + ((size_t)b * SEQ + (t - NMETA)) * D; }
        else dst = P.out + OFF_YS + (size_t)(m - MP) * D;
        f32x4 v[4]; float s = 0.f;
#pragma unroll
        for (int j = 0; j < 4; ++j) { const u32x2 w = *((const u32x2*)(xb + (size_t)m * D) + lane + 64 * j); v[j][0] = bf2f(w.x & 0xffffu); v[j][1] = bf2f(w.x >> 16); v[j][2] = bf2f(w.y & 0xffffu); v[j][3] = bf2f(w.y >> 16);
            s += (v[j][0] * v[j][0] + v[j][1] * v[j][1]) + (v[j][2] * v[j][2] + v[j][3] * v[j][3]); }
        const float rs = __builtin_amdgcn_rsqf(wave_sum(s, lane) * (1.0f / 1024.0f) + EPS);
#pragma unroll
        for (int j = 0; j < 4; ++j) { const f32x4 g4 = *((const f32x4*)gn + lane + 64 * j); *((f32x4*)dst + lane + 64 * j) = v[j] * rs * g4; }
    }
}

__global__ void __launch_bounds__(512, 2) hymba_fwd(Params P) {
    extern __shared__ __attribute__((aligned(16))) unsigned char lds_raw[];
    LAS unsigned char* lds = (LAS unsigned char*)lds_raw;
    int wave0 = __builtin_amdgcn_readfirstlane((int)threadIdx.x >> 6);
    asm volatile("" : "+s"(wave0));
#define MYTID() (wave0 * 64 + my_lane_volatile())
    unsigned long long tacc_ = 0ull, tst_ = 0ull; (void)tacc_; (void)tst_;
#define TSTART(k) do { if (TIME_PHASE == (k)) tst_ = __builtin_amdgcn_s_memrealtime(); } while (0)
#define TEND(k) do { if (TIME_PHASE == (k)) tacc_ += __builtin_amdgcn_s_memrealtime() - tst_; } while (0)
    { const int tid = MYTID(); for (int i = tid; i < (LDS_BYTES - LDS_MISC) / 4; i += 512) ((LAS unsigned*)(lds + LDS_MISC))[i] = 0u; }
    __syncthreads();
    { unsigned char* w_ = glob_launder(P.ws); (void)xcd_barrier_post((unsigned*)(w_ + WS_CTL) + 4096, (volatile LAS unsigned*)(lds + LDS_MISC) + 8, MYTID()); }
#define GRID_BAR() do { unsigned char* w_ = glob_launder(P.ws); XcdBarrier b_; b_.bar = (unsigned*)(w_ + WS_CTL) + 4096; b_.x = xb_xcc_id(); b_.st = (volatile LAS unsigned*)(lds + LDS_MISC) + 8; \
        int t_ = MYTID(); asm volatile("" : "+v"(t_)); xcd_barrier(b_, t_); } while (0)
#define PHASE_ENV() Params Q = P; Q.ws = glob_launder(Q.ws); Q.out = glob_launder(Q.out); _Pragma("unroll") for (int i_ = 0; i_ < 31; ++i_) Q.in[i_] = glob(Q.in[i_]); unsigned char* ws = Q.ws; (void)ws; int ptid = MYTID(); asm volatile("" : "+v"(ptid)); const int lane = ptid & 63, wave = __builtin_amdgcn_readfirstlane(ptid >> 6); (void)lane; (void)wave; int G = (int)gridDim.x, bid = (int)blockIdx.x; asm volatile("" : "+s"(G), "+s"(bid)); (void)G; (void)bid

    TSTART(0);
    if (PH_MASK & 1) { PHASE_ENV(); if (REP_MASK & 256) p0_prologue(Q, lds, wave, lane, ptid); p0_prologue(Q, lds, wave, lane, ptid); }
    { cg::grid_group grid = cg::this_grid(); grid.sync(); }
    GRID_BAR();
    TEND(0);

#pragma unroll 1
    for (int l = 0; l < DEPTH; ++l) {
        TSTART(1);
        if (PH_MASK & 2) {
            PHASE_ENV();
            pg8::Gemm g{(const bf16_t*)(ws + WS_XB), (const bf16_t*)(ws + WS_W + (size_t)l * W_LAYER + W_IN), D, 67, 11, (long)256 * D * 2, (long)128 * D * 2, 0};
            pg8::ConsOrder S; S.init(67, 11, G, bid, (REP_MASK & 1) ? 2 : 1); S.cnt = (unsigned*)(ws + WS_CTL) + 16384 + ((l > 0 ? l - 1 : 0) * 2 + 1) * 67 * 64; S.need = l > 0 ? 4u : 0u; S.tmo = (unsigned*)(ws + WS_CTL) + 8; S.ovl = 0; S.wid = wave; S.nP = 67; S.rb = l > 0 ? 1 : 0;
            pg8::EpiIn E{(bf16_t*)(ws + WS_PROJ), (float*)(ws + WS_DTRAW), (const float*)(ws + WS_SS) + (size_t)(2 * l) * MPAD * 16};
            pg8::gemm_phase<pg8::EpiIn, pg8::ConsOrder, true, true>(lds, g, S, E, ptid);
        }
        if (l > 0) TEND(81);
        GRID_BAR();
        TEND(1);
        TSTART(2);
        {
            PHASE_ENV();
            const LayerPtrs L = layer_ptrs(Q, l);
            constexpr int N_SSD = NB * NCH * 2, N_LRU = NB * NCH, N_SMP = NS, N_SLRU = MS / 64, N_ALL = N_SSD + N_LRU + N_SMP + N_SLRU;
            TSTART(24);
            static_assert(N_SSD == 528 && N_LRU == 264 && N_SMP == 128 && N_SLRU == 8, "M1 deal");
            constexpr int O_L = N_SSD, O_S = N_SSD + N_LRU, O_SL = N_SSD + N_LRU + N_SMP;
#pragma unroll 1
            for (int k = 0; ; ++k) {
                int it;
                if (G == 256) {
                    if (k >= 4) break;
                    const int w = bid;
                    if (w < 120) it = k == 0 ? O_L + w : 3 * w + (k - 1);
                    else if (w < 168) it = k < 2 ? O_L + 120 + 2 * (w - 120) + k : 360 + 2 * (w - 120) + (k - 2);
                    else if (w < 200) it = k < 2 ? 456 + 2 * (w - 168) + k : (k == 2 ? O_S + (w - 168) : -1);
                    else if (w < 248) it = k == 0 ? O_L + 216 + (w - 200) : (k < 3 ? O_S + 32 + 2 * (w - 200) + (k - 1) : -1);
                    else it = k == 0 ? O_SL + (w - 248) : (k == 1 ? 520 + (w - 248) : -1);
                    if (it < 0) continue;
                } else { it = bid + k * G; if (it >= N_ALL) break; }
                if (it < N_SSD) { if (PH_MASK & 4) { const int b = it / (NCH * 2), r = it % (NCH * 2); m1_ssd_unit(Q, L, l, b, r >> 1, r & 1, lds, wave, lane); } }
                else if (it < N_SSD + N_LRU) { const int r = it - N_SSD; int nr_ = (REP_MASK & 524288) ? 2 : 1; asm volatile("" : "+s"(nr_));
#pragma unroll 1
                    for (int q_ = 0; q_ < nr_; ++q_) if (PH_MASK & 8) m1_lru_unit(Q, L, l, r / NCH, r % NCH, lds, wave, lane); }
                else if (it < N_SSD + N_LRU + N_SMP) { if (PH_MASK & 16) m1_sample_ssd_unit(Q, L, l, it - N_SSD - N_LRU, lds, wave, lane); __syncthreads(); }
                else { if (PH_MASK & 16) lru_sample_unit(Q, L, l, it - N_SSD - N_LRU - N_SMP, lds, wave, lane); }
            }
            TEND(24);
        }
        GRID_BAR();
        TEND(2);
        if (REP_MASK & 128) { for (int eb_ = 0; eb_ < 10; ++eb_) GRID_BAR(); }
        TSTART(3);
        if (PH_MASK & 32) { PHASE_ENV(); m2_phase(Q, l, ptid, 0); }
        GRID_BAR();
        TEND(3);
        TSTART(4);
        {
            PHASE_ENV();
            const LayerPtrs L = layer_ptrs(Q, l);
            constexpr int N_PR = NB * NCH, N_SM = MS / 64, N_U = N_PR + N_SM;
            TSTART(44);
            int nrr_ = (REP_MASK & 262144) ? 2 : 1; asm volatile("" : "+s"(nrr_));
#pragma unroll 1
            for (int rr_ = 0; rr_ < nrr_; ++rr_) {
                for (int un = bid; un < N_U; un += G) {
                    if (un < N_PR) { if (PH_MASK & 64) m3_ssd_unit<false>(Q, L, l, un / NCH, un % NCH, 0, lds, wave, lane); } else if (PH_MASK & 128) m3_ssd_unit<true>(Q, L, l, 0, 0, un - N_PR, lds, wave, lane); }
                { const int nx = N_U > G ? N_U - G : 0, nl = G - nx;
                  if (bid >= nx) for (int un = bid - nx; un < N_PR; un += nl) { if (PH_MASK & 64) m3_lru_light(Q, L, un / NCH, un % NCH, wave, lane); } }
            }
            TEND(44);
        }
        GRID_BAR();
        TEND(4);
        TSTART(5);
        if (PH_MASK & 256) {
            PHASE_ENV();
            pg8::Gemm g{(const bf16_t*)(ws + WS_MIXED), (const bf16_t*)(ws + WS_W + (size_t)l * W_LAYER + W_OUT), D, 67, 4, (long)256 * D * 2, (long)128 * D * 2, 0};
            pg8::ProdOrder S; S.init(67, 4, G, (bid + G - (69 * 24) % G) % G); S.cnt = (unsigned*)(ws + WS_CTL) + 16384 + (l * 2 + 0) * 67 * 64; S.tid = ptid;
            pg8::EpiRes E{(bf16_t*)(ws + WS_XB), (float*)(ws + WS_SS) + (size_t)(2 * l + 1) * MPAD * 16};
            pg8::gemm_phase<pg8::EpiRes, pg8::ProdOrder, true, true>(lds, g, S, E, ptid);
        }
        TEND(5);
        TSTART(6);
        if (PH_MASK & 512) {
            PHASE_ENV();
            pg8::Gemm g{(const bf16_t*)(ws + WS_XB) - 2 * D, (const bf16_t*)(ws + WS_W + (size_t)l * W_LAYER + W_UP), D, 69, 24, (long)248 * D * 2, (long)124 * D * 2, 1};
            pg8::ConsOrder S; S.init(69, 24, G, bid, (REP_MASK & (8 | 512 | 8192 | 16384)) ? 2 : 1); S.cnt = (unsigned*)(ws + WS_CTL) + 16384 + (l * 2 + 0) * 67 * 64; S.need = 4u; S.tmo = (unsigned*)(ws + WS_CTL) + 8; S.ovl = 1; S.wid = wave; S.nP = 67; S.nMg = 67;
            pg8::EpiUp E{(bf16_t*)(ws + WS_ABUF), (const float*)(ws + WS_SS) + (size_t)(2 * l + 1) * MPAD * 16, Q.in[I_FCW] + (size_t)l * 3 * 6144, Q.in[I_FCB] + (size_t)l * 6144,
                         Q.out + OFF_PFC + (size_t)l * NB * 2 * 6144, (float*)(ws + WS_USAMP), (void*)(ws + WS_X)};
            pg8::gemm_phase<pg8::EpiUp, pg8::ConsOrder, true, true>(lds, g, S, E, ptid);
        }
        GRID_BAR();
        TEND(6);
        TSTART(7);
        if (PH_MASK & 512) { PHASE_ENV(); ffn_sample_phase(Q, l, ptid); }
        GRID_BAR();
        TEND(7);
        TSTART(8);
        if (l < DEPTH - 1) TSTART(81);
        if (PH_MASK & 1024) {
            PHASE_ENV();
            pg8::Gemm g{(const bf16_t*)(ws + WS_ABUF), (const bf16_t*)(ws + WS_W + (size_t)l * W_LAYER + W_DOWN), DFF, 67, 4, (long)256 * DFFP * 2, (long)128 * DFFP * 2, 0, DFFP};
            pg8::ProdOrder S; S.init(67, 4, G, (bid + G - (67 * 11) % G) % G); S.cnt = (unsigned*)(ws + WS_CTL) + 16384 + (l * 2 + 1) * 67 * 64; S.tid = ptid;
            pg8::EpiRes E{(bf16_t*)(ws + WS_XB), (float*)(ws + WS_SS) + (size_t)(2 * l + 2) * MPAD * 16};
            pg8::gemm_phase<pg8::EpiRes, pg8::ProdOrder, true, true>(lds, g, S, E, ptid);
        }
        if (l == DEPTH - 1) GRID_BAR();
        TEND(8);
    }
    TSTART(9);
    if (PH_MASK & 2048) { PHASE_ENV(); final_phase(Q, wave, lane); }
    TEND(9);
    if (TIME_PHASE >= 0 && blockIdx.x == TIME_WG) { const unsigned long long t0_ = __builtin_amdgcn_s_memrealtime(); while (__builtin_amdgcn_s_memrealtime() - t0_ < 9ull * tacc_) __builtin_amdgcn_s_sleep(8); }
}

extern "C" void kernel_launch(void* const* d_in, const int* in_sizes, int n_in, void* d_out, int out_size, void* d_ws, size_t ws_size, hipStream_t stream) {
    static int grid = 0;
    if (grid == 0) {
        if (n_in != 31 || (size_t)out_size != OUT_TOTAL || ws_size < WS_END) { fprintf(stderr, "kernel_launch: unexpected problem (n_in %d, out %d, ws %zu)\n", n_in, out_size, ws_size); grid = -1; return; }
        int dev = 0, cus = 0, per_cu = 0;
        if (hipGetDevice(&dev) != hipSuccess || hipDeviceGetAttribute(&cus, hipDeviceAttributeMultiprocessorCount, dev) != hipSuccess) { grid = -1; return; }
        if (hipFuncSetAttribute((const void*)hymba_fwd, hipFuncAttributeMaxDynamicSharedMemorySize, LDS_BYTES) != hipSuccess) { fprintf(stderr, "kernel_launch: hipFuncSetAttribute failed\n"); grid = -1; return; }
        if (hipOccupancyMaxActiveBlocksPerMultiprocessor(&per_cu, (const void*)hymba_fwd, 512, LDS_BYTES) != hipSuccess || per_cu < 1) { fprintf(stderr, "kernel_launch: occupancy query says %d\n", per_cu); per_cu = 1; }
        (void)hipGetLastError();
        grid = cus * (per_cu > 1 ? 1 : per_cu);
    }
    if (grid < 0) return;
    (void)hipMemsetAsync((char*)d_ws + WS_CTL, 0, CTL_BYTES, stream);
    Params p{};
    for (int i = 0; i < 31; ++i) p.in[i] = (const float*)d_in[i];
    p.out = (float*)d_out; p.ws = (unsigned char*)d_ws;
    void* args[] = {&p};
    hipError_t e = hipLaunchCooperativeKernel((const void*)hymba_fwd, dim3(grid), dim3(512), args, LDS_BYTES, stream);
    if (e != hipSuccess) fprintf(stderr, "kernel_launch: cooperative launch failed: %s (grid %d)\n", hipGetErrorString(e), grid);
}
```
